# Optimizing an MI355X kernel written in HIP

```python
import math
import jax, jax.numpy as jnp
from jax import lax
import numpy as np

D_MODEL = 1024
BATCH = 2
SEQ = 8192
DEPTH = 1

D_PLE = 256
D_MIX = D_MODEL
D_CONV = D_MIX // 2
D_SGU = D_MIX - D_CONV
CONV_GROUPS = 8
CONV_WIDTH = 31
N_SGU_HEADS = 8
SGU_HEAD_DIM = D_SGU // N_SGU_HEADS
CHUNK = 128
LN_EPS = 1e-5
ALPHA = (2 * DEPTH) ** 0.25
BETA = (8 * DEPTH) ** -0.25
D_IN = 3 * D_CONV + 3 * D_SGU

kernel_name = "hybrid_conformer_conv_chunked_sgu_deepnorm"


def _layer_norm(x, g, b):
    xf = x.astype(jnp.float32)
    mu = jnp.mean(xf, axis=-1, keepdims=True)
    var = jnp.mean(jnp.square(xf - mu), axis=-1, keepdims=True)
    y = (xf - mu) * lax.rsqrt(var + LN_EPS)
    return (y * g.astype(jnp.float32) + b.astype(jnp.float32)).astype(x.dtype)


def _causal_depthwise_conv(a, w, b):
    out = lax.conv_general_dilated(
        a, w[:, None, :].astype(a.dtype),
        window_strides=(1,),
        padding=[(CONV_WIDTH - 1, 0)],
        dimension_numbers=("NWC", "WIO", "NWC"),
        feature_group_count=a.shape[-1])
    return out + b


def _conformer_conv_branch(a_val, a_gate, a_z, conv_w, conv_b, ln_g, ln_b):
    a = a_val * jax.nn.sigmoid(a_gate)
    a = _causal_depthwise_conv(a, conv_w, conv_b)
    a = jax.nn.silu(_layer_norm(a, ln_g, ln_b))
    return a * jax.nn.silu(a_z)


def _chunked_sgu_branch(b_u, b_v, b_z, ln_g, ln_b, w_s, b_s):
    bsz, seq, _ = b_u.shape
    u = jax.nn.gelu(b_u, approximate=False)
    v = _layer_norm(jax.nn.gelu(b_v, approximate=False), ln_g, ln_b)
    vh = v.reshape(bsz, seq // CHUNK, CHUNK, N_SGU_HEADS, SGU_HEAD_DIM)
    mask = jnp.tril(jnp.ones((CHUNK, CHUNK), dtype=bool))
    w = jnp.where(mask[None], w_s, jnp.zeros((), w_s.dtype))
    sv = jnp.einsum("hts,bcshd->bcthd", w, vh)
    sv = sv + jnp.transpose(b_s)[None, None, :, :, None]
    sv = sv.reshape(bsz, seq, D_SGU)
    return (u * sv) * jax.nn.silu(b_z)


def setup_inputs(seed: int = 0) -> dict:
    key = jax.random.key(seed)
    ks = jax.random.split(key, 20)
    f32 = jnp.float32
    nrm = lambda k, shape, s: jax.random.normal(k, shape, f32) * s
    return {
        "x": nrm(ks[0], (BATCH, SEQ, D_MODEL), 1.0),
        "p": nrm(ks[1], (DEPTH, BATCH, SEQ, D_PLE), 1.0),
        "ln_emb_g": 1.0 + nrm(ks[2], (D_MODEL,), 0.02),
        "ln_emb_b": nrm(ks[3], (D_MODEL,), 0.02),
        "w_in": nrm(ks[4], (DEPTH, D_MODEL, D_IN), D_MODEL ** -0.5),
        "conv_w": nrm(ks[5], (DEPTH, CONV_WIDTH, D_CONV), CONV_WIDTH ** -0.5),
        "conv_b": nrm(ks[6], (DEPTH, D_CONV), 0.02),
        "conv_ln_g": 1.0 + nrm(ks[7], (DEPTH, D_CONV), 0.02),
        "conv_ln_b": nrm(ks[8], (DEPTH, D_CONV), 0.02),
        "sgu_ln_g": 1.0 + nrm(ks[9], (DEPTH, D_SGU), 0.02),
        "sgu_ln_b": nrm(ks[10], (DEPTH, D_SGU), 0.02),
        "w_s": nrm(ks[11], (DEPTH, N_SGU_HEADS, CHUNK, CHUNK), CHUNK ** -0.5),
        "b_s": 1.0 + nrm(ks[12], (DEPTH, N_SGU_HEADS, CHUNK), 0.02),
        "w_out": nrm(ks[13], (DEPTH, D_MIX, D_MODEL), BETA * D_MIX ** -0.5),
        "post_ln_g": 1.0 + nrm(ks[14], (DEPTH, D_MODEL), 0.02),
        "post_ln_b": nrm(ks[15], (DEPTH, D_MODEL), 0.02),
        "w_ple": nrm(ks[16], (DEPTH, D_PLE, D_MODEL), D_PLE ** -0.5),
        "w_ple_gate": nrm(ks[17], (DEPTH, D_MODEL, D_MODEL), D_MODEL ** -0.5),
        "b_ple_gate": nrm(ks[18], (DEPTH, D_MODEL), 0.02),
    }


def reference(x, p, ln_emb_g, ln_emb_b, w_in, conv_w, conv_b, conv_ln_g, conv_ln_b,
              sgu_ln_g, sgu_ln_b, w_s, b_s, w_out, post_ln_g, post_ln_b,
              w_ple, w_ple_gate, b_ple_gate):
    splits = [D_CONV, 2 * D_CONV, 3 * D_CONV, 3 * D_CONV + D_SGU, 3 * D_CONV + 2 * D_SGU]
    h = _layer_norm(x, ln_emb_g, ln_emb_b)
    for i in range(DEPTH):
        proj = jnp.einsum("bsd,de->bse", h, w_in[i])
        a_val, a_gate, a_z, b_u, b_v, b_z = jnp.split(proj, splits, axis=-1)
        y_a = _conformer_conv_branch(a_val, a_gate, a_z, conv_w[i], conv_b[i],
                                     conv_ln_g[i], conv_ln_b[i])
        y_b = _chunked_sgu_branch(b_u, b_v, b_z, sgu_ln_g[i], sgu_ln_b[i], w_s[i], b_s[i])
        y = jnp.concatenate([y_a, y_b], axis=-1)
        mix = jnp.einsum("bse,ed->bsd", y, w_out[i])
        h = _layer_norm(ALPHA * h + mix, post_ln_g[i], post_ln_b[i])
        pe = jnp.einsum("bsk,kd->bsd", p[i], w_ple[i])
        gate = jax.nn.sigmoid(jnp.einsum("bsd,de->bse", h, w_ple_gate[i]) + b_ple_gate[i])
        h = h + gate * pe
    return h
```

```cpp
#include <hip/hip_runtime.h>
#include <hip/hip_cooperative_groups.h>
#include <cstdio>
#include <cstdint>
namespace cg = cooperative_groups;
namespace pg8 {
#define PG8_LAS __attribute__((address_space(3)))
typedef unsigned short bf16_t;
typedef short bf16x8 __attribute__((ext_vector_type(8)));
typedef float f32x4 __attribute__((ext_vector_type(4)));
typedef unsigned u32x4 __attribute__((ext_vector_type(4)));
constexpr int BM = 256, BK = 64, HALF = 128, HTB = HALF * BK * 2  , STAGE_BYTES = 8 * HTB, NXCD = 8, WGM = 8;

__host__ __device__ __forceinline__ int lds_byte(int r, int c) { const int st = (r >> 4) * 2 + (c >> 5), rr = r & 15, cc = c & 31, ob = rr * 64 + cc * 2; return st * 1024 + (ob ^ (((ob >> 9) & 1) << 5)); }
__host__ __device__ __forceinline__ void stage_rc(int b, int& R, int& C) { const int st = b / 1024, sb = b % 1024, swz = sb ^ (((sb >> 9) & 1) << 5); R = (st >> 1) * 16 + swz / 64; C = (st & 1) * 32 + (swz % 64) / 2; }
__host__ __device__ __forceinline__ int perm32(int rho) { const int n = rho >> 4, i = rho & 15; return 8 * (i >> 2) + 4 * n + (i & 3); }

struct Unit { int pm, pn; };
struct Gemm { const bf16_t* A; const bf16_t* Bt; int M, N, K; };

struct StaticOrder {
    int nM, nN, nwg, G, c;
    __host__ __device__ void init(int M, int N, int G_, int c_) { nM = M / BM; nN = N / BM; nwg = nM * nN; G = G_; c = c_; }
    __host__ __device__ bool next(int i, Unit& u) const {
        const long L = (long)i * G + c; if (L >= nwg) return false;
        int wgid = (int)L; { const int q = nwg / NXCD, r = nwg % NXCD, xcd = wgid % NXCD, off = wgid / NXCD; wgid = (xcd < r ? xcd * (q + 1) : r * (q + 1) + (xcd - r) * q) + off; }
        const int nig = WGM * nN, gid = wgid / nig, fm = gid * WGM, gsz = (nM - fm) < WGM ? (nM - fm) : WGM;
        u.pm = fm + ((wgid % nig) % gsz); u.pn = (wgid % nig) / gsz; return true;
    }
    __device__ __forceinline__ void a_ready(const Unit&) const {}
    __device__ __forceinline__ void done(const Unit&) const {}
};

__device__ __forceinline__ unsigned cvt_pk_bf16(float lo, float hi) { unsigned r; asm volatile("v_cvt_pk_bf16_f32 %0, %1, %2" : "=v"(r) : "v"(lo), "v"(hi)); return r; }
typedef float f32x2 __attribute__((ext_vector_type(2)));
__device__ __forceinline__ f32x2 gelu_pk(f32x2 v) {
    const f32x2 av = __builtin_elementwise_abs(v), d = av * 0.2316418882f + 1.0f;
    f32x2 t; t.x = __builtin_amdgcn_rcpf(d.x); t.y = __builtin_amdgcn_rcpf(d.y);
    f32x2 q = t * 0.5307027145f + (-0.7265760135f); q = q * t + 0.7107068705f; q = q * t + (-0.142248368f); q = q * t + 0.127414796f; q = q * t;
    const f32x2 s = (v * v) * (-0.72134752044f);
    f32x2 e; e.x = __builtin_amdgcn_exp2f(s.x); e.y = __builtin_amdgcn_exp2f(s.y);
    const f32x2 m = v * (q * e), r = v - m;
    f32x2 o; o.x = v.x < 0.f ? m.x : r.x; o.y = v.y < 0.f ? m.y : r.y; return o;
}

template <int ACT  > struct EpiBf16 {
    static constexpr bool PERM = true, AFTER_DRAIN = false; static_assert(ACT == 0 || ACT == 1, "EpiBf16: ACT is 0 (none) or 1 (gelu_pk)");
    bf16_t* O; int ldc; const float* bias; int split_cols; size_t split_stride; float scale0;
    __device__ __forceinline__ void operator()(const f32x4 (&acc)[2][2][4][2], const Unit& u, int wr, int wc, int fr, int fq) const {
        const int row0 = u.pm * BM + wr * 64 + fr; int colt = u.pn * BM; bf16_t* base = O;
        float sc = 1.f; if (split_cols) { const int t = colt / split_cols; base += (size_t)t * split_stride; colt -= t * split_cols; if (t == 0) sc = scale0; }
        const int col0 = colt + wc * 32 + 8 * fq, bcol0 = u.pn * BM + wc * 32 + 8 * fq;
        f32x4 bv[2][2];
#pragma unroll
        for (int bj = 0; bj < 2; ++bj)
#pragma unroll
            for (int n = 0; n < 2; ++n) bv[bj][n] = bias ? *(const f32x4*)(bias + bcol0 + bj * HALF + 4 * n) : (f32x4){0.f, 0.f, 0.f, 0.f};
#pragma unroll
        for (int ai = 0; ai < 2; ++ai)
#pragma unroll
            for (int m = 0; m < 4; ++m) { bf16_t* rowp = base + (size_t)(row0 + ai * HALF + m * 16) * ldc + col0;
#pragma unroll
                for (int bj = 0; bj < 2; ++bj) { f32x4 v0 = acc[ai][bj][m][0] + bv[bj][0], v1 = acc[ai][bj][m][1] + bv[bj][1];
                    if (ACT == 1) { f32x2 a = gelu_pk((f32x2){v0[0], v0[1]}), b = gelu_pk((f32x2){v0[2], v0[3]}), c = gelu_pk((f32x2){v1[0], v1[1]}), d = gelu_pk((f32x2){v1[2], v1[3]});
                        v0 = (f32x4){a.x, a.y, b.x, b.y}; v1 = (f32x4){c.x, c.y, d.x, d.y}; }
                    v0 = v0 * sc; v1 = v1 * sc; u32x4 w; w.x = cvt_pk_bf16(v0[0], v0[1]); w.y = cvt_pk_bf16(v0[2], v0[3]); w.z = cvt_pk_bf16(v1[0], v1[1]); w.w = cvt_pk_bf16(v1[2], v1[3]);
                    *(u32x4*)(rowp + bj * HALF) = w; } }
    }
};
__device__ __forceinline__ float sigm(float x) { return __builtin_amdgcn_rcpf(1.0f + __builtin_amdgcn_exp2f(-1.44269504089f * x)); }
__device__ __forceinline__ f32x4 sigm4(f32x4 v) { return (f32x4){sigm(v[0]), sigm(v[1]), sigm(v[2]), sigm(v[3])}; }
__device__ __forceinline__ f32x4 gelu4(f32x4 v) { const f32x2 a = gelu_pk((f32x2){v[0], v[1]}), b = gelu_pk((f32x2){v[2], v[3]}); return (f32x4){a.x, a.y, b.x, b.y}; }
__device__ __forceinline__ u32x4 pack8(f32x4 v0, f32x4 v1) { u32x4 w; w.x = cvt_pk_bf16(v0[0], v0[1]); w.y = cvt_pk_bf16(v0[2], v0[3]); w.z = cvt_pk_bf16(v1[0], v1[1]); w.w = cvt_pk_bf16(v1[2], v1[3]); return w; }
__device__ __forceinline__ f32x4 unpk_lo(u32x4 w) { return (f32x4){__uint_as_float(w.x << 16), __uint_as_float(w.x & 0xffff0000u), __uint_as_float(w.y << 16), __uint_as_float(w.y & 0xffff0000u)}; }
__device__ __forceinline__ f32x4 unpk_hi(u32x4 w) { return (f32x4){__uint_as_float(w.z << 16), __uint_as_float(w.z & 0xffff0000u), __uint_as_float(w.w << 16), __uint_as_float(w.w & 0xffff0000u)}; }

struct EpiP1 {
    static constexpr bool PERM = true, AFTER_DRAIN = false;
    bf16_t *Ab, *SZ, *UG, *GV;
    __device__ __forceinline__ void operator()(const f32x4 (&acc)[2][2][4][2], const Unit& u, int wr, int wc, int fr, int fq) const {
        const int row0 = u.pm * BM + wr * 64 + fr, pn = u.pn, cl = wc * 32 + 8 * fq;
        if (pn < 4 || (pn >= 6 && pn < 10)) {
            const bool glu = pn < 4; bf16_t* base = glu ? Ab : UG; const int colt = 128 * (glu ? pn : pn - 6) + cl;
#pragma unroll
            for (int ai = 0; ai < 2; ++ai)
#pragma unroll
                for (int m = 0; m < 4; ++m) { bf16_t* rowp = base + (size_t)(row0 + ai * HALF + m * 16) * 512 + colt;
                    const f32x4 v0 = acc[ai][0][m][0], v1 = acc[ai][0][m][1], g0 = acc[ai][1][m][0], g1 = acc[ai][1][m][1];
                    f32x4 o0, o1;
                    if (glu) { o0 = v0 * sigm4(g0); o1 = v1 * sigm4(g1); }
                    else { o0 = gelu4(v0) * (g0 * sigm4(g0)); o1 = gelu4(v1) * (g1 * sigm4(g1)); }
                    *(u32x4*)rowp = pack8(o0, o1); }
        } else {
            const bool sil = pn < 6; bf16_t* base = sil ? SZ : GV; const int colt = 256 * (sil ? pn - 4 : pn - 10) + cl;
#pragma unroll
            for (int ai = 0; ai < 2; ++ai)
#pragma unroll
                for (int m = 0; m < 4; ++m) { bf16_t* rowp = base + (size_t)(row0 + ai * HALF + m * 16) * 512 + colt;
#pragma unroll
                    for (int bj = 0; bj < 2; ++bj) { const f32x4 v0 = acc[ai][bj][m][0], v1 = acc[ai][bj][m][1]; f32x4 o0, o1;
                        if (sil) { o0 = v0 * sigm4(v0); o1 = v1 * sigm4(v1); } else { o0 = gelu4(v0); o1 = gelu4(v1); }
                        *(u32x4*)(rowp + bj * HALF) = pack8(o0, o1); } }
        }
    }
};

struct EpiP3 {
    static constexpr bool PERM = true, AFTER_DRAIN = true;
    const bf16_t* H; float* R; bf16_t* RB; float* statsP; float alpha;
    __device__ __forceinline__ void fused(f32x4 (&acc)[2][2][4][2], const Unit& u, int wr, int wc, int fr, int fq, PG8_LAS unsigned char* lds, int wid, int lane) const {
        PG8_LAS f32x2* P = (PG8_LAS f32x2*)lds;
        const int col0 = u.pn * BM + wc * 32 + 8 * fq;
#pragma unroll
        for (int ai = 0; ai < 2; ++ai)
#pragma unroll
            for (int m = 0; m < 4; ++m) { const int r = ai * HALF + wr * 64 + m * 16 + fr; const size_t off = (size_t)(u.pm * BM + r) * 1024 + col0; float s1 = 0.f, s2 = 0.f;
#pragma unroll
                for (int bj = 0; bj < 2; ++bj) { const u32x4 hh = *(const u32x4*)(H + off + bj * HALF);
                    const f32x4 v0 = acc[ai][bj][m][0] + alpha * unpk_lo(hh), v1 = acc[ai][bj][m][1] + alpha * unpk_hi(hh);
                    *(f32x4*)(R + off + bj * HALF) = v0; *(f32x4*)(R + off + bj * HALF + 4) = v1; *(u32x4*)(RB + off + bj * HALF) = pack8(v0, v1);
                    s1 += (v0[0] + v0[1]) + (v0[2] + v0[3]) + (v1[0] + v1[1]) + (v1[2] + v1[3]);
                    s2 += (v0[0] * v0[0] + v0[1] * v0[1]) + (v0[2] * v0[2] + v0[3] * v0[3]) + (v1[0] * v1[0] + v1[1] * v1[1]) + (v1[2] * v1[2] + v1[3] * v1[3]); }
                s1 += __shfl_xor(s1, 16); s1 += __shfl_xor(s1, 32); s2 += __shfl_xor(s2, 16); s2 += __shfl_xor(s2, 32);
                if (fq == 0) P[r * 4 + wc] = (f32x2){s1, s2}; }
        __syncthreads();
        const int tid = wid * 64 + lane;
        if (tid < 256) { const f32x2 a = P[tid * 4 + 0], b = P[tid * 4 + 1], c = P[tid * 4 + 2], d = P[tid * 4 + 3];
            *(f32x2*)(statsP + (size_t)(u.pm * BM + tid) * 8 + u.pn * 2) = (f32x2){(a.x + b.x) + (c.x + d.x), (a.y + b.y) + (c.y + d.y)}; }
    }
};

struct EpiP4 {
    static constexpr bool PERM = true, AFTER_DRAIN = true;
    const float* R; const bf16_t* PE; const float* statsP; const float* cp1; const float* cp2; const float* bgate; const float* g; const float* b; float* out; float eps;
    __device__ __forceinline__ void fused(f32x4 (&acc)[2][2][4][2], const Unit& u, int wr, int wc, int fr, int fq, PG8_LAS unsigned char* lds, int wid, int lane) const {
        PG8_LAS float* C = (PG8_LAS float*)lds;
        PG8_LAS f32x2* T = (PG8_LAS f32x2*)(lds + 2048);
        const int tid = wid * 64 + lane;
        { const int col = tid & 255, which = tid >> 8; const float* cp = cp1 + which * (16 * 1024); float s = 0.f;
#pragma unroll
          for (int kb = 0; kb < 16; ++kb) s += cp[kb * 1024 + u.pn * BM + col];
          if (which) s += bgate[u.pn * BM + col];
          C[which * 256 + col] = s; }
        if (tid < 256) { const float* sp = statsP + (size_t)(u.pm * BM + tid) * 8; const f32x4 a = *(const f32x4*)sp, bq = *(const f32x4*)(sp + 4);
            const float s1 = (a[0] + a[2]) + (bq[0] + bq[2]), s2 = (a[1] + a[3]) + (bq[1] + bq[3]);
            const float mu = s1 * (1.0f / 1024.0f); float var = s2 * (1.0f / 1024.0f) - mu * mu; var = var < 0.f ? 0.f : var;
            T[tid] = (f32x2){mu, 1.0f / sqrtf(var + eps)}; }
        __syncthreads();
#pragma unroll
        for (int bj = 0; bj < 2; ++bj) {
            const int cl = wc * 32 + 8 * fq + bj * HALF, gc = u.pn * BM + cl;
            const f32x4 c1a = *(const PG8_LAS f32x4*)(C + cl), c1b = *(const PG8_LAS f32x4*)(C + cl + 4), c2a = *(const PG8_LAS f32x4*)(C + 256 + cl), c2b = *(const PG8_LAS f32x4*)(C + 256 + cl + 4);
            const f32x4 ga = *(const f32x4*)(g + gc), gb = *(const f32x4*)(g + gc + 4), ba = *(const f32x4*)(b + gc), bb = *(const f32x4*)(b + gc + 4);
#pragma unroll
            for (int ai = 0; ai < 2; ++ai)
#pragma unroll
                for (int m = 0; m < 4; ++m) { const int r = ai * HALF + wr * 64 + m * 16 + fr; const f32x2 sr = T[r]; const size_t off = (size_t)(u.pm * BM + r) * 1024 + gc;
                    const f32x4 r0 = *(const f32x4*)(R + off), r1 = *(const f32x4*)(R + off + 4); const u32x4 pw = *(const u32x4*)(PE + off);
                    const f32x4 p0 = unpk_lo(pw), p1 = unpk_hi(pw);
                    const f32x4 gp0 = (acc[ai][bj][m][0] - sr.x * c1a) * sr.y + c2a, gp1 = (acc[ai][bj][m][1] - sr.x * c1b) * sr.y + c2b;
                    const f32x4 h0 = (r0 - sr.x) * sr.y * ga + ba, h1 = (r1 - sr.x) * sr.y * gb + bb;
                    *(f32x4*)(out + off) = h0 + sigm4(gp0) * p0; *(f32x4*)(out + off + 4) = h1 + sigm4(gp1) * p1; }
        }
    }
};

template <class Epi, class Sched, bool ALIGN_EPI = false, bool SP2 = false>
__device__ __forceinline__ void gemm_phase(PG8_LAS unsigned char* lds, const Gemm g, const Sched& S, const Epi& E) {
    int tid_ = threadIdx.x; asm volatile("" : "+v"(tid_));
    const int tid = tid_, wid = __builtin_amdgcn_readfirstlane(tid >> 6), lane = tid & 63, wr = wid >> 2, wc = wid & 3, fr = lane & 15, fq = lane >> 4;
    const int K = g.K, nt = K / BK;
    unsigned voffA[2], voffB[2];
#pragma unroll
    for (int i = 0; i < 2; ++i) { int R, C; stage_rc(tid * 16 + i * 8192, R, C); const int Rb = Epi::PERM ? ((R & ~31) + perm32(R & 31)) : R;
        voffA[i] = (unsigned)(R * K + C) * 2u; voffB[i] = (unsigned)(Rb * K + C) * 2u; }
    const size_t kstep = (size_t)(BK * 2);
    const size_t hstep = (size_t)HALF * K * 2;
    const size_t tstep = 2 * hstep;
    const unsigned ldsw = (unsigned)wid * 1024u;
    const int aoff = lds_byte(wr * 64 + fr, fq * 8), boff = lds_byte(wc * 32 + fr, fq * 8);
#define PG8_SA(b, h) (((b) * 2 + (h)) * HTB)
#define PG8_SB(b, h) ((4 + (b) * 2 + (h)) * HTB)
#define PG8_STAGE(bufoff, gbase, voff) do { _Pragma("unroll") for (int _i = 0; _i < 2; ++_i) \
        __builtin_amdgcn_global_load_lds((const unsigned*)((const char*)(gbase) + (voff)[_i]), (PG8_LAS unsigned*)(lds + (bufoff) + ldsw + _i * 8192), 16, 0, 0); } while (0)
#define PG8_LDA(dst, b, h) do { _Pragma("unroll") for (int m = 0; m < 4; ++m) _Pragma("unroll") for (int k = 0; k < 2; ++k) dst[m][k] = *(const PG8_LAS bf16x8*)(lds + PG8_SA(b, h) + aoff + m * 2048 + k * 1024); } while (0)
#define PG8_LDB(dst, b, h) do { _Pragma("unroll") for (int n = 0; n < 2; ++n) _Pragma("unroll") for (int k = 0; k < 2; ++k) dst[n][k] = *(const PG8_LAS bf16x8*)(lds + PG8_SB(b, h) + boff + n * 2048 + k * 1024); } while (0)
#define PG8_MMA(ai, bj, At, Bt) do { __builtin_amdgcn_s_setprio(1); _Pragma("unroll") for (int m = 0; m < 4; ++m) _Pragma("unroll") for (int n = 0; n < 2; ++n) _Pragma("unroll") for (int k = 0; k < 2; ++k) \
        acc[ai][bj][m][n] = __builtin_amdgcn_mfma_f32_16x16x32_bf16(Bt[n][k], At[m][k], acc[ai][bj][m][n], 0, 0, 0); __builtin_amdgcn_s_setprio(0); } while (0)
#define PG8_WAIT_V(n) asm volatile("s_waitcnt vmcnt(" #n ")" ::: "memory")
#define PG8_WAIT_L(n) asm volatile("s_waitcnt lgkmcnt(" #n ")" ::: "memory")
#define PG8_BAR __builtin_amdgcn_s_barrier()
#define PG8_SCHED __builtin_amdgcn_sched_barrier(0)
    Unit cur, nxt; int ui = 0;
    if (!S.next(0, cur)) return;
    f32x4 acc[2][2][4][2];
#pragma unroll
    for (int a = 0; a < 2; ++a)
#pragma unroll
        for (int b = 0; b < 2; ++b)
#pragma unroll
            for (int m = 0; m < 4; ++m)
#pragma unroll
                for (int n = 0; n < 2; ++n) acc[a][b][m][n] = (f32x4){0.f, 0.f, 0.f, 0.f};
    bf16x8 At[4][2], B0[2][2], B1[2][2];
    const char* cA = (const char*)g.A + (size_t)cur.pm * tstep; const char* cB = (const char*)g.Bt + (size_t)cur.pn * tstep;
    S.a_ready(cur);
    if constexpr (SP2) {
        PG8_STAGE(PG8_SB(0, 0), cB, voffB); PG8_STAGE(PG8_SB(0, 1), cB + hstep, voffB); PG8_STAGE(PG8_SA(0, 0), cA, voffA); PG8_STAGE(PG8_SA(0, 1), cA + hstep, voffA);
        if (wr == 1) PG8_BAR;
        PG8_WAIT_V(2); PG8_BAR;
        PG8_STAGE(PG8_SB(1, 0), cB + kstep, voffB); PG8_STAGE(PG8_SA(1, 0), cA + kstep, voffA); PG8_STAGE(PG8_SB(1, 1), cB + hstep + kstep, voffB);
        PG8_WAIT_V(6); PG8_BAR;
    } else {
        PG8_STAGE(PG8_SB(0, 0), cB, voffB); PG8_STAGE(PG8_SA(0, 0), cA, voffA); PG8_STAGE(PG8_SB(0, 1), cB + hstep, voffB); PG8_STAGE(PG8_SA(0, 1), cA + hstep, voffA);
        if (wr == 1) PG8_BAR;
        PG8_WAIT_V(4); PG8_BAR;
        PG8_STAGE(PG8_SB(1, 0), cB + kstep, voffB); PG8_STAGE(PG8_SA(1, 0), cA + kstep, voffA); PG8_STAGE(PG8_SB(1, 1), cB + hstep + kstep, voffB);
        PG8_WAIT_V(6); PG8_BAR;
    }
    for (;;) {
        const bool has_next = S.next(ui + 1, nxt);
        const char* nA = has_next ? (const char*)g.A + (size_t)nxt.pm * tstep : cA; const char* nB = has_next ? (const char*)g.Bt + (size_t)nxt.pn * tstep : cB;
        for (int t = 0; t < nt; t += 2) {
            const bool last = (t == nt - 2);
            const char* a1 = cA + (size_t)(t + 1) * kstep;
            const char* a2 = last ? nA : cA + (size_t)(t + 2) * kstep; const char* b2 = last ? nB : cB + (size_t)(t + 2) * kstep;
            const char* a3 = a2 + kstep; const char* b3 = b2 + kstep;
            if (last && has_next) S.a_ready(nxt);
            if constexpr (SP2) {
            PG8_LDB(B0, 0, 0); PG8_LDB(B1, 0, 1); PG8_SCHED; PG8_LDA(At, 0, 0); PG8_STAGE(PG8_SA(1, 1), a1 + hstep, voffA);
            PG8_WAIT_V(8); PG8_WAIT_L(0); PG8_BAR; PG8_MMA(0, 0, At, B0); PG8_MMA(0, 1, At, B1); PG8_BAR; PG8_SCHED;
            PG8_LDA(At, 0, 1); PG8_STAGE(PG8_SB(0, 0), b2, voffB); PG8_STAGE(PG8_SB(0, 1), b2 + hstep, voffB); PG8_STAGE(PG8_SA(0, 0), a2, voffA);
            PG8_WAIT_V(8); PG8_WAIT_L(0); PG8_BAR; PG8_MMA(1, 0, At, B0); PG8_MMA(1, 1, At, B1); PG8_BAR; PG8_SCHED;
            PG8_LDB(B0, 1, 0); PG8_LDB(B1, 1, 1); PG8_SCHED; PG8_LDA(At, 1, 0); PG8_STAGE(PG8_SA(0, 1), a2 + hstep, voffA);
            PG8_WAIT_V(8); PG8_WAIT_L(0); PG8_BAR; PG8_MMA(0, 0, At, B0); PG8_MMA(0, 1, At, B1); PG8_BAR; PG8_SCHED;
            PG8_LDA(At, 1, 1); PG8_STAGE(PG8_SB(1, 0), b3, voffB); PG8_STAGE(PG8_SB(1, 1), b3 + hstep, voffB); PG8_STAGE(PG8_SA(1, 0), a3, voffA);
            PG8_WAIT_V(8); PG8_WAIT_L(0); PG8_BAR; PG8_MMA(1, 0, At, B0); PG8_MMA(1, 1, At, B1); PG8_BAR; PG8_SCHED;
            } else {
            PG8_LDB(B0, 0, 0); PG8_SCHED; PG8_LDA(At, 0, 0); PG8_STAGE(PG8_SA(1, 1), a1 + hstep, voffA);
            PG8_WAIT_L(8); PG8_BAR; PG8_WAIT_L(0); PG8_MMA(0, 0, At, B0); PG8_BAR; PG8_SCHED;
            PG8_LDB(B1, 0, 1); PG8_STAGE(PG8_SB(0, 0), b2, voffB);
            PG8_BAR; PG8_WAIT_L(0); PG8_MMA(0, 1, At, B1); PG8_BAR;
            PG8_LDA(At, 0, 1); PG8_STAGE(PG8_SA(0, 0), a2, voffA);
            PG8_BAR; PG8_WAIT_L(0); PG8_MMA(1, 0, At, B0); PG8_BAR; PG8_SCHED;
            PG8_STAGE(PG8_SB(0, 1), b2 + hstep, voffB);
            PG8_WAIT_V(6); PG8_BAR; PG8_MMA(1, 1, At, B1); PG8_BAR;
            PG8_LDB(B0, 1, 0); PG8_SCHED; PG8_LDA(At, 1, 0); PG8_STAGE(PG8_SA(0, 1), a2 + hstep, voffA);
            PG8_WAIT_L(8); PG8_BAR; PG8_WAIT_L(0); PG8_MMA(0, 0, At, B0); PG8_BAR; PG8_SCHED;
            PG8_LDB(B1, 1, 1); PG8_STAGE(PG8_SB(1, 0), b3, voffB);
            PG8_BAR; PG8_WAIT_L(0); PG8_MMA(0, 1, At, B1); PG8_BAR;
            PG8_LDA(At, 1, 1); PG8_STAGE(PG8_SA(1, 0), a3, voffA);
            PG8_BAR; PG8_WAIT_L(0); PG8_MMA(1, 0, At, B0); PG8_BAR; PG8_SCHED;
            PG8_STAGE(PG8_SB(1, 1), b3 + hstep, voffB);
            PG8_WAIT_V(6); PG8_BAR; PG8_MMA(1, 1, At, B1); PG8_BAR;
            }
        }
        if constexpr (ALIGN_EPI) { if (wr == 0) PG8_BAR; }
        if constexpr (!Epi::AFTER_DRAIN) { E(acc, cur, wr, wc, fr, fq); S.done(cur); }
        if (!has_next) break;
#pragma unroll
        for (int a = 0; a < 2; ++a)
#pragma unroll
            for (int b = 0; b < 2; ++b)
#pragma unroll
                for (int m = 0; m < 4; ++m)
#pragma unroll
                    for (int n = 0; n < 2; ++n) acc[a][b][m][n] = (f32x4){0.f, 0.f, 0.f, 0.f};
        cur = nxt; cA = nA; cB = nB; ++ui;
        if constexpr (ALIGN_EPI) { if (wr == 1) PG8_BAR; }
    }
    PG8_WAIT_V(0);
    if constexpr (!ALIGN_EPI) { if (wr == 0) PG8_BAR; }
    PG8_BAR;
    if constexpr (Epi::AFTER_DRAIN) { E.fused(acc, cur, wr, wc, fr, fq, lds, wid, lane); S.done(cur); }
#undef PG8_SA
#undef PG8_SB
#undef PG8_STAGE
#undef PG8_LDA
#undef PG8_LDB
#undef PG8_MMA
#undef PG8_WAIT_V
#undef PG8_WAIT_L
#undef PG8_BAR
#undef PG8_SCHED
}
}
#ifndef PG8_SP2
#define PG8_SP2 true
#endif
#ifndef PG8_ALIGN
#define PG8_ALIGN true
#endif
#define LAS __attribute__((address_space(3)))
typedef unsigned short bf16;
typedef unsigned v4u __attribute__((ext_vector_type(4)));
typedef unsigned v2u __attribute__((ext_vector_type(2)));
typedef float f32x4 __attribute__((ext_vector_type(4)));
typedef float f32x2 __attribute__((ext_vector_type(2)));
typedef short bf16x8 __attribute__((ext_vector_type(8)));
#define LDS_WAIT() asm volatile("s_waitcnt lgkmcnt(0)" ::: "memory")

constexpr int NWAVES = 8, NTHR = 512;
constexpr int M = 16384, D = 1024, DIN = 3072, DPLE = 256, DC = 512, SEQ = 8192, CHUNK = 128, NHEAD = 8, CW = 31;
constexpr float LN_EPS = 1e-5f, ALPHA = 1.189207115002721f;
constexpr size_t MiB = 1u << 20;
constexpr size_t WS_CP1 = 0, WS_CP2 = 64 * 1024, WS_STATSP = 128 * 1024;
constexpr size_t WS_WSB = 1 * MiB;
constexpr size_t WS_WIN = 2 * MiB, WS_WOUT = 8 * MiB, WS_WG = 10 * MiB, WS_WPLE = 12 * MiB;
constexpr size_t WS_H = 16 * MiB, WS_PB = 48 * MiB, WS_PE = 56 * MiB, WS_Y = 88 * MiB, WS_RB = 120 * MiB;
constexpr size_t WS_AB = 152 * MiB, WS_SZ = 168 * MiB, WS_UG = 184 * MiB, WS_GV = 200 * MiB;
constexpr size_t WS_R = 152 * MiB;
constexpr size_t WS_END = 216 * MiB;
constexpr int LDS_BYTES = 147456;

__device__ __forceinline__ unsigned f2bf(float f) { unsigned u = __builtin_bit_cast(unsigned, f); return (u + 0x7fffu + ((u >> 16) & 1u)) >> 16; }
__device__ __forceinline__ unsigned pk2(float lo, float hi) { return f2bf(lo) | (f2bf(hi) << 16); }
__device__ __forceinline__ float bf_lo(unsigned u) { return __uint_as_float(u << 16); }
__device__ __forceinline__ float bf_hi(unsigned u) { return __uint_as_float(u & 0xffff0000u); }
__device__ __forceinline__ float wave_sum(float v) {
#pragma unroll
    for (int o = 1; o < 64; o <<= 1) v += __shfl_xor(v, o);
    return v;
}
__device__ __forceinline__ float sigm_f(float x) { return __builtin_amdgcn_rcpf(1.0f + __builtin_amdgcn_exp2f(-1.44269504089f * x)); }

struct Args { const float* in[19]; float* out; unsigned char* ws; };

__device__ __forceinline__ int win_map(int n) {
    const int seg = n >> 9, o = n & 511, blk = o >> 7, w = o & 127;
    if (seg == 0) return 256 * blk + w;
    if (seg == 1) return 256 * blk + 128 + w;
    if (seg == 2) return 1024 + o;
    if (seg == 3) return 1536 + 256 * blk + w;
    if (seg == 5) return 1536 + 256 * blk + 128 + w;
    return 2560 + o;
}
template <bool GATE>
__device__ __forceinline__ void tr_item(const float* W, int K, int N, bf16* WT, int drow, LAS float* scr, int k0, int n0, int lane, const float* g, const float* b, float* cp1, float* cp2) {
#pragma unroll 8
    for (int i = 0; i < 32; ++i) { const int kk = 2 * i + (lane >> 5); scr[kk * 33 + (lane & 31)] = W[(size_t)(k0 + kk) * N + n0 + (lane & 31)]; }
    LDS_WAIT(); asm volatile("" ::: "memory");
    const int c = lane & 7;
    float gs[8];
#pragma unroll
    for (int e = 0; e < 8; ++e) gs[e] = GATE ? g[k0 + 8 * c + e] : 1.0f;
#pragma unroll
    for (int j = 0; j < 4; ++j) { const int n = (lane >> 3) + 8 * j; const LAS float* s = scr + (8 * c) * 33 + n;
        v4u o; o.x = pk2(s[0 * 33] * gs[0], s[1 * 33] * gs[1]); o.y = pk2(s[2 * 33] * gs[2], s[3 * 33] * gs[3]); o.z = pk2(s[4 * 33] * gs[4], s[5 * 33] * gs[5]); o.w = pk2(s[6 * 33] * gs[6], s[7 * 33] * gs[7]);
        *(v4u*)(WT + (size_t)(drow + n) * K + k0 + 8 * c) = o; }
    if (GATE) { const int n = lane & 31, half = lane >> 5; float s1 = 0.f, s2 = 0.f;
#pragma unroll 8
        for (int kk = 0; kk < 32; ++kk) { const int k = 32 * half + kk; const float w = scr[k * 33 + n]; s1 += g[k0 + k] * w; s2 += b[k0 + k] * w; }
        s1 += __shfl_xor(s1, 32); s2 += __shfl_xor(s2, 32);
        if (lane < 32) { cp1[(k0 >> 6) * N + n0 + n] = s1; cp2[(k0 >> 6) * N + n0 + n] = s2; } }
    LDS_WAIT(); asm volatile("" ::: "memory");
}

__device__ __forceinline__ void p0_prologue(const Args& a, LAS unsigned char* lds, int wave, int lane) {
    unsigned char* ws = a.ws;
    LAS float* scr = (LAS float*)(lds + wave * 16384);
    const int gw = blockIdx.x * NWAVES + wave, NGW = gridDim.x * NWAVES;
    constexpr int I_IN = (D / 64) * (DIN / 32), I_OUT = (D / 64) * (D / 32), I_G = I_OUT, I_PLE = (DPLE / 64) * (D / 32);
    constexpr int NITEMS = I_IN + I_OUT + I_G + I_PLE;
    for (int it = gw; it < NITEMS; it += NGW) {
        int r = it;
        if (r < I_IN) { const int nblk = DIN / 32, kb = r / nblk, nb = r % nblk; tr_item<false>(a.in[4], D, DIN, (bf16*)(ws + WS_WIN), win_map(32 * nb), scr, 64 * kb, 32 * nb, lane, nullptr, nullptr, nullptr, nullptr); continue; } r -= I_IN;
        if (r < I_OUT) { const int nblk = D / 32, kb = r / nblk, nb = r % nblk; tr_item<false>(a.in[13], D, D, (bf16*)(ws + WS_WOUT), 32 * nb, scr, 64 * kb, 32 * nb, lane, nullptr, nullptr, nullptr, nullptr); continue; } r -= I_OUT;
        if (r < I_G) { const int nblk = D / 32, kb = r / nblk, nb = r % nblk; tr_item<true>(a.in[17], D, D, (bf16*)(ws + WS_WG), 32 * nb, scr, 64 * kb, 32 * nb, lane, a.in[14], a.in[15], (float*)(ws + WS_CP1), (float*)(ws + WS_CP2)); continue; } r -= I_G;
        { const int nblk = D / 32, kb = r / nblk, nb = r % nblk; tr_item<false>(a.in[16], DPLE, D, (bf16*)(ws + WS_WPLE), 32 * nb, scr, 64 * kb, 32 * nb, lane, nullptr, nullptr, nullptr, nullptr); }
    }
    {
        const float* x = a.in[0]; bf16* H = (bf16*)(ws + WS_H);
        f32x4 gg[4], bb[4];
#pragma unroll
        for (int j = 0; j < 4; ++j) { gg[j] = *(const f32x4*)(a.in[2] + 4 * lane + 256 * j); bb[j] = *(const f32x4*)(a.in[3] + 4 * lane + 256 * j); }
        for (int m = gw; m < M; m += NGW) {
            const f32x4* xr = (const f32x4*)(x + (size_t)m * D) + lane;
            f32x4 v[4]; float s = 0.f;
#pragma unroll
            for (int j = 0; j < 4; ++j) { v[j] = xr[64 * j]; s += (v[j][0] + v[j][1]) + (v[j][2] + v[j][3]); }
            const float mean = wave_sum(s) * (1.f / D); float s2 = 0.f;
#pragma unroll
            for (int j = 0; j < 4; ++j) { v[j] = v[j] - mean; s2 += (v[j][0] * v[j][0] + v[j][1] * v[j][1]) + (v[j][2] * v[j][2] + v[j][3] * v[j][3]); }
            const float rstd = 1.f / sqrtf(wave_sum(s2) * (1.f / D) + LN_EPS);
            v2u* o8 = (v2u*)(H + (size_t)m * D) + lane;
#pragma unroll
            for (int j = 0; j < 4; ++j) { const f32x4 y = v[j] * rstd * gg[j] + bb[j]; o8[64 * j] = (v2u){pk2(y[0], y[1]), pk2(y[2], y[3])}; }
        }
    }
    {
        const float* p = a.in[1]; bf16* Pb = (bf16*)(ws + WS_PB);
        const int gt = blockIdx.x * NTHR + threadIdx.x, NGT = gridDim.x * NTHR;
        for (int i = gt; i < M * DPLE / 8; i += NGT) { const f32x4 a0 = *(const f32x4*)(p + (size_t)i * 8), a1 = *(const f32x4*)(p + (size_t)i * 8 + 4);
            *(v4u*)(Pb + (size_t)i * 8) = (v4u){pk2(a0[0], a0[1]), pk2(a0[2], a0[3]), pk2(a1[0], a1[1]), pk2(a1[2], a1[3])}; }
        const float* wsrc = a.in[11]; bf16* Wsb = (bf16*)(ws + WS_WSB);
        for (int i = gt; i < NHEAD * CHUNK * CHUNK / 8; i += NGT) { const int t = (i >> 4) & 127, s0 = (i & 15) * 8;
            const f32x4 a0 = *(const f32x4*)(wsrc + (size_t)i * 8), a1 = *(const f32x4*)(wsrc + (size_t)i * 8 + 4);
            float e[8] = {a0[0], a0[1], a0[2], a0[3], a1[0], a1[1], a1[2], a1[3]};
#pragma unroll
            for (int k = 0; k < 8; ++k) e[k] = (s0 + k <= t) ? e[k] : 0.f;
            *(v4u*)(Wsb + (size_t)i * 8) = (v4u){pk2(e[0], e[1]), pk2(e[2], e[3]), pk2(e[4], e[5]), pk2(e[6], e[7])}; }
    }
}

__device__ __forceinline__ void conv_item(LAS unsigned char* lds, int it, const bf16* Ab, const bf16* SZ, bf16* Y, const f32x2 (&w)[CW], f32x2 cb,
                                          const float* lng, const float* lnb, int tid, int wave, int lane) {
    const int m0 = it * 32, t0 = m0 & (SEQ - 1);
    LAS unsigned char* in = lds; LAS float* outt = (LAS float*)(lds + 65536);
    for (int q = tid; q < 62 * 64; q += NTHR) { const int row = q >> 6, c16 = q & 63; v4u v = (v4u){0u, 0u, 0u, 0u};
        if (t0 - 30 + row >= 0) v = *(const v4u*)(Ab + (size_t)(m0 - 30 + row) * DC + c16 * 8);
        *(LAS v4u*)(in + row * 1024 + c16 * 16) = v; }
    __syncthreads();
    const int cp = tid & 255, rh = tid >> 8;
    f32x2 acc[16];
#pragma unroll
    for (int t = 0; t < 16; ++t) acc[t] = (f32x2){0.f, 0.f};
#pragma unroll
    for (int j = 0; j < 46; ++j) { const unsigned d = *(const LAS unsigned*)(in + (16 * rh + j) * 1024 + cp * 4); const f32x2 v = (f32x2){bf_lo(d), bf_hi(d)};
#pragma unroll
        for (int k = 0; k < CW; ++k) { const int t = j - k; if (t >= 0 && t < 16) acc[t] += w[k] * v; } }
#pragma unroll
    for (int t = 0; t < 16; ++t) *(LAS f32x2*)(outt + (16 * rh + t) * DC + 2 * cp) = acc[t] + cb;
    __syncthreads();
#pragma unroll
    for (int rr = 0; rr < 4; ++rr) { const int row = 4 * wave + rr; const size_t m = (size_t)(m0 + row);
        f32x4 v[2]; float s = 0.f;
#pragma unroll
        for (int j = 0; j < 2; ++j) { v[j] = *(const LAS f32x4*)(outt + row * DC + 4 * lane + 256 * j); s += (v[j][0] + v[j][1]) + (v[j][2] + v[j][3]); }
        const float mean = wave_sum(s) * (1.f / DC); float s2 = 0.f;
#pragma unroll
        for (int j = 0; j < 2; ++j) { v[j] = v[j] - mean; s2 += (v[j][0] * v[j][0] + v[j][1] * v[j][1]) + (v[j][2] * v[j][2] + v[j][3] * v[j][3]); }
        const float rstd = 1.f / sqrtf(wave_sum(s2) * (1.f / DC) + LN_EPS);
#pragma unroll
        for (int j = 0; j < 2; ++j) { const int c = 4 * lane + 256 * j; const f32x4 gg = *(const f32x4*)(lng + c), bb = *(const f32x4*)(lnb + c);
            const v2u zz = *(const v2u*)(SZ + m * DC + c);
            f32x4 y = v[j] * rstd * gg + bb;
            y = (f32x4){y[0] * sigm_f(y[0]), y[1] * sigm_f(y[1]), y[2] * sigm_f(y[2]), y[3] * sigm_f(y[3])};
            y = y * (f32x4){bf_lo(zz.x), bf_hi(zz.x), bf_lo(zz.y), bf_hi(zz.y)};
            *(v2u*)(Y + m * D + c) = (v2u){pk2(y[0], y[1]), pk2(y[2], y[3])}; } }
    __syncthreads();
}

__device__ __forceinline__ void sgu_item(LAS unsigned char* lds, int it, const bf16* GV, const bf16* UG, const bf16* Wsb, const float* bs, const float* lng, const float* lnb, bf16* Y,
                                         int tid, int wave, int lane) {
    constexpr int RS = 516;
    const int c = it >> 1, hh = it & 1, m0 = c * CHUNK;
    {
        const f32x4 g0 = *(const f32x4*)(lng + 8 * lane), g1 = *(const f32x4*)(lng + 8 * lane + 4), b0 = *(const f32x4*)(lnb + 8 * lane), b1 = *(const f32x4*)(lnb + 8 * lane + 4);
        v4u raw[16];
#pragma unroll
        for (int i = 0; i < 16; ++i) raw[i] = *(const v4u*)(GV + (size_t)(m0 + 16 * wave + i) * DC + 8 * lane);
#pragma unroll
        for (int i = 0; i < 16; ++i) {
            f32x4 x0 = (f32x4){bf_lo(raw[i].x), bf_hi(raw[i].x), bf_lo(raw[i].y), bf_hi(raw[i].y)}, x1 = (f32x4){bf_lo(raw[i].z), bf_hi(raw[i].z), bf_lo(raw[i].w), bf_hi(raw[i].w)};
            const float s = (x0[0] + x0[1]) + (x0[2] + x0[3]) + (x1[0] + x1[1]) + (x1[2] + x1[3]);
            const float mean = wave_sum(s) * (1.f / DC);
            x0 = x0 - mean; x1 = x1 - mean;
            const float q = (x0[0] * x0[0] + x0[1] * x0[1]) + (x0[2] * x0[2] + x0[3] * x0[3]) + (x1[0] * x1[0] + x1[1] * x1[1]) + (x1[2] * x1[2] + x1[3] * x1[3]);
            const float rstd = 1.f / sqrtf(wave_sum(q) * (1.f / DC) + LN_EPS);
            x0 = x0 * rstd * g0 + b0; x1 = x1 * rstd * g1 + b1;
            if ((lane >> 5) == hh) { LAS unsigned* dst = (LAS unsigned*)(lds + (16 * wave + i) * RS + (lane & 31) * 16);
                dst[0] = pk2(x0[0], x0[1]); dst[1] = pk2(x0[2], x0[3]); dst[2] = pk2(x1[0], x1[1]); dst[3] = pk2(x1[2], x1[3]); }
        }
    }
    __syncthreads();
    {
        const int hl = wave >> 1, dh = wave & 1, h = 4 * hh + hl, dbase = hl * 64 + dh * 32, fr = lane & 15, q = lane >> 4;
        bf16x8 vf[2][4];
#pragma unroll
        for (int nb = 0; nb < 2; ++nb)
#pragma unroll
            for (int ks = 0; ks < 4; ++ks)
#pragma unroll
                for (int jj = 0; jj < 8; ++jj) vf[nb][ks][jj] = (short)*(const LAS unsigned short*)(lds + (32 * ks + 8 * q + jj) * RS + 2 * (dbase + 16 * nb + fr));
        f32x4 acc[8][2];
#pragma unroll
        for (int tb = 0; tb < 8; ++tb) { acc[tb][0] = (f32x4){0.f, 0.f, 0.f, 0.f}; acc[tb][1] = (f32x4){0.f, 0.f, 0.f, 0.f}; }
#pragma unroll
        for (int tb = 0; tb < 8; ++tb)
#pragma unroll
            for (int ks = 0; ks < 4; ++ks) if (ks <= (tb >> 1)) {
                const bf16x8 wf = *(const bf16x8*)(Wsb + ((size_t)(h * CHUNK + 16 * tb + fr)) * CHUNK + 32 * ks + 8 * q);
                acc[tb][0] = __builtin_amdgcn_mfma_f32_16x16x32_bf16(vf[0][ks], wf, acc[tb][0], 0, 0, 0);
                acc[tb][1] = __builtin_amdgcn_mfma_f32_16x16x32_bf16(vf[1][ks], wf, acc[tb][1], 0, 0, 0); }
#pragma unroll
        for (int tb = 0; tb < 8; ++tb) { const int t = 16 * tb + fr; const float bias = bs[h * CHUNK + t]; const size_t m = (size_t)(m0 + t);
#pragma unroll
            for (int nb = 0; nb < 2; ++nb) { const int col = 256 * hh + dbase + 16 * nb + 4 * q;
                const v2u ug = *(const v2u*)(UG + m * DC + col);
                const f32x4 o = (acc[tb][nb] + bias) * (f32x4){bf_lo(ug.x), bf_hi(ug.x), bf_lo(ug.y), bf_hi(ug.y)};
                *(v2u*)(Y + m * D + DC + col) = (v2u){pk2(o[0], o[1]), pk2(o[2], o[3])}; } }
    }
    __syncthreads();
}

__device__ __forceinline__ void p2_mixer(const Args& a, LAS unsigned char* lds, int tid, int wave, int lane) {
    unsigned char* ws = a.ws;
    const bf16* Ab = (const bf16*)(ws + WS_AB); const bf16* SZ = (const bf16*)(ws + WS_SZ); const bf16* UG = (const bf16*)(ws + WS_UG); const bf16* GV = (const bf16*)(ws + WS_GV);
    bf16* Y = (bf16*)(ws + WS_Y);
    for (int it = blockIdx.x; it < M / CHUNK * 2; it += gridDim.x)
        sgu_item(lds, it, GV, UG, (const bf16*)(ws + WS_WSB), a.in[12], a.in[9], a.in[10], Y, tid, wave, lane);
    {
        const int cp = tid & 255;
        f32x2 w[CW];
#pragma unroll
        for (int k = 0; k < CW; ++k) w[k] = *(const f32x2*)(a.in[5] + k * DC + 2 * cp);
        const f32x2 cb = *(const f32x2*)(a.in[6] + 2 * cp);
        for (int it = blockIdx.x; it < M / 32; it += gridDim.x)
            conv_item(lds, it, Ab, SZ, Y, w, cb, a.in[7], a.in[8], tid, wave, lane);
    }
}

__global__ void __launch_bounds__(NTHR, 2) fwd_megakernel(Args a) {
    extern __shared__ __attribute__((aligned(16))) unsigned char lds_raw[];
    LAS unsigned char* lds = (LAS unsigned char*)lds_raw;
    cg::grid_group grid = cg::this_grid();
#define FRESH_IDS int tid = threadIdx.x; asm volatile("" : "+v"(tid)); const int lane = tid & 63, wave = __builtin_amdgcn_readfirstlane(tid >> 6); (void)lane; (void)wave;
    unsigned char* ws = a.ws;
    const int G = gridDim.x;

#ifndef NO_P0
    { FRESH_IDS p0_prologue(a, lds, wave, lane); }
#endif
    grid.sync();

#ifndef NO_P1
#ifndef NO_PE
    {
        pg8::Gemm g{(const bf16*)(ws + WS_PB), (const bf16*)(ws + WS_WPLE), M, D, DPLE}; pg8::StaticOrder S; S.init(M, D, G, (int)blockIdx.x);
        pg8::EpiBf16<0> E{(bf16*)(ws + WS_PE), D, nullptr, 0, 0, 1.f};
        pg8::gemm_phase<pg8::EpiBf16<0>, pg8::StaticOrder, PG8_ALIGN, PG8_SP2>(lds, g, S, E);
    }
#endif
#ifndef NO_IN
    {
        pg8::Gemm g{(const bf16*)(ws + WS_H), (const bf16*)(ws + WS_WIN), M, DIN, D}; pg8::StaticOrder S; S.init(M, DIN, G, (int)blockIdx.x);
        pg8::EpiP1 E{(bf16*)(ws + WS_AB), (bf16*)(ws + WS_SZ), (bf16*)(ws + WS_UG), (bf16*)(ws + WS_GV)};
        pg8::gemm_phase<pg8::EpiP1, pg8::StaticOrder, PG8_ALIGN, PG8_SP2>(lds, g, S, E);
    }
#endif
#endif
    grid.sync();

#ifndef NO_P2
    { FRESH_IDS p2_mixer(a, lds, tid, wave, lane); }
#endif
    grid.sync();

#ifndef NO_P3
    {
        pg8::Gemm g{(const bf16*)(ws + WS_Y), (const bf16*)(ws + WS_WOUT), M, D, D}; pg8::StaticOrder S; S.init(M, D, G, (int)blockIdx.x);
        pg8::EpiP3 E{(const bf16*)(ws + WS_H), (float*)(ws + WS_R), (bf16*)(ws + WS_RB), (float*)(ws + WS_STATSP), ALPHA};
        pg8::gemm_phase<pg8::EpiP3, pg8::StaticOrder, false, PG8_SP2>(lds, g, S, E);
    }
#endif
    grid.sync();

#ifndef NO_P4
    {
        pg8::Gemm g{(const bf16*)(ws + WS_RB), (const bf16*)(ws + WS_WG), M, D, D}; pg8::StaticOrder S; S.init(M, D, G, (int)blockIdx.x);
        pg8::EpiP4 E{(const float*)(ws + WS_R), (const bf16*)(ws + WS_PE), (const float*)(ws + WS_STATSP), (const float*)(ws + WS_CP1), (const float*)(ws + WS_CP2), a.in[18], a.in[14], a.in[15], a.out, LN_EPS};
        pg8::gemm_phase<pg8::EpiP4, pg8::StaticOrder, false, PG8_SP2>(lds, g, S, E);
    }
#endif
}

extern "C" void kernel_launch(void* const* d_in, const int* in_sizes, int n_in, void* d_out, int out_size, void* d_ws, size_t ws_size, hipStream_t stream) {
    static int grid = 0;
    if (grid == 0) {
        if (n_in != 19 || in_sizes[0] != M * D || out_size != M * D || ws_size < WS_END) { fprintf(stderr, "kernel_launch: unexpected shapes (n_in %d, in0 %d, out %d, ws %zu)\n", n_in, n_in > 0 ? in_sizes[0] : -1, out_size, ws_size); grid = -1; return; }
        int dev = 0, cus = 0, per_cu = 0;
        if (hipGetDevice(&dev) != hipSuccess || hipDeviceGetAttribute(&cus, hipDeviceAttributeMultiprocessorCount, dev) != hipSuccess) { fprintf(stderr, "kernel_launch: device query failed\n"); grid = -1; return; }
        if (hipFuncSetAttribute((const void*)fwd_megakernel, hipFuncAttributeMaxDynamicSharedMemorySize, LDS_BYTES) != hipSuccess) { fprintf(stderr, "kernel_launch: hipFuncSetAttribute failed\n"); grid = -1; return; }
        if (hipOccupancyMaxActiveBlocksPerMultiprocessor(&per_cu, (const void*)fwd_megakernel, NTHR, LDS_BYTES) != hipSuccess || per_cu < 1) { fprintf(stderr, "kernel_launch: occupancy query says %d\n", per_cu); per_cu = 1; }
        (void)hipGetLastError();
        grid = cus * 1;
    }
    if (grid < 0) return;
    Args a{};
    for (int i = 0; i < 19; ++i) a.in[i] = (const float*)d_in[i];
    a.out = (float*)d_out; a.ws = (unsigned char*)d_ws;
    void* args[] = {&a};
    hipError_t e = hipLaunchCooperativeKernel((const void*)fwd_megakernel, dim3(grid), dim3(NTHR), args, LDS_BYTES, stream);
    if (e != hipSuccess) fprintf(stderr, "kernel_launch: cooperative launch failed: %s (grid %d)\n", hipGetErrorString(e), grid);
}
```

```cpp
#include <hip/hip_runtime.h>
#include <hip/hip_cooperative_groups.h>
#include <cstdio>
#include <cstdint>
namespace cg = cooperative_groups;
namespace pg8 {
#define PG8_LAS __attribute__((address_space(3)))
typedef unsigned short bf16_t;
typedef short bf16x8 __attribute__((ext_vector_type(8)));
typedef float f32x4 __attribute__((ext_vector_type(4)));
typedef unsigned u32x4 __attribute__((ext_vector_type(4)));
constexpr int BM = 256, BK = 64, HALF = 128, HTB = HALF * BK * 2  , STAGE_BYTES = 8 * HTB, NXCD = 8, WGM = 8;

__host__ __device__ __forceinline__ int lds_byte(int r, int c) { const int st = (r >> 4) * 2 + (c >> 5), rr = r & 15, cc = c & 31, ob = rr * 64 + cc * 2; return st * 1024 + (ob ^ (((ob >> 9) & 1) << 5)); }
__host__ __device__ __forceinline__ void stage_rc(int b, int& R, int& C) { const int st = b / 1024, sb = b % 1024, swz = sb ^ (((sb >> 9) & 1) << 5); R = (st >> 1) * 16 + swz / 64; C = (st & 1) * 32 + (swz % 64) / 2; }
__host__ __device__ __forceinline__ int perm32(int rho) { const int n = rho >> 4, i = rho & 15; return 8 * (i >> 2) + 4 * n + (i & 3); }

struct Unit { int pm, pn; };
struct Gemm { const bf16_t* A; const bf16_t* Bt; int M, N, K; };

struct StaticOrder {
    int nM, nN, nwg, G, c;
    __host__ __device__ void init(int M, int N, int G_, int c_) { nM = M / BM; nN = N / BM; nwg = nM * nN; G = G_; c = c_; }
    __host__ __device__ bool next(int i, Unit& u) const {
        const long L = (long)i * G + c; if (L >= nwg) return false;
        int wgid = (int)L; { const int q = nwg / NXCD, r = nwg % NXCD, xcd = wgid % NXCD, off = wgid / NXCD; wgid = (xcd < r ? xcd * (q + 1) : r * (q + 1) + (xcd - r) * q) + off; }
        const int nig = WGM * nN, gid = wgid / nig, fm = gid * WGM, gsz = (nM - fm) < WGM ? (nM - fm) : WGM;
        u.pm = fm + ((wgid % nig) % gsz); u.pn = (wgid % nig) / gsz; return true;
    }
    __device__ __forceinline__ void a_ready(const Unit&) const {}
    __device__ __forceinline__ void done(const Unit&) const {}
};

__device__ __forceinline__ unsigned cvt_pk_bf16(float lo, float hi) { unsigned r; asm volatile("v_cvt_pk_bf16_f32 %0, %1, %2" : "=v"(r) : "v"(lo), "v"(hi)); return r; }
typedef float f32x2 __attribute__((ext_vector_type(2)));
__device__ __forceinline__ f32x2 gelu_pk(f32x2 v) {
    const f32x2 av = __builtin_elementwise_abs(v), d = av * 0.2316418882f + 1.0f;
    f32x2 t; t.x = __builtin_amdgcn_rcpf(d.x); t.y = __builtin_amdgcn_rcpf(d.y);
    f32x2 q = t * 0.5307027145f + (-0.7265760135f); q = q * t + 0.7107068705f; q = q * t + (-0.142248368f); q = q * t + 0.127414796f; q = q * t;
    const f32x2 s = (v * v) * (-0.72134752044f);
    f32x2 e; e.x = __builtin_amdgcn_exp2f(s.x); e.y = __builtin_amdgcn_exp2f(s.y);
    const f32x2 m = v * (q * e), r = v - m;
    f32x2 o; o.x = v.x < 0.f ? m.x : r.x; o.y = v.y < 0.f ? m.y : r.y; return o;
}

template <int ACT  > struct EpiBf16 {
    static constexpr bool PERM = true, AFTER_DRAIN = false; static_assert(ACT == 0 || ACT == 1, "EpiBf16: ACT is 0 (none) or 1 (gelu_pk)");
    bf16_t* O; int ldc; const float* bias; int split_cols; size_t split_stride; float scale0;
    __device__ __forceinline__ void operator()(const f32x4 (&acc)[2][2][4][2], const Unit& u, int wr, int wc, int fr, int fq) const {
        const int row0 = u.pm * BM + wr * 64 + fr; int colt = u.pn * BM; bf16_t* base = O;
        float sc = 1.f; if (split_cols) { const int t = colt / split_cols; base += (size_t)t * split_stride; colt -= t * split_cols; if (t == 0) sc = scale0; }
        const int col0 = colt + wc * 32 + 8 * fq, bcol0 = u.pn * BM + wc * 32 + 8 * fq;
        f32x4 bv[2][2];
#pragma unroll
        for (int bj = 0; bj < 2; ++bj)
#pragma unroll
            for (int n = 0; n < 2; ++n) bv[bj][n] = bias ? *(const f32x4*)(bias + bcol0 + bj * HALF + 4 * n) : (f32x4){0.f, 0.f, 0.f, 0.f};
#pragma unroll
        for (int ai = 0; ai < 2; ++ai)
#pragma unroll
            for (int m = 0; m < 4; ++m) { bf16_t* rowp = base + (size_t)(row0 + ai * HALF + m * 16) * ldc + col0;
#pragma unroll
                for (int bj = 0; bj < 2; ++bj) { f32x4 v0 = acc[ai][bj][m][0] + bv[bj][0], v1 = acc[ai][bj][m][1] + bv[bj][1];
                    if (ACT == 1) { f32x2 a = gelu_pk((f32x2){v0[0], v0[1]}), b = gelu_pk((f32x2){v0[2], v0[3]}), c = gelu_pk((f32x2){v1[0], v1[1]}), d = gelu_pk((f32x2){v1[2], v1[3]});
                        v0 = (f32x4){a.x, a.y, b.x, b.y}; v1 = (f32x4){c.x, c.y, d.x, d.y}; }
                    v0 = v0 * sc; v1 = v1 * sc; u32x4 w; w.x = cvt_pk_bf16(v0[0], v0[1]); w.y = cvt_pk_bf16(v0[2], v0[3]); w.z = cvt_pk_bf16(v1[0], v1[1]); w.w = cvt_pk_bf16(v1[2], v1[3]);
                    *(u32x4*)(rowp + bj * HALF) = w; } }
    }
};
__device__ __forceinline__ float sigm(float x) { return __builtin_amdgcn_rcpf(1.0f + __builtin_amdgcn_exp2f(-1.44269504089f * x)); }
__device__ __forceinline__ f32x4 sigm4(f32x4 v) { return (f32x4){sigm(v[0]), sigm(v[1]), sigm(v[2]), sigm(v[3])}; }
__device__ __forceinline__ f32x4 gelu4(f32x4 v) { const f32x2 a = gelu_pk((f32x2){v[0], v[1]}), b = gelu_pk((f32x2){v[2], v[3]}); return (f32x4){a.x, a.y, b.x, b.y}; }
__device__ __forceinline__ u32x4 pack8(f32x4 v0, f32x4 v1) { u32x4 w; w.x = cvt_pk_bf16(v0[0], v0[1]); w.y = cvt_pk_bf16(v0[2], v0[3]); w.z = cvt_pk_bf16(v1[0], v1[1]); w.w = cvt_pk_bf16(v1[2], v1[3]); return w; }
__device__ __forceinline__ f32x4 unpk_lo(u32x4 w) { return (f32x4){__uint_as_float(w.x << 16), __uint_as_float(w.x & 0xffff0000u), __uint_as_float(w.y << 16), __uint_as_float(w.y & 0xffff0000u)}; }
__device__ __forceinline__ f32x4 unpk_hi(u32x4 w) { return (f32x4){__uint_as_float(w.z << 16), __uint_as_float(w.z & 0xffff0000u), __uint_as_float(w.w << 16), __uint_as_float(w.w & 0xffff0000u)}; }

struct EpiP1 {
    static constexpr bool PERM = true, AFTER_DRAIN = false;
    bf16_t *Ab, *SZ, *UG, *GV;
    __device__ __forceinline__ void operator()(const f32x4 (&acc)[2][2][4][2], const Unit& u, int wr, int wc, int fr, int fq) const {
        const int row0 = u.pm * BM + wr * 64 + fr, pn = u.pn, cl = wc * 32 + 8 * fq;
        if (pn < 4 || (pn >= 6 && pn < 10)) {
            const bool glu = pn < 4; bf16_t* base = glu ? Ab : UG; const int colt = 128 * (glu ? pn : pn - 6) + cl;
#pragma unroll
            for (int ai = 0; ai < 2; ++ai)
#pragma unroll
                for (int m = 0; m < 4; ++m) { bf16_t* rowp = base + (size_t)(row0 + ai * HALF + m * 16) * 512 + colt;
                    const f32x4 v0 = acc[ai][0][m][0], v1 = acc[ai][0][m][1], g0 = acc[ai][1][m][0], g1 = acc[ai][1][m][1];
                    f32x4 o0, o1;
                    if (glu) { o0 = v0 * sigm4(g0); o1 = v1 * sigm4(g1); }
                    else { o0 = gelu4(v0) * (g0 * sigm4(g0)); o1 = gelu4(v1) * (g1 * sigm4(g1)); }
                    *(u32x4*)rowp = pack8(o0, o1); }
        } else {
            const bool sil = pn < 6; bf16_t* base = sil ? SZ : GV; const int colt = 256 * (sil ? pn - 4 : pn - 10) + cl;
#pragma unroll
            for (int ai = 0; ai < 2; ++ai)
#pragma unroll
                for (int m = 0; m < 4; ++m) { bf16_t* rowp = base + (size_t)(row0 + ai * HALF + m * 16) * 512 + colt;
#pragma unroll
                    for (int bj = 0; bj < 2; ++bj) { const f32x4 v0 = acc[ai][bj][m][0], v1 = acc[ai][bj][m][1]; f32x4 o0, o1;
                        if (sil) { o0 = v0 * sigm4(v0); o1 = v1 * sigm4(v1); } else { o0 = gelu4(v0); o1 = gelu4(v1); }
                        *(u32x4*)(rowp + bj * HALF) = pack8(o0, o1); } }
        }
    }
};

struct EpiP3 {
    static constexpr bool PERM = true, AFTER_DRAIN = true;
    const bf16_t* H; float* R; bf16_t* RB; float* statsP; float alpha;
    __device__ __forceinline__ void fused(f32x4 (&acc)[2][2][4][2], const Unit& u, int wr, int wc, int fr, int fq, PG8_LAS unsigned char* lds, int wid, int lane) const {
        PG8_LAS f32x2* P = (PG8_LAS f32x2*)lds;
        const int col0 = u.pn * BM + wc * 32 + 8 * fq;
#pragma unroll
        for (int ai = 0; ai < 2; ++ai)
#pragma unroll
            for (int m = 0; m < 4; ++m) { const int r = ai * HALF + wr * 64 + m * 16 + fr; const size_t off = (size_t)(u.pm * BM + r) * 1024 + col0; float s1 = 0.f, s2 = 0.f;
#pragma unroll
                for (int bj = 0; bj < 2; ++bj) { const u32x4 hh = *(const u32x4*)(H + off + bj * HALF);
                    const f32x4 v0 = acc[ai][bj][m][0] + alpha * unpk_lo(hh), v1 = acc[ai][bj][m][1] + alpha * unpk_hi(hh);
                    *(f32x4*)(R + off + bj * HALF) = v0; *(f32x4*)(R + off + bj * HALF + 4) = v1; *(u32x4*)(RB + off + bj * HALF) = pack8(v0, v1);
                    s1 += (v0[0] + v0[1]) + (v0[2] + v0[3]) + (v1[0] + v1[1]) + (v1[2] + v1[3]);
                    s2 += (v0[0] * v0[0] + v0[1] * v0[1]) + (v0[2] * v0[2] + v0[3] * v0[3]) + (v1[0] * v1[0] + v1[1] * v1[1]) + (v1[2] * v1[2] + v1[3] * v1[3]); }
                s1 += __shfl_xor(s1, 16); s1 += __shfl_xor(s1, 32); s2 += __shfl_xor(s2, 16); s2 += __shfl_xor(s2, 32);
                if (fq == 0) P[r * 4 + wc] = (f32x2){s1, s2}; }
        __syncthreads();
        const int tid = wid * 64 + lane;
        if (tid < 256) { const f32x2 a = P[tid * 4 + 0], b = P[tid * 4 + 1], c = P[tid * 4 + 2], d = P[tid * 4 + 3];
            *(f32x2*)(statsP + (size_t)(u.pm * BM + tid) * 8 + u.pn * 2) = (f32x2){(a.x + b.x) + (c.x + d.x), (a.y + b.y) + (c.y + d.y)}; }
    }
};

struct EpiP4 {
    static constexpr bool PERM = true, AFTER_DRAIN = true;
    const float* R; const bf16_t* PE; const float* statsP; const float* cp1; const float* cp2; const float* bgate; const float* g; const float* b; float* out; float eps;
    __device__ __forceinline__ void fused(f32x4 (&acc)[2][2][4][2], const Unit& u, int wr, int wc, int fr, int fq, PG8_LAS unsigned char* lds, int wid, int lane) const {
        PG8_LAS float* C = (PG8_LAS float*)lds;
        PG8_LAS f32x2* T = (PG8_LAS f32x2*)(lds + 2048);
        const int tid = wid * 64 + lane;
        { const int col = tid & 255, which = tid >> 8; const float* cp = cp1 + which * (16 * 1024); float s = 0.f;
#pragma unroll
          for (int kb = 0; kb < 16; ++kb) s += cp[kb * 1024 + u.pn * BM + col];
          if (which) s += bgate[u.pn * BM + col];
          C[which * 256 + col] = s; }
        if (tid < 256) { const float* sp = statsP + (size_t)(u.pm * BM + tid) * 8; const f32x4 a = *(const f32x4*)sp, bq = *(const f32x4*)(sp + 4);
            const float s1 = (a[0] + a[2]) + (bq[0] + bq[2]), s2 = (a[1] + a[3]) + (bq[1] + bq[3]);
            const float mu = s1 * (1.0f / 1024.0f); float var = s2 * (1.0f / 1024.0f) - mu * mu; var = var < 0.f ? 0.f : var;
            T[tid] = (f32x2){mu, 1.0f / sqrtf(var + eps)}; }
        __syncthreads();
#pragma unroll
        for (int bj = 0; bj < 2; ++bj) {
            const int cl = wc * 32 + 8 * fq + bj * HALF, gc = u.pn * BM + cl;
            const f32x4 c1a = *(const PG8_LAS f32x4*)(C + cl), c1b = *(const PG8_LAS f32x4*)(C + cl + 4), c2a = *(const PG8_LAS f32x4*)(C + 256 + cl), c2b = *(const PG8_LAS f32x4*)(C + 256 + cl + 4);
            const f32x4 ga = *(const f32x4*)(g + gc), gb = *(const f32x4*)(g + gc + 4), ba = *(const f32x4*)(b + gc), bb = *(const f32x4*)(b + gc + 4);
#pragma unroll
            for (int ai = 0; ai < 2; ++ai)
#pragma unroll
                for (int m = 0; m < 4; ++m) { const int r = ai * HALF + wr * 64 + m * 16 + fr; const f32x2 sr = T[r]; const size_t off = (size_t)(u.pm * BM + r) * 1024 + gc;
                    const f32x4 r0 = *(const f32x4*)(R + off), r1 = *(const f32x4*)(R + off + 4); const u32x4 pw = *(const u32x4*)(PE + off);
                    const f32x4 p0 = unpk_lo(pw), p1 = unpk_hi(pw);
                    const f32x4 gp0 = (acc[ai][bj][m][0] - sr.x * c1a) * sr.y + c2a, gp1 = (acc[ai][bj][m][1] - sr.x * c1b) * sr.y + c2b;
                    const f32x4 h0 = (r0 - sr.x) * sr.y * ga + ba, h1 = (r1 - sr.x) * sr.y * gb + bb;
                    *(f32x4*)(out + off) = h0 + sigm4(gp0) * p0; *(f32x4*)(out + off + 4) = h1 + sigm4(gp1) * p1; }
        }
    }
};

template <class Epi, class Sched, bool ALIGN_EPI = false, bool SP2 = false>
__device__ __forceinline__ void gemm_phase(PG8_LAS unsigned char* lds, const Gemm g, const Sched& S, const Epi& E) {
    int tid_ = threadIdx.x; asm volatile("" : "+v"(tid_));
    const int tid = tid_, wid = __builtin_amdgcn_readfirstlane(tid >> 6), lane = tid & 63, wr = wid >> 2, wc = wid & 3, fr = lane & 15, fq = lane >> 4;
    const int K = g.K, nt = K / BK;
    unsigned voffA[2], voffB[2];
#pragma unroll
    for (int i = 0; i < 2; ++i) { int R, C; stage_rc(tid * 16 + i * 8192, R, C); const int Rb = Epi::PERM ? ((R & ~31) + perm32(R & 31)) : R;
        voffA[i] = (unsigned)(R * K + C) * 2u; voffB[i] = (unsigned)(Rb * K + C) * 2u; }
    const size_t kstep = (size_t)(BK * 2);
    const size_t hstep = (size_t)HALF * K * 2;
    const size_t tstep = 2 * hstep;
    const unsigned ldsw = (unsigned)wid * 1024u;
    const int aoff = lds_byte(wr * 64 + fr, fq * 8), boff = lds_byte(wc * 32 + fr, fq * 8);
#define PG8_SA(b, h) (((b) * 2 + (h)) * HTB)
#define PG8_SB(b, h) ((4 + (b) * 2 + (h)) * HTB)
#define PG8_STAGE(bufoff, gbase, voff) do { _Pragma("unroll") for (int _i = 0; _i < 2; ++_i) \
        __builtin_amdgcn_global_load_lds((const unsigned*)((const char*)(gbase) + (voff)[_i]), (PG8_LAS unsigned*)(lds + (bufoff) + ldsw + _i * 8192), 16, 0, 0); } while (0)
#define PG8_LDA(dst, b, h) do { _Pragma("unroll") for (int m = 0; m < 4; ++m) _Pragma("unroll") for (int k = 0; k < 2; ++k) dst[m][k] = *(const PG8_LAS bf16x8*)(lds + PG8_SA(b, h) + aoff + m * 2048 + k * 1024); } while (0)
#define PG8_LDB(dst, b, h) do { _Pragma("unroll") for (int n = 0; n < 2; ++n) _Pragma("unroll") for (int k = 0; k < 2; ++k) dst[n][k] = *(const PG8_LAS bf16x8*)(lds + PG8_SB(b, h) + boff + n * 2048 + k * 1024); } while (0)
#define PG8_MMA(ai, bj, At, Bt) do { __builtin_amdgcn_s_setprio(1); _Pragma("unroll") for (int m = 0; m < 4; ++m) _Pragma("unroll") for (int n = 0; n < 2; ++n) _Pragma("unroll") for (int k = 0; k < 2; ++k) \
        acc[ai][bj][m][n] = __builtin_amdgcn_mfma_f32_16x16x32_bf16(Bt[n][k], At[m][k], acc[ai][bj][m][n], 0, 0, 0); __builtin_amdgcn_s_setprio(0); } while (0)
#define PG8_WAIT_V(n) asm volatile("s_waitcnt vmcnt(" #n ")" ::: "memory")
#define PG8_WAIT_L(n) asm volatile("s_waitcnt lgkmcnt(" #n ")" ::: "memory")
#define PG8_BAR __builtin_amdgcn_s_barrier()
#define PG8_SCHED __builtin_amdgcn_sched_barrier(0)
    Unit cur, nxt; int ui = 0;
    if (!S.next(0, cur)) return;
    f32x4 acc[2][2][4][2];
#pragma unroll
    for (int a = 0; a < 2; ++a)
#pragma unroll
        for (int b = 0; b < 2; ++b)
#pragma unroll
            for (int m = 0; m < 4; ++m)
#pragma unroll
                for (int n = 0; n < 2; ++n) acc[a][b][m][n] = (f32x4){0.f, 0.f, 0.f, 0.f};
    bf16x8 At[4][2], B0[2][2], B1[2][2];
    const char* cA = (const char*)g.A + (size_t)cur.pm * tstep; const char* cB = (const char*)g.Bt + (size_t)cur.pn * tstep;
    S.a_ready(cur);
    if constexpr (SP2) {
        PG8_STAGE(PG8_SB(0, 0), cB, voffB); PG8_STAGE(PG8_SB(0, 1), cB + hstep, voffB); PG8_STAGE(PG8_SA(0, 0), cA, voffA); PG8_STAGE(PG8_SA(0, 1), cA + hstep, voffA);
        if (wr == 1) PG8_BAR;
        PG8_WAIT_V(2); PG8_BAR;
        PG8_STAGE(PG8_SB(1, 0), cB + kstep, voffB); PG8_STAGE(PG8_SA(1, 0), cA + kstep, voffA); PG8_STAGE(PG8_SB(1, 1), cB + hstep + kstep, voffB);
        PG8_WAIT_V(6); PG8_BAR;
    } else {
        PG8_STAGE(PG8_SB(0, 0), cB, voffB); PG8_STAGE(PG8_SA(0, 0), cA, voffA); PG8_STAGE(PG8_SB(0, 1), cB + hstep, voffB); PG8_STAGE(PG8_SA(0, 1), cA + hstep, voffA);
        if (wr == 1) PG8_BAR;
        PG8_WAIT_V(4); PG8_BAR;
        PG8_STAGE(PG8_SB(1, 0), cB + kstep, voffB); PG8_STAGE(PG8_SA(1, 0), cA + kstep, voffA); PG8_STAGE(PG8_SB(1, 1), cB + hstep + kstep, voffB);
        PG8_WAIT_V(6); PG8_BAR;
    }
    for (;;) {
        const bool has_next = S.next(ui + 1, nxt);
        const char* nA = has_next ? (const char*)g.A + (size_t)nxt.pm * tstep : cA; const char* nB = has_next ? (const char*)g.Bt + (size_t)nxt.pn * tstep : cB;
        for (int t = 0; t < nt; t += 2) {
            const bool last = (t == nt - 2);
            const char* a1 = cA + (size_t)(t + 1) * kstep;
            const char* a2 = last ? nA : cA + (size_t)(t + 2) * kstep; const char* b2 = last ? nB : cB + (size_t)(t + 2) * kstep;
            const char* a3 = a2 + kstep; const char* b3 = b2 + kstep;
            if (last && has_next) S.a_ready(nxt);
            if constexpr (SP2) {
            PG8_LDB(B0, 0, 0); PG8_LDB(B1, 0, 1); PG8_SCHED; PG8_LDA(At, 0, 0); PG8_STAGE(PG8_SA(1, 1), a1 + hstep, voffA);
            PG8_WAIT_V(8); PG8_WAIT_L(0); PG8_BAR; PG8_MMA(0, 0, At, B0); PG8_MMA(0, 1, At, B1); PG8_BAR; PG8_SCHED;
            PG8_LDA(At, 0, 1); PG8_STAGE(PG8_SB(0, 0), b2, voffB); PG8_STAGE(PG8_SB(0, 1), b2 + hstep, voffB); PG8_STAGE(PG8_SA(0, 0), a2, voffA);
            PG8_WAIT_V(8); PG8_WAIT_L(0); PG8_BAR; PG8_MMA(1, 0, At, B0); PG8_MMA(1, 1, At, B1); PG8_BAR; PG8_SCHED;
            PG8_LDB(B0, 1, 0); PG8_LDB(B1, 1, 1); PG8_SCHED; PG8_LDA(At, 1, 0); PG8_STAGE(PG8_SA(0, 1), a2 + hstep, voffA);
            PG8_WAIT_V(8); PG8_WAIT_L(0); PG8_BAR; PG8_MMA(0, 0, At, B0); PG8_MMA(0, 1, At, B1); PG8_BAR; PG8_SCHED;
            PG8_LDA(At, 1, 1); PG8_STAGE(PG8_SB(1, 0), b3, voffB); PG8_STAGE(PG8_SB(1, 1), b3 + hstep, voffB); PG8_STAGE(PG8_SA(1, 0), a3, voffA);
            PG8_WAIT_V(8); PG8_WAIT_L(0); PG8_BAR; PG8_MMA(1, 0, At, B0); PG8_MMA(1, 1, At, B1); PG8_BAR; PG8_SCHED;
            } else {
            PG8_LDB(B0, 0, 0); PG8_SCHED; PG8_LDA(At, 0, 0); PG8_STAGE(PG8_SA(1, 1), a1 + hstep, voffA);
            PG8_WAIT_L(8); PG8_BAR; PG8_WAIT_L(0); PG8_MMA(0, 0, At, B0); PG8_BAR; PG8_SCHED;
            PG8_LDB(B1, 0, 1); PG8_STAGE(PG8_SB(0, 0), b2, voffB);
            PG8_BAR; PG8_WAIT_L(0); PG8_MMA(0, 1, At, B1); PG8_BAR;
            PG8_LDA(At, 0, 1); PG8_STAGE(PG8_SA(0, 0), a2, voffA);
            PG8_BAR; PG8_WAIT_L(0); PG8_MMA(1, 0, At, B0); PG8_BAR; PG8_SCHED;
            PG8_STAGE(PG8_SB(0, 1), b2 + hstep, voffB);
            PG8_WAIT_V(6); PG8_BAR; PG8_MMA(1, 1, At, B1); PG8_BAR;
            PG8_LDB(B0, 1, 0); PG8_SCHED; PG8_LDA(At, 1, 0); PG8_STAGE(PG8_SA(0, 1), a2 + hstep, voffA);
            PG8_WAIT_L(8); PG8_BAR; PG8_WAIT_L(0); PG8_MMA(0, 0, At, B0); PG8_BAR; PG8_SCHED;
            PG8_LDB(B1, 1, 1); PG8_STAGE(PG8_SB(1, 0), b3, voffB);
            PG8_BAR; PG8_WAIT_L(0); PG8_MMA(0, 1, At, B1); PG8_BAR;
            PG8_LDA(At, 1, 1); PG8_STAGE(PG8_SA(1, 0), a3, voffA);
            PG8_BAR; PG8_WAIT_L(0); PG8_MMA(1, 0, At, B0); PG8_BAR; PG8_SCHED;
            PG8_STAGE(PG8_SB(1, 1), b3 + hstep, voffB);
            PG8_WAIT_V(6); PG8_BAR; PG8_MMA(1, 1, At, B1); PG8_BAR;
            }
        }
        if constexpr (ALIGN_EPI) { if (wr == 0) PG8_BAR; }
        if constexpr (!Epi::AFTER_DRAIN) { E(acc, cur, wr, wc, fr, fq); S.done(cur); }
        if (!has_next) break;
#pragma unroll
        for (int a = 0; a < 2; ++a)
#pragma unroll
            for (int b = 0; b < 2; ++b)
#pragma unroll
                for (int m = 0; m < 4; ++m)
#pragma unroll
                    for (int n = 0; n < 2; ++n) acc[a][b][m][n] = (f32x4){0.f, 0.f, 0.f, 0.f};
        cur = nxt; cA = nA; cB = nB; ++ui;
        if constexpr (ALIGN_EPI) { if (wr == 1) PG8_BAR; }
    }
    PG8_WAIT_V(0);
    if constexpr (!ALIGN_EPI) { if (wr == 0) PG8_BAR; }
    PG8_BAR;
    if constexpr (Epi::AFTER_DRAIN) { E.fused(acc, cur, wr, wc, fr, fq, lds, wid, lane); S.done(cur); }
#undef PG8_SA
#undef PG8_SB
#undef PG8_STAGE
#undef PG8_LDA
#undef PG8_LDB
#undef PG8_MMA
#undef PG8_WAIT_V
#undef PG8_WAIT_L
#undef PG8_BAR
#undef PG8_SCHED
}
}
#ifndef PG8_SP2
#define PG8_SP2 true
#endif
#ifndef PG8_ALIGN
#define PG8_ALIGN true
#endif
#define LAS __attribute__((address_space(3)))
typedef unsigned short bf16;
typedef unsigned v4u __attribute__((ext_vector_type(4)));
typedef unsigned v2u __attribute__((ext_vector_type(2)));
typedef float f32x4 __attribute__((ext_vector_type(4)));
typedef float f32x2 __attribute__((ext_vector_type(2)));
typedef short bf16x8 __attribute__((ext_vector_type(8)));
#define LDS_WAIT() asm volatile("s_waitcnt lgkmcnt(0)" ::: "memory")

constexpr int NWAVES = 8, NTHR = 512;
constexpr int M = 16384, D = 1024, DIN = 3072, DPLE = 256, DC = 512, SEQ = 8192, CHUNK = 128, NHEAD = 8, CW = 31;
constexpr float LN_EPS = 1e-5f, ALPHA = 1.189207115002721f;
constexpr size_t MiB = 1u << 20;
constexpr size_t WS_CP1 = 0, WS_CP2 = 64 * 1024, WS_STATSP = 128 * 1024;
constexpr size_t WS_WSB = 1 * MiB;
constexpr size_t WS_WIN = 2 * MiB, WS_WOUT = 8 * MiB, WS_WG = 10 * MiB, WS_WPLE = 12 * MiB;
constexpr size_t WS_H = 16 * MiB, WS_PB = 48 * MiB, WS_PE = 56 * MiB, WS_Y = 88 * MiB, WS_RB = 120 * MiB;
constexpr size_t WS_AB = 152 * MiB, WS_SZ = 168 * MiB, WS_UG = 184 * MiB, WS_GV = 200 * MiB;
constexpr size_t WS_R = 152 * MiB;
constexpr size_t WS_END = 216 * MiB;
constexpr int LDS_BYTES = 147456;

__device__ __forceinline__ unsigned f2bf(float f) { unsigned u = __builtin_bit_cast(unsigned, f); return (u + 0x7fffu + ((u >> 16) & 1u)) >> 16; }
__device__ __forceinline__ unsigned pk2(float lo, float hi) { return f2bf(lo) | (f2bf(hi) << 16); }
__device__ __forceinline__ float bf_lo(unsigned u) { return __uint_as_float(u << 16); }
__device__ __forceinline__ float bf_hi(unsigned u) { return __uint_as_float(u & 0xffff0000u); }
__device__ __forceinline__ float wave_sum(float v) {
#pragma unroll
    for (int o = 1; o < 64; o <<= 1) v += __shfl_xor(v, o);
    return v;
}
__device__ __forceinline__ float sigm_f(float x) { return __builtin_amdgcn_rcpf(1.0f + __builtin_amdgcn_exp2f(-1.44269504089f * x)); }

#define GAS __attribute__((address_space(1)))
constexpr size_t WS_BAR = 768 * 1024, BAR_ZERO_BYTES = 16384;
constexpr int MISC_OFF = LDS_BYTES - 128;
#define XB_TMO      128
#define XB_XCNT(j)  (256  + 64 * (j))
#define XB_XSUB(j)  (1280 + 64 * (j))
#define XB_XGEN(j)  (2304 + 64 * (j))
#define XB_TOP      3328
#define XB_TOPGEN   3392
#define XCD_BAR_WORDS 3456
#define XB_SPIN_CAP (1u << 18)

__device__ __forceinline__ unsigned xb_ld(unsigned* p)              { return __hip_atomic_load(p, __ATOMIC_RELAXED, __HIP_MEMORY_SCOPE_AGENT); }
__device__ __forceinline__ unsigned xb_add(unsigned* p, unsigned v) { return __hip_atomic_fetch_add(p, v, __ATOMIC_RELAXED, __HIP_MEMORY_SCOPE_AGENT); }
__device__ __forceinline__ unsigned xb_xcc_id() { return (unsigned)__builtin_amdgcn_s_getreg((3 << 11) | 20) & 0xFu; }
#define XB_SPIN(cond, bar) do { unsigned _sp = 0; while (cond) { __builtin_amdgcn_s_sleep(1); \
    if ((++_sp & 255u) == 0u) { if (xb_ld(&(bar)[XB_TMO])) break; if (_sp > XB_SPIN_CAP) { atomicAdd(&(bar)[XB_TMO], 1u); break; } } } } while (0)

struct XcdBarrier {
    unsigned* bar; unsigned x;
    volatile LAS unsigned* st;
};

__device__ __forceinline__ XcdBarrier xcd_barrier_post(unsigned* bar, volatile LAS unsigned* st) {
    XcdBarrier b; b.bar = bar; b.x = xb_xcc_id(); b.st = st;
    if (threadIdx.x == 0) (void)xb_add(&bar[XB_XCNT(b.x)], 1u);
    return b;
}
__device__ __forceinline__ void xcd_barrier_complete(unsigned* bar, unsigned x, unsigned& nloc, unsigned& nx) {
    const unsigned G = gridDim.x * gridDim.y * gridDim.z;
    unsigned sum, cnt, mine, sp = 0u;
    for (;;) {
        sum = 0u; cnt = 0u; mine = 0u;
#pragma unroll
        for (unsigned j = 0; j < 16; ++j) { const unsigned c = xb_ld(&bar[XB_XCNT(j)]); sum += c; cnt += (c > 0u) ? 1u : 0u; mine = (j == x) ? c : mine; }
        if (sum == G) break;
        __builtin_amdgcn_s_sleep(1);
        if ((++sp & 255u) == 0u) { if (xb_ld(&bar[XB_TMO])) break; if (sp > XB_SPIN_CAP) { atomicAdd(&bar[XB_TMO], 1u); break; } }
    }
    nloc = mine > 0u ? mine : 1u; nx = cnt > 0u ? cnt : 1u;
}

__device__ __forceinline__ void xcd_barrier(const XcdBarrier& b) {
    asm volatile("s_waitcnt vmcnt(0)" ::: "memory");
    __syncthreads();
    if (threadIdx.x == 0) {
        unsigned* bar = b.bar;
        __builtin_amdgcn_s_waitcnt(0);
        unsigned nloc = b.st[0], nx = b.st[1];
        if (nloc == 0u) { xcd_barrier_complete(bar, b.x, nloc, nx); b.st[0] = nloc; b.st[1] = nx; }
        const unsigned old = xb_add(&bar[XB_XSUB(b.x)], 1u);
        const unsigned gen = old / nloc;
        if (old + 1u == (gen + 1u) * nloc) {
            __builtin_amdgcn_fence(__ATOMIC_RELEASE, "agent");
            asm volatile("s_waitcnt vmcnt(0)" ::: "memory");
            const unsigned og = xb_add(&bar[XB_TOP], 1u);
            const unsigned tg = og / nx;
            if (og + 1u == (tg + 1u) * nx) xb_add(&bar[XB_TOPGEN], 1u);
            else XB_SPIN(xb_ld(&bar[XB_TOPGEN]) == tg, bar);
            __builtin_amdgcn_fence(__ATOMIC_ACQUIRE, "agent");
            xb_add(&bar[XB_XGEN(b.x)], 1u);
            asm volatile("s_waitcnt vmcnt(0)" ::: "memory");
        } else {
            XB_SPIN(xb_ld(&bar[XB_XGEN(b.x)]) == gen, bar);
            __builtin_amdgcn_fence(__ATOMIC_ACQUIRE, "agent");
            asm volatile("s_waitcnt vmcnt(0)" ::: "memory");
        }
    }
    __syncthreads();
}

struct Args { const float* in[19]; float* out; unsigned char* ws; };

__device__ __forceinline__ int win_map(int n) {
    const int seg = n >> 9, o = n & 511, blk = o >> 7, w = o & 127;
    if (seg == 0) return 256 * blk + w;
    if (seg == 1) return 256 * blk + 128 + w;
    if (seg == 2) return 1024 + o;
    if (seg == 3) return 1536 + 256 * blk + w;
    if (seg == 5) return 1536 + 256 * blk + 128 + w;
    return 2560 + o;
}
template <bool GATE>
__device__ __forceinline__ void tr_item(const float* W, int K, int N, bf16* WT, int drow, LAS float* scr, int k0, int n0, int lane, const float* g, const float* b, float* cp1, float* cp2) {
#pragma unroll 8
    for (int i = 0; i < 32; ++i) { const int kk = 2 * i + (lane >> 5); scr[kk * 33 + (lane & 31)] = W[(size_t)(k0 + kk) * N + n0 + (lane & 31)]; }
    LDS_WAIT(); asm volatile("" ::: "memory");
    const int c = lane & 7;
    float gs[8];
#pragma unroll
    for (int e = 0; e < 8; ++e) gs[e] = GATE ? g[k0 + 8 * c + e] : 1.0f;
#pragma unroll
    for (int j = 0; j < 4; ++j) { const int n = (lane >> 3) + 8 * j; const LAS float* s = scr + (8 * c) * 33 + n;
        v4u o; o.x = pk2(s[0 * 33] * gs[0], s[1 * 33] * gs[1]); o.y = pk2(s[2 * 33] * gs[2], s[3 * 33] * gs[3]); o.z = pk2(s[4 * 33] * gs[4], s[5 * 33] * gs[5]); o.w = pk2(s[6 * 33] * gs[6], s[7 * 33] * gs[7]);
        *(v4u*)(WT + (size_t)(drow + n) * K + k0 + 8 * c) = o; }
    if (GATE) { const int n = lane & 31, half = lane >> 5; float s1 = 0.f, s2 = 0.f;
#pragma unroll 8
        for (int kk = 0; kk < 32; ++kk) { const int k = 32 * half + kk; const float w = scr[k * 33 + n]; s1 += g[k0 + k] * w; s2 += b[k0 + k] * w; }
        s1 += __shfl_xor(s1, 32); s2 += __shfl_xor(s2, 32);
        if (lane < 32) { cp1[(k0 >> 6) * N + n0 + n] = s1; cp2[(k0 >> 6) * N + n0 + n] = s2; } }
    LDS_WAIT(); asm volatile("" ::: "memory");
}

__device__ __forceinline__ void p0_prologue(const Args& a, LAS unsigned char* lds, int wave, int lane) {
    unsigned char* ws = a.ws;
    LAS float* scr = (LAS float*)(lds + wave * 16384);
    const int gw = blockIdx.x * NWAVES + wave, NGW = gridDim.x * NWAVES;
    constexpr int I_IN = (D / 64) * (DIN / 32), I_OUT = (D / 64) * (D / 32), I_G = I_OUT, I_PLE = (DPLE / 64) * (D / 32);
    constexpr int NITEMS = I_IN + I_OUT + I_G + I_PLE;
    for (int it = gw; it < NITEMS; it += NGW) {
        int r = it;
        if (r < I_IN) { const int nblk = DIN / 32, kb = r / nblk, nb = r % nblk; tr_item<false>(a.in[4], D, DIN, (bf16*)(ws + WS_WIN), win_map(32 * nb), scr, 64 * kb, 32 * nb, lane, nullptr, nullptr, nullptr, nullptr); continue; } r -= I_IN;
        if (r < I_OUT) { const int nblk = D / 32, kb = r / nblk, nb = r % nblk; tr_item<false>(a.in[13], D, D, (bf16*)(ws + WS_WOUT), 32 * nb, scr, 64 * kb, 32 * nb, lane, nullptr, nullptr, nullptr, nullptr); continue; } r -= I_OUT;
        if (r < I_G) { const int nblk = D / 32, kb = r / nblk, nb = r % nblk; tr_item<true>(a.in[17], D, D, (bf16*)(ws + WS_WG), 32 * nb, scr, 64 * kb, 32 * nb, lane, a.in[14], a.in[15], (float*)(ws + WS_CP1), (float*)(ws + WS_CP2)); continue; } r -= I_G;
        { const int nblk = D / 32, kb = r / nblk, nb = r % nblk; tr_item<false>(a.in[16], DPLE, D, (bf16*)(ws + WS_WPLE), 32 * nb, scr, 64 * kb, 32 * nb, lane, nullptr, nullptr, nullptr, nullptr); }
    }
    {
        const float* x = a.in[0]; bf16* H = (bf16*)(ws + WS_H);
        f32x4 gg[4], bb[4];
#pragma unroll
        for (int j = 0; j < 4; ++j) { gg[j] = *(const f32x4*)(a.in[2] + 4 * lane + 256 * j); bb[j] = *(const f32x4*)(a.in[3] + 4 * lane + 256 * j); }
        for (int m = gw; m < M; m += NGW) {
            const f32x4* xr = (const f32x4*)(x + (size_t)m * D) + lane;
            f32x4 v[4]; float s = 0.f;
#pragma unroll
            for (int j = 0; j < 4; ++j) { v[j] = xr[64 * j]; s += (v[j][0] + v[j][1]) + (v[j][2] + v[j][3]); }
            const float mean = wave_sum(s) * (1.f / D); float s2 = 0.f;
#pragma unroll
            for (int j = 0; j < 4; ++j) { v[j] = v[j] - mean; s2 += (v[j][0] * v[j][0] + v[j][1] * v[j][1]) + (v[j][2] * v[j][2] + v[j][3] * v[j][3]); }
            const float rstd = 1.f / sqrtf(wave_sum(s2) * (1.f / D) + LN_EPS);
            v2u* o8 = (v2u*)(H + (size_t)m * D) + lane;
#pragma unroll
            for (int j = 0; j < 4; ++j) { const f32x4 y = v[j] * rstd * gg[j] + bb[j]; o8[64 * j] = (v2u){pk2(y[0], y[1]), pk2(y[2], y[3])}; }
        }
    }
    {
        const float* p = a.in[1]; bf16* Pb = (bf16*)(ws + WS_PB);
        const int gt = blockIdx.x * NTHR + threadIdx.x, NGT = gridDim.x * NTHR;
        for (int i = gt; i < M * DPLE / 8; i += NGT) { const f32x4 a0 = *(const f32x4*)(p + (size_t)i * 8), a1 = *(const f32x4*)(p + (size_t)i * 8 + 4);
            *(v4u*)(Pb + (size_t)i * 8) = (v4u){pk2(a0[0], a0[1]), pk2(a0[2], a0[3]), pk2(a1[0], a1[1]), pk2(a1[2], a1[3])}; }
        const float* wsrc = a.in[11]; bf16* Wsb = (bf16*)(ws + WS_WSB);
        for (int i = gt; i < NHEAD * CHUNK * CHUNK / 8; i += NGT) { const int t = (i >> 4) & 127, s0 = (i & 15) * 8;
            const f32x4 a0 = *(const f32x4*)(wsrc + (size_t)i * 8), a1 = *(const f32x4*)(wsrc + (size_t)i * 8 + 4);
            float e[8] = {a0[0], a0[1], a0[2], a0[3], a1[0], a1[1], a1[2], a1[3]};
#pragma unroll
            for (int k = 0; k < 8; ++k) e[k] = (s0 + k <= t) ? e[k] : 0.f;
            *(v4u*)(Wsb + (size_t)i * 8) = (v4u){pk2(e[0], e[1]), pk2(e[2], e[3]), pk2(e[4], e[5]), pk2(e[6], e[7])}; }
    }
}

__device__ __forceinline__ void conv_item(LAS unsigned char* lds, int it, const bf16* Ab, const bf16* SZ, bf16* Y, const f32x2 (&w)[CW], f32x2 cb,
                                          const float* lng, const float* lnb, int tid, int wave, int lane) {
    const int m0 = it * 32, t0 = m0 & (SEQ - 1);
    LAS unsigned char* in = lds; LAS float* outt = (LAS float*)(lds + 65536);
    for (int q = tid; q < 62 * 64; q += NTHR) { const int row = q >> 6, c16 = q & 63; v4u v = (v4u){0u, 0u, 0u, 0u};
        if (t0 - 30 + row >= 0) v = *(const v4u*)(Ab + (size_t)(m0 - 30 + row) * DC + c16 * 8);
        *(LAS v4u*)(in + row * 1024 + c16 * 16) = v; }
    __syncthreads();
    const int cp = tid & 255, rh = tid >> 8;
    f32x2 acc[16];
#pragma unroll
    for (int t = 0; t < 16; ++t) acc[t] = (f32x2){0.f, 0.f};
#pragma unroll
    for (int j = 0; j < 46; ++j) { const unsigned d = *(const LAS unsigned*)(in + (16 * rh + j) * 1024 + cp * 4); const f32x2 v = (f32x2){bf_lo(d), bf_hi(d)};
#pragma unroll
        for (int k = 0; k < CW; ++k) { const int t = j - k; if (t >= 0 && t < 16) acc[t] += w[k] * v; } }
#pragma unroll
    for (int t = 0; t < 16; ++t) *(LAS f32x2*)(outt + (16 * rh + t) * DC + 2 * cp) = acc[t] + cb;
    __syncthreads();
#pragma unroll
    for (int rr = 0; rr < 4; ++rr) { const int row = 4 * wave + rr; const size_t m = (size_t)(m0 + row);
        f32x4 v[2]; float s = 0.f;
#pragma unroll
        for (int j = 0; j < 2; ++j) { v[j] = *(const LAS f32x4*)(outt + row * DC + 4 * lane + 256 * j); s += (v[j][0] + v[j][1]) + (v[j][2] + v[j][3]); }
        const float mean = wave_sum(s) * (1.f / DC); float s2 = 0.f;
#pragma unroll
        for (int j = 0; j < 2; ++j) { v[j] = v[j] - mean; s2 += (v[j][0] * v[j][0] + v[j][1] * v[j][1]) + (v[j][2] * v[j][2] + v[j][3] * v[j][3]); }
        const float rstd = 1.f / sqrtf(wave_sum(s2) * (1.f / DC) + LN_EPS);
#pragma unroll
        for (int j = 0; j < 2; ++j) { const int c = 4 * lane + 256 * j; const f32x4 gg = *(const f32x4*)(lng + c), bb = *(const f32x4*)(lnb + c);
            const v2u zz = *(const v2u*)(SZ + m * DC + c);
            f32x4 y = v[j] * rstd * gg + bb;
            y = (f32x4){y[0] * sigm_f(y[0]), y[1] * sigm_f(y[1]), y[2] * sigm_f(y[2]), y[3] * sigm_f(y[3])};
            y = y * (f32x4){bf_lo(zz.x), bf_hi(zz.x), bf_lo(zz.y), bf_hi(zz.y)};
            *(v2u*)(Y + m * D + c) = (v2u){pk2(y[0], y[1]), pk2(y[2], y[3])}; } }
    __syncthreads();
}

__device__ __forceinline__ void sgu_item(LAS unsigned char* lds, int it, const bf16* GV, const bf16* UG, const bf16* Wsb, const float* bs, const float* lng, const float* lnb, bf16* Y,
                                         int tid, int wave, int lane) {
    constexpr int RS = 516;
    const int c = it >> 1, hh = it & 1, m0 = c * CHUNK;
    {
        const f32x4 g0 = *(const f32x4*)(lng + 8 * lane), g1 = *(const f32x4*)(lng + 8 * lane + 4), b0 = *(const f32x4*)(lnb + 8 * lane), b1 = *(const f32x4*)(lnb + 8 * lane + 4);
        v4u raw[16];
#pragma unroll
        for (int i = 0; i < 16; ++i) raw[i] = *(const v4u*)(GV + (size_t)(m0 + 16 * wave + i) * DC + 8 * lane);
#pragma unroll
        for (int i = 0; i < 16; ++i) {
            f32x4 x0 = (f32x4){bf_lo(raw[i].x), bf_hi(raw[i].x), bf_lo(raw[i].y), bf_hi(raw[i].y)}, x1 = (f32x4){bf_lo(raw[i].z), bf_hi(raw[i].z), bf_lo(raw[i].w), bf_hi(raw[i].w)};
            const float s = (x0[0] + x0[1]) + (x0[2] + x0[3]) + (x1[0] + x1[1]) + (x1[2] + x1[3]);
            const float mean = wave_sum(s) * (1.f / DC);
            x0 = x0 - mean; x1 = x1 - mean;
            const float q = (x0[0] * x0[0] + x0[1] * x0[1]) + (x0[2] * x0[2] + x0[3] * x0[3]) + (x1[0] * x1[0] + x1[1] * x1[1]) + (x1[2] * x1[2] + x1[3] * x1[3]);
            const float rstd = 1.f / sqrtf(wave_sum(q) * (1.f / DC) + LN_EPS);
            x0 = x0 * rstd * g0 + b0; x1 = x1 * rstd * g1 + b1;
            if ((lane >> 5) == hh) { LAS unsigned* dst = (LAS unsigned*)(lds + (16 * wave + i) * RS + (lane & 31) * 16);
                dst[0] = pk2(x0[0], x0[1]); dst[1] = pk2(x0[2], x0[3]); dst[2] = pk2(x1[0], x1[1]); dst[3] = pk2(x1[2], x1[3]); }
        }
    }
    __syncthreads();
    {
        const int hl = wave >> 1, dh = wave & 1, h = 4 * hh + hl, dbase = hl * 64 + dh * 32, fr = lane & 15, q = lane >> 4;
        bf16x8 vf[2][4];
#pragma unroll
        for (int nb = 0; nb < 2; ++nb)
#pragma unroll
            for (int ks = 0; ks < 4; ++ks)
#pragma unroll
                for (int jj = 0; jj < 8; ++jj) vf[nb][ks][jj] = (short)*(const LAS unsigned short*)(lds + (32 * ks + 8 * q + jj) * RS + 2 * (dbase + 16 * nb + fr));
        f32x4 acc[8][2];
#pragma unroll
        for (int tb = 0; tb < 8; ++tb) { acc[tb][0] = (f32x4){0.f, 0.f, 0.f, 0.f}; acc[tb][1] = (f32x4){0.f, 0.f, 0.f, 0.f}; }
#pragma unroll
        for (int tb = 0; tb < 8; ++tb)
#pragma unroll
            for (int ks = 0; ks < 4; ++ks) if (ks <= (tb >> 1)) {
                const bf16x8 wf = *(const bf16x8*)(Wsb + ((size_t)(h * CHUNK + 16 * tb + fr)) * CHUNK + 32 * ks + 8 * q);
                acc[tb][0] = __builtin_amdgcn_mfma_f32_16x16x32_bf16(vf[0][ks], wf, acc[tb][0], 0, 0, 0);
                acc[tb][1] = __builtin_amdgcn_mfma_f32_16x16x32_bf16(vf[1][ks], wf, acc[tb][1], 0, 0, 0); }
#pragma unroll
        for (int tb = 0; tb < 8; ++tb) { const int t = 16 * tb + fr; const float bias = bs[h * CHUNK + t]; const size_t m = (size_t)(m0 + t);
#pragma unroll
            for (int nb = 0; nb < 2; ++nb) { const int col = 256 * hh + dbase + 16 * nb + 4 * q;
                const v2u ug = *(const v2u*)(UG + m * DC + col);
                const f32x4 o = (acc[tb][nb] + bias) * (f32x4){bf_lo(ug.x), bf_hi(ug.x), bf_lo(ug.y), bf_hi(ug.y)};
                *(v2u*)(Y + m * D + DC + col) = (v2u){pk2(o[0], o[1]), pk2(o[2], o[3])}; } }
    }
    __syncthreads();
}

__device__ __forceinline__ void p2_mixer(const Args& a, LAS unsigned char* lds, int tid, int wave, int lane) {
    unsigned char* ws = a.ws;
    const bf16* Ab = (const bf16*)(ws + WS_AB); const bf16* SZ = (const bf16*)(ws + WS_SZ); const bf16* UG = (const bf16*)(ws + WS_UG); const bf16* GV = (const bf16*)(ws + WS_GV);
    bf16* Y = (bf16*)(ws + WS_Y);
    for (int it = blockIdx.x; it < M / CHUNK * 2; it += gridDim.x)
        sgu_item(lds, it, GV, UG, (const bf16*)(ws + WS_WSB), a.in[12], a.in[9], a.in[10], Y, tid, wave, lane);
    {
        const int cp = tid & 255;
        f32x2 w[CW];
#pragma unroll
        for (int k = 0; k < CW; ++k) w[k] = *(const f32x2*)(a.in[5] + k * DC + 2 * cp);
        const f32x2 cb = *(const f32x2*)(a.in[6] + 2 * cp);
        for (int it = blockIdx.x; it < M / 32; it += gridDim.x)
            conv_item(lds, it, Ab, SZ, Y, w, cb, a.in[7], a.in[8], tid, wave, lane);
    }
}

__global__ void __launch_bounds__(NTHR, 2) fwd_megakernel(Args a) {
    extern __shared__ __attribute__((aligned(16))) unsigned char lds_raw[];
    LAS unsigned char* lds = (LAS unsigned char*)lds_raw;
    cg::grid_group grid = cg::this_grid();
#define FRESH_IDS int tid = threadIdx.x; asm volatile("" : "+v"(tid)); const int lane = tid & 63, wave = __builtin_amdgcn_readfirstlane(tid >> 6); (void)lane; (void)wave;
    unsigned char* ws = a.ws;
    const int G = gridDim.x;
    if (threadIdx.x < 32) ((LAS unsigned*)(lds + MISC_OFF))[threadIdx.x] = 0u;
    __syncthreads();
    const XcdBarrier bar = xcd_barrier_post((unsigned*)(ws + WS_BAR), (volatile LAS unsigned*)(lds + MISC_OFF));
    if (ws == nullptr) grid.sync();
#define GRID_BAR() xcd_barrier(bar)

#ifndef NO_P0
    { FRESH_IDS p0_prologue(a, lds, wave, lane); }
#endif
    GRID_BAR();

#ifndef NO_P1
#ifndef NO_PE
    {
        pg8::Gemm g{(const bf16*)(ws + WS_PB), (const bf16*)(ws + WS_WPLE), M, D, DPLE}; pg8::StaticOrder S; S.init(M, D, G, (int)blockIdx.x);
        pg8::EpiBf16<0> E{(bf16*)(ws + WS_PE), D, nullptr, 0, 0, 1.f};
        pg8::gemm_phase<pg8::EpiBf16<0>, pg8::StaticOrder, PG8_ALIGN, PG8_SP2>(lds, g, S, E);
    }
#endif
#ifndef NO_IN
    {
        pg8::Gemm g{(const bf16*)(ws + WS_H), (const bf16*)(ws + WS_WIN), M, DIN, D}; pg8::StaticOrder S; S.init(M, DIN, G, (int)blockIdx.x);
        pg8::EpiP1 E{(bf16*)(ws + WS_AB), (bf16*)(ws + WS_SZ), (bf16*)(ws + WS_UG), (bf16*)(ws + WS_GV)};
        pg8::gemm_phase<pg8::EpiP1, pg8::StaticOrder, PG8_ALIGN, PG8_SP2>(lds, g, S, E);
    }
#endif
#endif
    GRID_BAR();

#ifndef NO_P2
    { FRESH_IDS p2_mixer(a, lds, tid, wave, lane); }
#endif
    GRID_BAR();

#ifndef NO_P3
    {
        pg8::Gemm g{(const bf16*)(ws + WS_Y), (const bf16*)(ws + WS_WOUT), M, D, D}; pg8::StaticOrder S; S.init(M, D, G, (int)blockIdx.x);
        pg8::EpiP3 E{(const bf16*)(ws + WS_H), (float*)(ws + WS_R), (bf16*)(ws + WS_RB), (float*)(ws + WS_STATSP), ALPHA};
        pg8::gemm_phase<pg8::EpiP3, pg8::StaticOrder, false, PG8_SP2>(lds, g, S, E);
    }
#endif
    GRID_BAR();

#ifndef NO_P4
    {
        pg8::Gemm g{(const bf16*)(ws + WS_RB), (const bf16*)(ws + WS_WG), M, D, D}; pg8::StaticOrder S; S.init(M, D, G, (int)blockIdx.x);
        pg8::EpiP4 E{(const float*)(ws + WS_R), (const bf16*)(ws + WS_PE), (const float*)(ws + WS_STATSP), (const float*)(ws + WS_CP1), (const float*)(ws + WS_CP2), a.in[18], a.in[14], a.in[15], a.out, LN_EPS};
        pg8::gemm_phase<pg8::EpiP4, pg8::StaticOrder, false, PG8_SP2>(lds, g, S, E);
    }
#endif
}

extern "C" void kernel_launch(void* const* d_in, const int* in_sizes, int n_in, void* d_out, int out_size, void* d_ws, size_t ws_size, hipStream_t stream) {
    static int grid = 0;
    if (grid == 0) {
        if (n_in != 19 || in_sizes[0] != M * D || out_size != M * D || ws_size < WS_END) { fprintf(stderr, "kernel_launch: unexpected shapes (n_in %d, in0 %d, out %d, ws %zu)\n", n_in, n_in > 0 ? in_sizes[0] : -1, out_size, ws_size); grid = -1; return; }
        int dev = 0, cus = 0, per_cu = 0;
        if (hipGetDevice(&dev) != hipSuccess || hipDeviceGetAttribute(&cus, hipDeviceAttributeMultiprocessorCount, dev) != hipSuccess) { fprintf(stderr, "kernel_launch: device query failed\n"); grid = -1; return; }
        if (hipFuncSetAttribute((const void*)fwd_megakernel, hipFuncAttributeMaxDynamicSharedMemorySize, LDS_BYTES) != hipSuccess) { fprintf(stderr, "kernel_launch: hipFuncSetAttribute failed\n"); grid = -1; return; }
        if (hipOccupancyMaxActiveBlocksPerMultiprocessor(&per_cu, (const void*)fwd_megakernel, NTHR, LDS_BYTES) != hipSuccess || per_cu < 1) { fprintf(stderr, "kernel_launch: occupancy query says %d\n", per_cu); per_cu = 1; }
        (void)hipGetLastError();
        grid = cus * 1;
    }
    if (grid < 0) return;
    Args a{};
    for (int i = 0; i < 19; ++i) a.in[i] = (const float*)d_in[i];
    a.out = (float*)d_out; a.ws = (unsigned char*)d_ws;
    if (hipMemsetAsync((char*)d_ws + WS_BAR, 0, BAR_ZERO_BYTES, stream) != hipSuccess) { fprintf(stderr, "kernel_launch: memset failed\n"); return; }
    void* args[] = {&a};
    hipError_t e = hipLaunchCooperativeKernel((const void*)fwd_megakernel, dim3(grid), dim3(NTHR), args, LDS_BYTES, stream);
    if (e != hipSuccess) fprintf(stderr, "kernel_launch: cooperative launch failed: %s (grid %d)\n", hipGetErrorString(e), grid);
}
```

```cpp
#include <hip/hip_runtime.h>
#include <hip/hip_cooperative_groups.h>
#include <cstdio>
#include <cstdint>
namespace cg = cooperative_groups;
namespace pg8 {
#define PG8_LAS __attribute__((address_space(3)))
typedef unsigned short bf16_t;
typedef short bf16x8 __attribute__((ext_vector_type(8)));
typedef float f32x4 __attribute__((ext_vector_type(4)));
typedef unsigned u32x4 __attribute__((ext_vector_type(4)));
constexpr int BM = 256, BK = 64, HALF = 128, HTB = HALF * BK * 2  , STAGE_BYTES = 8 * HTB, NXCD = 8, WGM = 8;

__host__ __device__ __forceinline__ int lds_byte(int r, int c) { const int st = (r >> 4) * 2 + (c >> 5), rr = r & 15, cc = c & 31, ob = rr * 64 + cc * 2; return st * 1024 + (ob ^ (((ob >> 9) & 1) << 5)); }
__host__ __device__ __forceinline__ void stage_rc(int b, int& R, int& C) { const int st = b / 1024, sb = b % 1024, swz = sb ^ (((sb >> 9) & 1) << 5); R = (st >> 1) * 16 + swz / 64; C = (st & 1) * 32 + (swz % 64) / 2; }
__host__ __device__ __forceinline__ int perm32(int rho) { const int n = rho >> 4, i = rho & 15; return 8 * (i >> 2) + 4 * n + (i & 3); }

struct Unit { int pm, pn; };
struct Gemm { const bf16_t* A; const bf16_t* Bt; int M, N, K; };

struct StaticOrder {
    int nM, nN, nwg, G, c;
    __host__ __device__ void init(int M, int N, int G_, int c_) { nM = M / BM; nN = N / BM; nwg = nM * nN; G = G_; c = c_; }
    __host__ __device__ bool next(int i, Unit& u) const {
        const long L = (long)i * G + c; if (L >= nwg) return false;
        int wgid = (int)L; { const int q = nwg / NXCD, r = nwg % NXCD, xcd = wgid % NXCD, off = wgid / NXCD; wgid = (xcd < r ? xcd * (q + 1) : r * (q + 1) + (xcd - r) * q) + off; }
        const int nig = WGM * nN, gid = wgid / nig, fm = gid * WGM, gsz = (nM - fm) < WGM ? (nM - fm) : WGM;
        u.pm = fm + ((wgid % nig) % gsz); u.pn = (wgid % nig) / gsz; return true;
    }
    __device__ __forceinline__ void a_ready(const Unit&) const {}
    __device__ __forceinline__ void done(const Unit&) const {}
};

__device__ __forceinline__ unsigned cvt_pk_bf16(float lo, float hi) { unsigned r; asm volatile("v_cvt_pk_bf16_f32 %0, %1, %2" : "=v"(r) : "v"(lo), "v"(hi)); return r; }
typedef float f32x2 __attribute__((ext_vector_type(2)));
__device__ __forceinline__ f32x2 gelu_pk(f32x2 v) {
    const f32x2 av = __builtin_elementwise_abs(v), d = av * 0.2316418882f + 1.0f;
    f32x2 t; t.x = __builtin_amdgcn_rcpf(d.x); t.y = __builtin_amdgcn_rcpf(d.y);
    f32x2 q = t * 0.5307027145f + (-0.7265760135f); q = q * t + 0.7107068705f; q = q * t + (-0.142248368f); q = q * t + 0.127414796f; q = q * t;
    const f32x2 s = (v * v) * (-0.72134752044f);
    f32x2 e; e.x = __builtin_amdgcn_exp2f(s.x); e.y = __builtin_amdgcn_exp2f(s.y);
    const f32x2 m = v * (q * e), r = v - m;
    f32x2 o; o.x = v.x < 0.f ? m.x : r.x; o.y = v.y < 0.f ? m.y : r.y; return o;
}

template <int ACT  > struct EpiBf16 {
    static constexpr bool PERM = true, AFTER_DRAIN = false; static_assert(ACT == 0 || ACT == 1, "EpiBf16: ACT is 0 (none) or 1 (gelu_pk)");
    bf16_t* O; int ldc; const float* bias; int split_cols; size_t split_stride; float scale0;
    __device__ __forceinline__ void operator()(const f32x4 (&acc)[2][2][4][2], const Unit& u, int wr, int wc, int fr, int fq) const {
        const int row0 = u.pm * BM + wr * 64 + fr; int colt = u.pn * BM; bf16_t* base = O;
        float sc = 1.f; if (split_cols) { const int t = colt / split_cols; base += (size_t)t * split_stride; colt -= t * split_cols; if (t == 0) sc = scale0; }
        const int col0 = colt + wc * 32 + 8 * fq, bcol0 = u.pn * BM + wc * 32 + 8 * fq;
        f32x4 bv[2][2];
#pragma unroll
        for (int bj = 0; bj < 2; ++bj)
#pragma unroll
            for (int n = 0; n < 2; ++n) bv[bj][n] = bias ? *(const f32x4*)(bias + bcol0 + bj * HALF + 4 * n) : (f32x4){0.f, 0.f, 0.f, 0.f};
#pragma unroll
        for (int ai = 0; ai < 2; ++ai)
#pragma unroll
            for (int m = 0; m < 4; ++m) { bf16_t* rowp = base + (size_t)(row0 + ai * HALF + m * 16) * ldc + col0;
#pragma unroll
                for (int bj = 0; bj < 2; ++bj) { f32x4 v0 = acc[ai][bj][m][0] + bv[bj][0], v1 = acc[ai][bj][m][1] + bv[bj][1];
                    if (ACT == 1) { f32x2 a = gelu_pk((f32x2){v0[0], v0[1]}), b = gelu_pk((f32x2){v0[2], v0[3]}), c = gelu_pk((f32x2){v1[0], v1[1]}), d = gelu_pk((f32x2){v1[2], v1[3]});
                        v0 = (f32x4){a.x, a.y, b.x, b.y}; v1 = (f32x4){c.x, c.y, d.x, d.y}; }
                    v0 = v0 * sc; v1 = v1 * sc; u32x4 w; w.x = cvt_pk_bf16(v0[0], v0[1]); w.y = cvt_pk_bf16(v0[2], v0[3]); w.z = cvt_pk_bf16(v1[0], v1[1]); w.w = cvt_pk_bf16(v1[2], v1[3]);
                    *(u32x4*)(rowp + bj * HALF) = w; } }
    }
};
__device__ __forceinline__ float sigm(float x) { return __builtin_amdgcn_rcpf(1.0f + __builtin_amdgcn_exp2f(-1.44269504089f * x)); }
__device__ __forceinline__ f32x4 sigm4(f32x4 v) { return (f32x4){sigm(v[0]), sigm(v[1]), sigm(v[2]), sigm(v[3])}; }
__device__ __forceinline__ f32x4 gelu4(f32x4 v) { const f32x2 a = gelu_pk((f32x2){v[0], v[1]}), b = gelu_pk((f32x2){v[2], v[3]}); return (f32x4){a.x, a.y, b.x, b.y}; }
__device__ __forceinline__ u32x4 pack8(f32x4 v0, f32x4 v1) { u32x4 w; w.x = cvt_pk_bf16(v0[0], v0[1]); w.y = cvt_pk_bf16(v0[2], v0[3]); w.z = cvt_pk_bf16(v1[0], v1[1]); w.w = cvt_pk_bf16(v1[2], v1[3]); return w; }
__device__ __forceinline__ f32x4 unpk_lo(u32x4 w) { return (f32x4){__uint_as_float(w.x << 16), __uint_as_float(w.x & 0xffff0000u), __uint_as_float(w.y << 16), __uint_as_float(w.y & 0xffff0000u)}; }
__device__ __forceinline__ f32x4 unpk_hi(u32x4 w) { return (f32x4){__uint_as_float(w.z << 16), __uint_as_float(w.z & 0xffff0000u), __uint_as_float(w.w << 16), __uint_as_float(w.w & 0xffff0000u)}; }

struct EpiP1 {
    static constexpr bool PERM = true, AFTER_DRAIN = false;
    bf16_t *Ab, *SZ, *UG, *GV;
    __device__ __forceinline__ void operator()(const f32x4 (&acc)[2][2][4][2], const Unit& u, int wr, int wc, int fr, int fq) const {
        const int row0 = u.pm * BM + wr * 64 + fr, pn = u.pn, cl = wc * 32 + 8 * fq;
        if (pn < 4 || (pn >= 6 && pn < 10)) {
            const bool glu = pn < 4; bf16_t* base = glu ? Ab : UG; const int colt = 128 * (glu ? pn : pn - 6) + cl;
#pragma unroll
            for (int ai = 0; ai < 2; ++ai)
#pragma unroll
                for (int m = 0; m < 4; ++m) { bf16_t* rowp = base + (size_t)(row0 + ai * HALF + m * 16) * 512 + colt;
                    const f32x4 v0 = acc[ai][0][m][0], v1 = acc[ai][0][m][1], g0 = acc[ai][1][m][0], g1 = acc[ai][1][m][1];
                    f32x4 o0, o1;
                    if (glu) { o0 = v0 * sigm4(g0); o1 = v1 * sigm4(g1); }
                    else { o0 = gelu4(v0) * (g0 * sigm4(g0)); o1 = gelu4(v1) * (g1 * sigm4(g1)); }
                    *(u32x4*)rowp = pack8(o0, o1); }
        } else {
            const bool sil = pn < 6; bf16_t* base = sil ? SZ : GV; const int colt = 256 * (sil ? pn - 4 : pn - 10) + cl;
#pragma unroll
            for (int ai = 0; ai < 2; ++ai)
#pragma unroll
                for (int m = 0; m < 4; ++m) { bf16_t* rowp = base + (size_t)(row0 + ai * HALF + m * 16) * 512 + colt;
#pragma unroll
                    for (int bj = 0; bj < 2; ++bj) { const f32x4 v0 = acc[ai][bj][m][0], v1 = acc[ai][bj][m][1]; f32x4 o0, o1;
                        if (sil) { o0 = v0 * sigm4(v0); o1 = v1 * sigm4(v1); } else { o0 = gelu4(v0); o1 = gelu4(v1); }
                        *(u32x4*)(rowp + bj * HALF) = pack8(o0, o1); } }
        }
    }
};

struct EpiP3 {
    static constexpr bool PERM = true, AFTER_DRAIN = true;
    const bf16_t* H; float* R; bf16_t* RB; float* statsP; float alpha;
    __device__ __forceinline__ void fused(f32x4 (&acc)[2][2][4][2], const Unit& u, int wr, int wc, int fr, int fq, PG8_LAS unsigned char* lds, int wid, int lane) const {
        PG8_LAS f32x2* P = (PG8_LAS f32x2*)lds;
        const int col0 = u.pn * BM + wc * 32 + 8 * fq;
#pragma unroll
        for (int ai = 0; ai < 2; ++ai)
#pragma unroll
            for (int m = 0; m < 4; ++m) { const int r = ai * HALF + wr * 64 + m * 16 + fr; const size_t off = (size_t)(u.pm * BM + r) * 1024 + col0; float s1 = 0.f, s2 = 0.f;
#pragma unroll
                for (int bj = 0; bj < 2; ++bj) { const u32x4 hh = *(const u32x4*)(H + off + bj * HALF);
                    const f32x4 v0 = acc[ai][bj][m][0] + alpha * unpk_lo(hh), v1 = acc[ai][bj][m][1] + alpha * unpk_hi(hh);
                    *(f32x4*)(R + off + bj * HALF) = v0; *(f32x4*)(R + off + bj * HALF + 4) = v1; *(u32x4*)(RB + off + bj * HALF) = pack8(v0, v1);
                    s1 += (v0[0] + v0[1]) + (v0[2] + v0[3]) + (v1[0] + v1[1]) + (v1[2] + v1[3]);
                    s2 += (v0[0] * v0[0] + v0[1] * v0[1]) + (v0[2] * v0[2] + v0[3] * v0[3]) + (v1[0] * v1[0] + v1[1] * v1[1]) + (v1[2] * v1[2] + v1[3] * v1[3]); }
                s1 += __shfl_xor(s1, 16); s1 += __shfl_xor(s1, 32); s2 += __shfl_xor(s2, 16); s2 += __shfl_xor(s2, 32);
                if (fq == 0) P[r * 4 + wc] = (f32x2){s1, s2}; }
        __syncthreads();
        const int tid = wid * 64 + lane;
        if (tid < 256) { const f32x2 a = P[tid * 4 + 0], b = P[tid * 4 + 1], c = P[tid * 4 + 2], d = P[tid * 4 + 3];
            *(f32x2*)(statsP + (size_t)(u.pm * BM + tid) * 8 + u.pn * 2) = (f32x2){(a.x + b.x) + (c.x + d.x), (a.y + b.y) + (c.y + d.y)}; }
    }
};

struct EpiP4 {
    static constexpr bool PERM = true, AFTER_DRAIN = true;
    const float* R; const bf16_t* PE; const float* statsP; const float* cp1; const float* cp2; const float* bgate; const float* g; const float* b; float* out; float eps;
    __device__ __forceinline__ void fused(f32x4 (&acc)[2][2][4][2], const Unit& u, int wr, int wc, int fr, int fq, PG8_LAS unsigned char* lds, int wid, int lane) const {
        PG8_LAS float* C = (PG8_LAS float*)lds;
        PG8_LAS f32x2* T = (PG8_LAS f32x2*)(lds + 2048);
        const int tid = wid * 64 + lane;
        { const int col = tid & 255, which = tid >> 8; const float* cp = cp1 + which * (16 * 1024); float s = 0.f;
#pragma unroll
          for (int kb = 0; kb < 16; ++kb) s += cp[kb * 1024 + u.pn * BM + col];
          if (which) s += bgate[u.pn * BM + col];
          C[which * 256 + col] = s; }
        if (tid < 256) { const float* sp = statsP + (size_t)(u.pm * BM + tid) * 8; const f32x4 a = *(const f32x4*)sp, bq = *(const f32x4*)(sp + 4);
            const float s1 = (a[0] + a[2]) + (bq[0] + bq[2]), s2 = (a[1] + a[3]) + (bq[1] + bq[3]);
            const float mu = s1 * (1.0f / 1024.0f); float var = s2 * (1.0f / 1024.0f) - mu * mu; var = var < 0.f ? 0.f : var;
            T[tid] = (f32x2){mu, 1.0f / sqrtf(var + eps)}; }
        __syncthreads();
#pragma unroll
        for (int bj = 0; bj < 2; ++bj) {
            const int cl = wc * 32 + 8 * fq + bj * HALF, gc = u.pn * BM + cl;
            const f32x4 c1a = *(const PG8_LAS f32x4*)(C + cl), c1b = *(const PG8_LAS f32x4*)(C + cl + 4), c2a = *(const PG8_LAS f32x4*)(C + 256 + cl), c2b = *(const PG8_LAS f32x4*)(C + 256 + cl + 4);
            const f32x4 ga = *(const f32x4*)(g + gc), gb = *(const f32x4*)(g + gc + 4), ba = *(const f32x4*)(b + gc), bb = *(const f32x4*)(b + gc + 4);
#pragma unroll
            for (int ai = 0; ai < 2; ++ai)
#pragma unroll
                for (int m = 0; m < 4; ++m) { const int r = ai * HALF + wr * 64 + m * 16 + fr; const f32x2 sr = T[r]; const size_t off = (size_t)(u.pm * BM + r) * 1024 + gc;
                    const f32x4 r0 = *(const f32x4*)(R + off), r1 = *(const f32x4*)(R + off + 4); const u32x4 pw = *(const u32x4*)(PE + off);
                    const f32x4 p0 = unpk_lo(pw), p1 = unpk_hi(pw);
                    const f32x4 gp0 = (acc[ai][bj][m][0] - sr.x * c1a) * sr.y + c2a, gp1 = (acc[ai][bj][m][1] - sr.x * c1b) * sr.y + c2b;
                    const f32x4 h0 = (r0 - sr.x) * sr.y * ga + ba, h1 = (r1 - sr.x) * sr.y * gb + bb;
                    *(f32x4*)(out + off) = h0 + sigm4(gp0) * p0; *(f32x4*)(out + off + 4) = h1 + sigm4(gp1) * p1; }
        }
    }
};

template <class Epi, class Sched, bool ALIGN_EPI = false, bool SP2 = false>
__device__ __forceinline__ void gemm_phase(PG8_LAS unsigned char* lds, const Gemm g, const Sched& S, const Epi& E) {
    int tid_ = threadIdx.x; asm volatile("" : "+v"(tid_));
    const int tid = tid_, wid = __builtin_amdgcn_readfirstlane(tid >> 6), lane = tid & 63, wr = wid >> 2, wc = wid & 3, fr = lane & 15, fq = lane >> 4;
    const int K = g.K, nt = K / BK;
    unsigned voffA[2], voffB[2];
#pragma unroll
    for (int i = 0; i < 2; ++i) { int R, C; stage_rc(tid * 16 + i * 8192, R, C); const int Rb = Epi::PERM ? ((R & ~31) + perm32(R & 31)) : R;
        voffA[i] = (unsigned)(R * K + C) * 2u; voffB[i] = (unsigned)(Rb * K + C) * 2u; }
    const size_t kstep = (size_t)(BK * 2);
    const size_t hstep = (size_t)HALF * K * 2;
    const size_t tstep = 2 * hstep;
    const unsigned ldsw = (unsigned)wid * 1024u;
    const int aoff = lds_byte(wr * 64 + fr, fq * 8), boff = lds_byte(wc * 32 + fr, fq * 8);
#define PG8_SA(b, h) (((b) * 2 + (h)) * HTB)
#define PG8_SB(b, h) ((4 + (b) * 2 + (h)) * HTB)
#define PG8_STAGE(bufoff, gbase, voff) do { _Pragma("unroll") for (int _i = 0; _i < 2; ++_i) \
        __builtin_amdgcn_global_load_lds((const unsigned*)((const char*)(gbase) + (voff)[_i]), (PG8_LAS unsigned*)(lds + (bufoff) + ldsw + _i * 8192), 16, 0, 0); } while (0)
#define PG8_LDA(dst, b, h) do { _Pragma("unroll") for (int m = 0; m < 4; ++m) _Pragma("unroll") for (int k = 0; k < 2; ++k) dst[m][k] = *(const PG8_LAS bf16x8*)(lds + PG8_SA(b, h) + aoff + m * 2048 + k * 1024); } while (0)
#define PG8_LDB(dst, b, h) do { _Pragma("unroll") for (int n = 0; n < 2; ++n) _Pragma("unroll") for (int k = 0; k < 2; ++k) dst[n][k] = *(const PG8_LAS bf16x8*)(lds + PG8_SB(b, h) + boff + n * 2048 + k * 1024); } while (0)
#define PG8_MMA(ai, bj, At, Bt) do { __builtin_amdgcn_s_setprio(1); _Pragma("unroll") for (int m = 0; m < 4; ++m) _Pragma("unroll") for (int n = 0; n < 2; ++n) _Pragma("unroll") for (int k = 0; k < 2; ++k) \
        acc[ai][bj][m][n] = __builtin_amdgcn_mfma_f32_16x16x32_bf16(Bt[n][k], At[m][k], acc[ai][bj][m][n], 0, 0, 0); __builtin_amdgcn_s_setprio(0); } while (0)
#define PG8_WAIT_V(n) asm volatile("s_waitcnt vmcnt(" #n ")" ::: "memory")
#define PG8_WAIT_L(n) asm volatile("s_waitcnt lgkmcnt(" #n ")" ::: "memory")
#define PG8_BAR __builtin_amdgcn_s_barrier()
#define PG8_SCHED __builtin_amdgcn_sched_barrier(0)
    Unit cur, nxt; int ui = 0;
    if (!S.next(0, cur)) return;
    f32x4 acc[2][2][4][2];
#pragma unroll
    for (int a = 0; a < 2; ++a)
#pragma unroll
        for (int b = 0; b < 2; ++b)
#pragma unroll
            for (int m = 0; m < 4; ++m)
#pragma unroll
                for (int n = 0; n < 2; ++n) acc[a][b][m][n] = (f32x4){0.f, 0.f, 0.f, 0.f};
    bf16x8 At[4][2], B0[2][2], B1[2][2];
    const char* cA = (const char*)g.A + (size_t)cur.pm * tstep; const char* cB = (const char*)g.Bt + (size_t)cur.pn * tstep;
    S.a_ready(cur);
    if constexpr (SP2) {
        PG8_STAGE(PG8_SB(0, 0), cB, voffB); PG8_STAGE(PG8_SB(0, 1), cB + hstep, voffB); PG8_STAGE(PG8_SA(0, 0), cA, voffA); PG8_STAGE(PG8_SA(0, 1), cA + hstep, voffA);
        if (wr == 1) PG8_BAR;
        PG8_WAIT_V(2); PG8_BAR;
        PG8_STAGE(PG8_SB(1, 0), cB + kstep, voffB); PG8_STAGE(PG8_SA(1, 0), cA + kstep, voffA); PG8_STAGE(PG8_SB(1, 1), cB + hstep + kstep, voffB);
        PG8_WAIT_V(6); PG8_BAR;
    } else {
        PG8_STAGE(PG8_SB(0, 0), cB, voffB); PG8_STAGE(PG8_SA(0, 0), cA, voffA); PG8_STAGE(PG8_SB(0, 1), cB + hstep, voffB); PG8_STAGE(PG8_SA(0, 1), cA + hstep, voffA);
        if (wr == 1) PG8_BAR;
        PG8_WAIT_V(4); PG8_BAR;
        PG8_STAGE(PG8_SB(1, 0), cB + kstep, voffB); PG8_STAGE(PG8_SA(1, 0), cA + kstep, voffA); PG8_STAGE(PG8_SB(1, 1), cB + hstep + kstep, voffB);
        PG8_WAIT_V(6); PG8_BAR;
    }
    for (;;) {
        const bool has_next = S.next(ui + 1, nxt);
        const char* nA = has_next ? (const char*)g.A + (size_t)nxt.pm * tstep : cA; const char* nB = has_next ? (const char*)g.Bt + (size_t)nxt.pn * tstep : cB;
        for (int t = 0; t < nt; t += 2) {
            const bool last = (t == nt - 2);
            const char* a1 = cA + (size_t)(t + 1) * kstep;
            const char* a2 = last ? nA : cA + (size_t)(t + 2) * kstep; const char* b2 = last ? nB : cB + (size_t)(t + 2) * kstep;
            const char* a3 = a2 + kstep; const char* b3 = b2 + kstep;
            if (last && has_next) S.a_ready(nxt);
            if constexpr (SP2) {
            PG8_LDB(B0, 0, 0); PG8_LDB(B1, 0, 1); PG8_SCHED; PG8_LDA(At, 0, 0); PG8_STAGE(PG8_SA(1, 1), a1 + hstep, voffA);
            PG8_WAIT_V(8); PG8_WAIT_L(0); PG8_BAR; PG8_MMA(0, 0, At, B0); PG8_MMA(0, 1, At, B1); PG8_BAR; PG8_SCHED;
            PG8_LDA(At, 0, 1); PG8_STAGE(PG8_SB(0, 0), b2, voffB); PG8_STAGE(PG8_SB(0, 1), b2 + hstep, voffB); PG8_STAGE(PG8_SA(0, 0), a2, voffA);
            PG8_WAIT_V(8); PG8_WAIT_L(0); PG8_BAR; PG8_MMA(1, 0, At, B0); PG8_MMA(1, 1, At, B1); PG8_BAR; PG8_SCHED;
            PG8_LDB(B0, 1, 0); PG8_LDB(B1, 1, 1); PG8_SCHED; PG8_LDA(At, 1, 0); PG8_STAGE(PG8_SA(0, 1), a2 + hstep, voffA);
            PG8_WAIT_V(8); PG8_WAIT_L(0); PG8_BAR; PG8_MMA(0, 0, At, B0); PG8_MMA(0, 1, At, B1); PG8_BAR; PG8_SCHED;
            PG8_LDA(At, 1, 1); PG8_STAGE(PG8_SB(1, 0), b3, voffB); PG8_STAGE(PG8_SB(1, 1), b3 + hstep, voffB); PG8_STAGE(PG8_SA(1, 0), a3, voffA);
            PG8_WAIT_V(8); PG8_WAIT_L(0); PG8_BAR; PG8_MMA(1, 0, At, B0); PG8_MMA(1, 1, At, B1); PG8_BAR; PG8_SCHED;
            } else {
            PG8_LDB(B0, 0, 0); PG8_SCHED; PG8_LDA(At, 0, 0); PG8_STAGE(PG8_SA(1, 1), a1 + hstep, voffA);
            PG8_WAIT_L(8); PG8_BAR; PG8_WAIT_L(0); PG8_MMA(0, 0, At, B0); PG8_BAR; PG8_SCHED;
            PG8_LDB(B1, 0, 1); PG8_STAGE(PG8_SB(0, 0), b2, voffB);
            PG8_BAR; PG8_WAIT_L(0); PG8_MMA(0, 1, At, B1); PG8_BAR;
            PG8_LDA(At, 0, 1); PG8_STAGE(PG8_SA(0, 0), a2, voffA);
            PG8_BAR; PG8_WAIT_L(0); PG8_MMA(1, 0, At, B0); PG8_BAR; PG8_SCHED;
            PG8_STAGE(PG8_SB(0, 1), b2 + hstep, voffB);
            PG8_WAIT_V(6); PG8_BAR; PG8_MMA(1, 1, At, B1); PG8_BAR;
            PG8_LDB(B0, 1, 0); PG8_SCHED; PG8_LDA(At, 1, 0); PG8_STAGE(PG8_SA(0, 1), a2 + hstep, voffA);
            PG8_WAIT_L(8); PG8_BAR; PG8_WAIT_L(0); PG8_MMA(0, 0, At, B0); PG8_BAR; PG8_SCHED;
            PG8_LDB(B1, 1, 1); PG8_STAGE(PG8_SB(1, 0), b3, voffB);
            PG8_BAR; PG8_WAIT_L(0); PG8_MMA(0, 1, At, B1); PG8_BAR;
            PG8_LDA(At, 1, 1); PG8_STAGE(PG8_SA(1, 0), a3, voffA);
            PG8_BAR; PG8_WAIT_L(0); PG8_MMA(1, 0, At, B0); PG8_BAR; PG8_SCHED;
            PG8_STAGE(PG8_SB(1, 1), b3 + hstep, voffB);
            PG8_WAIT_V(6); PG8_BAR; PG8_MMA(1, 1, At, B1); PG8_BAR;
            }
        }
        if constexpr (ALIGN_EPI) { if (wr == 0) PG8_BAR; }
        if constexpr (!Epi::AFTER_DRAIN) { E(acc, cur, wr, wc, fr, fq); S.done(cur); }
        if (!has_next) break;
#pragma unroll
        for (int a = 0; a < 2; ++a)
#pragma unroll
            for (int b = 0; b < 2; ++b)
#pragma unroll
                for (int m = 0; m < 4; ++m)
#pragma unroll
                    for (int n = 0; n < 2; ++n) acc[a][b][m][n] = (f32x4){0.f, 0.f, 0.f, 0.f};
        cur = nxt; cA = nA; cB = nB; ++ui;
        if constexpr (ALIGN_EPI) { if (wr == 1) PG8_BAR; }
    }
    PG8_WAIT_V(0);
    if constexpr (!ALIGN_EPI) { if (wr == 0) PG8_BAR; }
    PG8_BAR;
    if constexpr (Epi::AFTER_DRAIN) { E.fused(acc, cur, wr, wc, fr, fq, lds, wid, lane); S.done(cur); }
#undef PG8_SA
#undef PG8_SB
#undef PG8_STAGE
#undef PG8_LDA
#undef PG8_LDB
#undef PG8_MMA
#undef PG8_WAIT_V
#undef PG8_WAIT_L
#undef PG8_BAR
#undef PG8_SCHED
}
}
#ifndef REP_P0
#define REP_P0 1
#endif
#ifndef REP_P1
#define REP_P1 1
#endif
#ifndef REP_P2
#define REP_P2 1
#endif
#ifndef REP_P3
#define REP_P3 1
#endif
#ifndef REP_P4
#define REP_P4 1
#endif
#ifndef PG8_SP2
#define PG8_SP2 true
#endif
#ifndef PG8_ALIGN
#define PG8_ALIGN true
#endif
#define LAS __attribute__((address_space(3)))
typedef unsigned short bf16;
typedef unsigned v4u __attribute__((ext_vector_type(4)));
typedef unsigned v2u __attribute__((ext_vector_type(2)));
typedef float f32x4 __attribute__((ext_vector_type(4)));
typedef float f32x2 __attribute__((ext_vector_type(2)));
typedef short bf16x8 __attribute__((ext_vector_type(8)));
#define LDS_WAIT() asm volatile("s_waitcnt lgkmcnt(0)" ::: "memory")

constexpr int NWAVES = 8, NTHR = 512;
constexpr int M = 16384, D = 1024, DIN = 3072, DPLE = 256, DC = 512, SEQ = 8192, CHUNK = 128, NHEAD = 8, CW = 31;
constexpr float LN_EPS = 1e-5f, ALPHA = 1.189207115002721f;
constexpr size_t MiB = 1u << 20;
constexpr size_t WS_CP1 = 0, WS_CP2 = 64 * 1024, WS_STATSP = 128 * 1024;
constexpr size_t WS_WSB = 1 * MiB;
constexpr size_t WS_WIN = 2 * MiB, WS_WOUT = 8 * MiB, WS_WG = 10 * MiB, WS_WPLE = 12 * MiB;
constexpr size_t WS_H = 16 * MiB, WS_PB = 48 * MiB, WS_PE = 56 * MiB, WS_Y = 88 * MiB, WS_RB = 120 * MiB;
constexpr size_t WS_AB = 152 * MiB, WS_SZ = 168 * MiB, WS_UG = 184 * MiB, WS_GV = 200 * MiB;
constexpr size_t WS_R = 152 * MiB;
constexpr size_t WS_END = 216 * MiB;
constexpr int LDS_BYTES = 147456;

__device__ __forceinline__ unsigned f2bf(float f) { unsigned u = __builtin_bit_cast(unsigned, f); return (u + 0x7fffu + ((u >> 16) & 1u)) >> 16; }
__device__ __forceinline__ unsigned pk2(float lo, float hi) { return f2bf(lo) | (f2bf(hi) << 16); }
__device__ __forceinline__ float bf_lo(unsigned u) { return __uint_as_float(u << 16); }
__device__ __forceinline__ float bf_hi(unsigned u) { return __uint_as_float(u & 0xffff0000u); }
__device__ __forceinline__ float wave_sum(float v) {
#pragma unroll
    for (int o = 1; o < 64; o <<= 1) v += __shfl_xor(v, o);
    return v;
}
__device__ __forceinline__ float sigm_f(float x) { return __builtin_amdgcn_rcpf(1.0f + __builtin_amdgcn_exp2f(-1.44269504089f * x)); }

#define GAS __attribute__((address_space(1)))
constexpr size_t WS_BAR = 768 * 1024, BAR_ZERO_BYTES = 16384;
constexpr int MISC_OFF = LDS_BYTES - 128;
#define XB_TMO      128
#define XB_XCNT(j)  (256  + 64 * (j))
#define XB_XSUB(j)  (1280 + 64 * (j))
#define XB_XGEN(j)  (2304 + 64 * (j))
#define XB_TOP      3328
#define XB_TOPGEN   3392
#define XCD_BAR_WORDS 3456
#define XB_SPIN_CAP (1u << 18)

__device__ __forceinline__ unsigned xb_ld(unsigned* p)              { return __hip_atomic_load(p, __ATOMIC_RELAXED, __HIP_MEMORY_SCOPE_AGENT); }
__device__ __forceinline__ unsigned xb_add(unsigned* p, unsigned v) { return __hip_atomic_fetch_add(p, v, __ATOMIC_RELAXED, __HIP_MEMORY_SCOPE_AGENT); }
__device__ __forceinline__ unsigned xb_xcc_id() { return (unsigned)__builtin_amdgcn_s_getreg((3 << 11) | 20) & 0xFu; }
#define XB_SPIN(cond, bar) do { unsigned _sp = 0; while (cond) { __builtin_amdgcn_s_sleep(1); \
    if ((++_sp & 255u) == 0u) { if (xb_ld(&(bar)[XB_TMO])) break; if (_sp > XB_SPIN_CAP) { atomicAdd(&(bar)[XB_TMO], 1u); break; } } } } while (0)

struct XcdBarrier {
    unsigned* bar; unsigned x;
    volatile LAS unsigned* st;
};

__device__ __forceinline__ XcdBarrier xcd_barrier_post(unsigned* bar, volatile LAS unsigned* st) {
    XcdBarrier b; b.bar = bar; b.x = xb_xcc_id(); b.st = st;
    if (threadIdx.x == 0) (void)xb_add(&bar[XB_XCNT(b.x)], 1u);
    return b;
}
__device__ __forceinline__ void xcd_barrier_complete(unsigned* bar, unsigned x, unsigned& nloc, unsigned& nx) {
    const unsigned G = gridDim.x * gridDim.y * gridDim.z;
    unsigned sum, cnt, mine, sp = 0u;
    for (;;) {
        sum = 0u; cnt = 0u; mine = 0u;
#pragma unroll
        for (unsigned j = 0; j < 16; ++j) { const unsigned c = xb_ld(&bar[XB_XCNT(j)]); sum += c; cnt += (c > 0u) ? 1u : 0u; mine = (j == x) ? c : mine; }
        if (sum == G) break;
        __builtin_amdgcn_s_sleep(1);
        if ((++sp & 255u) == 0u) { if (xb_ld(&bar[XB_TMO])) break; if (sp > XB_SPIN_CAP) { atomicAdd(&bar[XB_TMO], 1u); break; } }
    }
    nloc = mine > 0u ? mine : 1u; nx = cnt > 0u ? cnt : 1u;
}

__device__ __forceinline__ void xcd_barrier(const XcdBarrier& b) {
    asm volatile("s_waitcnt vmcnt(0)" ::: "memory");
    __syncthreads();
    if (threadIdx.x == 0) {
        unsigned* bar = b.bar;
        __builtin_amdgcn_s_waitcnt(0);
        unsigned nloc = b.st[0], nx = b.st[1];
        if (nloc == 0u) { xcd_barrier_complete(bar, b.x, nloc, nx); b.st[0] = nloc; b.st[1] = nx; }
        const unsigned old = xb_add(&bar[XB_XSUB(b.x)], 1u);
        const unsigned gen = old / nloc;
        if (old + 1u == (gen + 1u) * nloc) {
            __builtin_amdgcn_fence(__ATOMIC_RELEASE, "agent");
            asm volatile("s_waitcnt vmcnt(0)" ::: "memory");
            const unsigned og = xb_add(&bar[XB_TOP], 1u);
            const unsigned tg = og / nx;
            if (og + 1u == (tg + 1u) * nx) xb_add(&bar[XB_TOPGEN], 1u);
            else XB_SPIN(xb_ld(&bar[XB_TOPGEN]) == tg, bar);
            __builtin_amdgcn_fence(__ATOMIC_ACQUIRE, "agent");
            xb_add(&bar[XB_XGEN(b.x)], 1u);
            asm volatile("s_waitcnt vmcnt(0)" ::: "memory");
        } else {
            XB_SPIN(xb_ld(&bar[XB_XGEN(b.x)]) == gen, bar);
            __builtin_amdgcn_fence(__ATOMIC_ACQUIRE, "agent");
            asm volatile("s_waitcnt vmcnt(0)" ::: "memory");
        }
    }
    __syncthreads();
}

struct Args { const float* in[19]; float* out; unsigned char* ws; };

__device__ __forceinline__ int win_map(int n) {
    const int seg = n >> 9, o = n & 511, blk = o >> 7, w = o & 127;
    if (seg == 0) return 256 * blk + w;
    if (seg == 1) return 256 * blk + 128 + w;
    if (seg == 2) return 1024 + o;
    if (seg == 3) return 1536 + 256 * blk + w;
    if (seg == 5) return 1536 + 256 * blk + 128 + w;
    return 2560 + o;
}
template <bool GATE>
__device__ __forceinline__ void tr_item(const float* W, int K, int N, bf16* WT, int drow, LAS float* scr, int k0, int n0, int lane, const float* g, const float* b, float* cp1, float* cp2) {
#pragma unroll 8
    for (int i = 0; i < 32; ++i) { const int kk = 2 * i + (lane >> 5); scr[kk * 33 + (lane & 31)] = W[(size_t)(k0 + kk) * N + n0 + (lane & 31)]; }
    LDS_WAIT(); asm volatile("" ::: "memory");
    const int c = lane & 7;
    float gs[8];
#pragma unroll
    for (int e = 0; e < 8; ++e) gs[e] = GATE ? g[k0 + 8 * c + e] : 1.0f;
#pragma unroll
    for (int j = 0; j < 4; ++j) { const int n = (lane >> 3) + 8 * j; const LAS float* s = scr + (8 * c) * 33 + n;
        v4u o; o.x = pk2(s[0 * 33] * gs[0], s[1 * 33] * gs[1]); o.y = pk2(s[2 * 33] * gs[2], s[3 * 33] * gs[3]); o.z = pk2(s[4 * 33] * gs[4], s[5 * 33] * gs[5]); o.w = pk2(s[6 * 33] * gs[6], s[7 * 33] * gs[7]);
        *(v4u*)(WT + (size_t)(drow + n) * K + k0 + 8 * c) = o; }
    if (GATE) { const int n = lane & 31, half = lane >> 5; float s1 = 0.f, s2 = 0.f;
#pragma unroll 8
        for (int kk = 0; kk < 32; ++kk) { const int k = 32 * half + kk; const float w = scr[k * 33 + n]; s1 += g[k0 + k] * w; s2 += b[k0 + k] * w; }
        s1 += __shfl_xor(s1, 32); s2 += __shfl_xor(s2, 32);
        if (lane < 32) { cp1[(k0 >> 6) * N + n0 + n] = s1; cp2[(k0 >> 6) * N + n0 + n] = s2; } }
    LDS_WAIT(); asm volatile("" ::: "memory");
}

__device__ __forceinline__ void p0_prologue(const Args& a, LAS unsigned char* lds, int wave, int lane) {
    unsigned char* ws = a.ws;
    LAS float* scr = (LAS float*)(lds + wave * 16384);
    const int gw = blockIdx.x * NWAVES + wave, NGW = gridDim.x * NWAVES;
    constexpr int I_IN = (D / 64) * (DIN / 32), I_OUT = (D / 64) * (D / 32), I_G = I_OUT, I_PLE = (DPLE / 64) * (D / 32);
    constexpr int NITEMS = I_IN + I_OUT + I_G + I_PLE;
    for (int it = gw; it < NITEMS; it += NGW) {
        int r = it;
        if (r < I_IN) { const int nblk = DIN / 32, kb = r / nblk, nb = r % nblk; tr_item<false>(a.in[4], D, DIN, (bf16*)(ws + WS_WIN), win_map(32 * nb), scr, 64 * kb, 32 * nb, lane, nullptr, nullptr, nullptr, nullptr); continue; } r -= I_IN;
        if (r < I_OUT) { const int nblk = D / 32, kb = r / nblk, nb = r % nblk; tr_item<false>(a.in[13], D, D, (bf16*)(ws + WS_WOUT), 32 * nb, scr, 64 * kb, 32 * nb, lane, nullptr, nullptr, nullptr, nullptr); continue; } r -= I_OUT;
        if (r < I_G) { const int nblk = D / 32, kb = r / nblk, nb = r % nblk; tr_item<true>(a.in[17], D, D, (bf16*)(ws + WS_WG), 32 * nb, scr, 64 * kb, 32 * nb, lane, a.in[14], a.in[15], (float*)(ws + WS_CP1), (float*)(ws + WS_CP2)); continue; } r -= I_G;
        { const int nblk = D / 32, kb = r / nblk, nb = r % nblk; tr_item<false>(a.in[16], DPLE, D, (bf16*)(ws + WS_WPLE), 32 * nb, scr, 64 * kb, 32 * nb, lane, nullptr, nullptr, nullptr, nullptr); }
    }
    {
        const float* x = a.in[0]; bf16* H = (bf16*)(ws + WS_H);
        f32x4 gg[4], bb[4];
#pragma unroll
        for (int j = 0; j < 4; ++j) { gg[j] = *(const f32x4*)(a.in[2] + 4 * lane + 256 * j); bb[j] = *(const f32x4*)(a.in[3] + 4 * lane + 256 * j); }
        for (int m = gw; m < M; m += NGW) {
            const f32x4* xr = (const f32x4*)(x + (size_t)m * D) + lane;
            f32x4 v[4]; float s = 0.f;
#pragma unroll
            for (int j = 0; j < 4; ++j) { v[j] = xr[64 * j]; s += (v[j][0] + v[j][1]) + (v[j][2] + v[j][3]); }
            const float mean = wave_sum(s) * (1.f / D); float s2 = 0.f;
#pragma unroll
            for (int j = 0; j < 4; ++j) { v[j] = v[j] - mean; s2 += (v[j][0] * v[j][0] + v[j][1] * v[j][1]) + (v[j][2] * v[j][2] + v[j][3] * v[j][3]); }
            const float rstd = 1.f / sqrtf(wave_sum(s2) * (1.f / D) + LN_EPS);
            v2u* o8 = (v2u*)(H + (size_t)m * D) + lane;
#pragma unroll
            for (int j = 0; j < 4; ++j) { const f32x4 y = v[j] * rstd * gg[j] + bb[j]; o8[64 * j] = (v2u){pk2(y[0], y[1]), pk2(y[2], y[3])}; }
        }
    }
    {
        const float* p = a.in[1]; bf16* Pb = (bf16*)(ws + WS_PB);
        const int gt = blockIdx.x * NTHR + threadIdx.x, NGT = gridDim.x * NTHR;
        for (int i = gt; i < M * DPLE / 8; i += NGT) { const f32x4 a0 = *(const f32x4*)(p + (size_t)i * 8), a1 = *(const f32x4*)(p + (size_t)i * 8 + 4);
            *(v4u*)(Pb + (size_t)i * 8) = (v4u){pk2(a0[0], a0[1]), pk2(a0[2], a0[3]), pk2(a1[0], a1[1]), pk2(a1[2], a1[3])}; }
        const float* wsrc = a.in[11]; bf16* Wsb = (bf16*)(ws + WS_WSB);
        for (int i = gt; i < NHEAD * CHUNK * CHUNK / 8; i += NGT) { const int t = (i >> 4) & 127, s0 = (i & 15) * 8;
            const f32x4 a0 = *(const f32x4*)(wsrc + (size_t)i * 8), a1 = *(const f32x4*)(wsrc + (size_t)i * 8 + 4);
            float e[8] = {a0[0], a0[1], a0[2], a0[3], a1[0], a1[1], a1[2], a1[3]};
#pragma unroll
            for (int k = 0; k < 8; ++k) e[k] = (s0 + k <= t) ? e[k] : 0.f;
            *(v4u*)(Wsb + (size_t)i * 8) = (v4u){pk2(e[0], e[1]), pk2(e[2], e[3]), pk2(e[4], e[5]), pk2(e[6], e[7])}; }
    }
}

template <int J> struct ConvStep {
    static __device__ __forceinline__ void run(f32x2 (&acc)[16], const f32x2 (&w)[CW], const LAS unsigned char* p) {
        const unsigned d = *(const LAS unsigned*)(p + J * 1024); const f32x2 v = (f32x2){bf_lo(d), bf_hi(d)};
#pragma unroll
        for (int k = 0; k < CW; ++k) { const int t = J - k; if (t >= 0 && t < 16) acc[t] += w[k] * v; }
        ConvStep<J + 1>::run(acc, w, p);
    }
};
template <> struct ConvStep<46> { static __device__ __forceinline__ void run(f32x2 (&)[16], const f32x2 (&)[CW], const LAS unsigned char*) {} };
__device__ __forceinline__ void conv_item(LAS unsigned char* lds, int it, const bf16* Ab, const bf16* SZ, bf16* Y, const f32x2 (&w)[CW], f32x2 cb,
                                          const float* lng, const float* lnb, int tid, int wave, int lane) {
    const int m0 = it * 32, t0 = m0 & (SEQ - 1);
    LAS unsigned char* in = lds; LAS float* outt = (LAS float*)(lds + 65536);
    {
        v4u v[8];
#pragma unroll
        for (int i = 0; i < 8; ++i) { const int q = tid + i * NTHR, row = q >> 6, c16 = q & 63; v[i] = (v4u){0u, 0u, 0u, 0u};
            if (q < 62 * 64 && t0 - 30 + row >= 0) v[i] = *(const v4u*)(Ab + (size_t)(m0 - 30 + row) * DC + c16 * 8); }
#pragma unroll
        for (int i = 0; i < 8; ++i) { const int q = tid + i * NTHR, row = q >> 6, c16 = q & 63; if (q < 62 * 64) *(LAS v4u*)(in + row * 1024 + c16 * 16) = v[i]; }
    }
    __syncthreads();
    const int cp = tid & 255, rh = tid >> 8;
    f32x2 acc[16];
#pragma unroll
    for (int t = 0; t < 16; ++t) acc[t] = (f32x2){0.f, 0.f};
    ConvStep<0>::run(acc, w, in + (16 * rh) * 1024 + cp * 4);
#pragma unroll
    for (int t = 0; t < 16; ++t) *(LAS f32x2*)(outt + (16 * rh + t) * DC + 2 * cp) = acc[t] + cb;
    __syncthreads();
    {
        f32x4 gg[2], bb[2]; v2u zz[4][2];
#pragma unroll
        for (int j = 0; j < 2; ++j) { const int c = 4 * lane + 256 * j; gg[j] = *(const f32x4*)(lng + c); bb[j] = *(const f32x4*)(lnb + c);
#pragma unroll
            for (int rr = 0; rr < 4; ++rr) zz[rr][j] = *(const v2u*)(SZ + (size_t)(m0 + 4 * wave + rr) * DC + c); }
#pragma unroll
        for (int rr = 0; rr < 4; ++rr) { const int row = 4 * wave + rr; const size_t m = (size_t)(m0 + row);
            f32x4 v[2]; float s = 0.f;
#pragma unroll
            for (int j = 0; j < 2; ++j) { v[j] = *(const LAS f32x4*)(outt + row * DC + 4 * lane + 256 * j); s += (v[j][0] + v[j][1]) + (v[j][2] + v[j][3]); }
            const float mean = wave_sum(s) * (1.f / DC); float s2 = 0.f;
#pragma unroll
            for (int j = 0; j < 2; ++j) { v[j] = v[j] - mean; s2 += (v[j][0] * v[j][0] + v[j][1] * v[j][1]) + (v[j][2] * v[j][2] + v[j][3] * v[j][3]); }
            const float rstd = 1.f / sqrtf(wave_sum(s2) * (1.f / DC) + LN_EPS);
#pragma unroll
            for (int j = 0; j < 2; ++j) { const int c = 4 * lane + 256 * j;
                f32x4 y = v[j] * rstd * gg[j] + bb[j];
                y = (f32x4){y[0] * sigm_f(y[0]), y[1] * sigm_f(y[1]), y[2] * sigm_f(y[2]), y[3] * sigm_f(y[3])};
                y = y * (f32x4){bf_lo(zz[rr][j].x), bf_hi(zz[rr][j].x), bf_lo(zz[rr][j].y), bf_hi(zz[rr][j].y)};
                *(v2u*)(Y + m * D + c) = (v2u){pk2(y[0], y[1]), pk2(y[2], y[3])}; } }
    }
    __syncthreads();
}

__device__ __forceinline__ void sgu_item(LAS unsigned char* lds, int it, const bf16* GV, const bf16* UG, const bf16* Wsb, const float* bs, const float* lng, const float* lnb, bf16* Y,
                                         int tid, int wave, int lane) {
    constexpr int RS = 516;
    const int c = it >> 1, hh = it & 1, m0 = c * CHUNK;
    {
        const f32x4 g0 = *(const f32x4*)(lng + 8 * lane), g1 = *(const f32x4*)(lng + 8 * lane + 4), b0 = *(const f32x4*)(lnb + 8 * lane), b1 = *(const f32x4*)(lnb + 8 * lane + 4);
        v4u raw[16];
#pragma unroll
        for (int i = 0; i < 16; ++i) raw[i] = *(const v4u*)(GV + (size_t)(m0 + 16 * wave + i) * DC + 8 * lane);
#pragma unroll
        for (int i = 0; i < 16; ++i) {
            f32x4 x0 = (f32x4){bf_lo(raw[i].x), bf_hi(raw[i].x), bf_lo(raw[i].y), bf_hi(raw[i].y)}, x1 = (f32x4){bf_lo(raw[i].z), bf_hi(raw[i].z), bf_lo(raw[i].w), bf_hi(raw[i].w)};
            const float s = (x0[0] + x0[1]) + (x0[2] + x0[3]) + (x1[0] + x1[1]) + (x1[2] + x1[3]);
            const float mean = wave_sum(s) * (1.f / DC);
            x0 = x0 - mean; x1 = x1 - mean;
            const float q = (x0[0] * x0[0] + x0[1] * x0[1]) + (x0[2] * x0[2] + x0[3] * x0[3]) + (x1[0] * x1[0] + x1[1] * x1[1]) + (x1[2] * x1[2] + x1[3] * x1[3]);
            const float rstd = 1.f / sqrtf(wave_sum(q) * (1.f / DC) + LN_EPS);
            x0 = x0 * rstd * g0 + b0; x1 = x1 * rstd * g1 + b1;
            if ((lane >> 5) == hh) { LAS unsigned* dst = (LAS unsigned*)(lds + (16 * wave + i) * RS + (lane & 31) * 16);
                dst[0] = pk2(x0[0], x0[1]); dst[1] = pk2(x0[2], x0[3]); dst[2] = pk2(x1[0], x1[1]); dst[3] = pk2(x1[2], x1[3]); }
        }
    }
    __syncthreads();
    {
        const int hl = wave >> 1, dh = wave & 1, h = 4 * hh + hl, dbase = hl * 64 + dh * 32, fr = lane & 15, q = lane >> 4;
        bf16x8 vf[2][4];
#pragma unroll
        for (int nb = 0; nb < 2; ++nb)
#pragma unroll
            for (int ks = 0; ks < 4; ++ks)
#pragma unroll
                for (int jj = 0; jj < 8; ++jj) vf[nb][ks][jj] = (short)*(const LAS unsigned short*)(lds + (32 * ks + 8 * q + jj) * RS + 2 * (dbase + 16 * nb + fr));
        f32x4 acc[8][2];
#pragma unroll
        for (int tb = 0; tb < 8; ++tb) { acc[tb][0] = (f32x4){0.f, 0.f, 0.f, 0.f}; acc[tb][1] = (f32x4){0.f, 0.f, 0.f, 0.f}; }
#pragma unroll
        for (int tb = 0; tb < 8; ++tb)
#pragma unroll
            for (int ks = 0; ks < 4; ++ks) if (ks <= (tb >> 1)) {
                const bf16x8 wf = *(const bf16x8*)(Wsb + ((size_t)(h * CHUNK + 16 * tb + fr)) * CHUNK + 32 * ks + 8 * q);
                acc[tb][0] = __builtin_amdgcn_mfma_f32_16x16x32_bf16(vf[0][ks], wf, acc[tb][0], 0, 0, 0);
                acc[tb][1] = __builtin_amdgcn_mfma_f32_16x16x32_bf16(vf[1][ks], wf, acc[tb][1], 0, 0, 0); }
#pragma unroll
        for (int tb = 0; tb < 8; ++tb) { const int t = 16 * tb + fr; const float bias = bs[h * CHUNK + t]; const size_t m = (size_t)(m0 + t);
#pragma unroll
            for (int nb = 0; nb < 2; ++nb) { const int col = 256 * hh + dbase + 16 * nb + 4 * q;
                const v2u ug = *(const v2u*)(UG + m * DC + col);
                const f32x4 o = (acc[tb][nb] + bias) * (f32x4){bf_lo(ug.x), bf_hi(ug.x), bf_lo(ug.y), bf_hi(ug.y)};
                *(v2u*)(Y + m * D + DC + col) = (v2u){pk2(o[0], o[1]), pk2(o[2], o[3])}; } }
    }
    __syncthreads();
}

__device__ __forceinline__ void p2_mixer(const Args& a, LAS unsigned char* lds, int tid, int wave, int lane) {
    unsigned char* ws = a.ws;
    const bf16* Ab = (const bf16*)(ws + WS_AB); const bf16* SZ = (const bf16*)(ws + WS_SZ); const bf16* UG = (const bf16*)(ws + WS_UG); const bf16* GV = (const bf16*)(ws + WS_GV);
    bf16* Y = (bf16*)(ws + WS_Y);
    for (int it = blockIdx.x; it < M / CHUNK * 2; it += gridDim.x)
        sgu_item(lds, it, GV, UG, (const bf16*)(ws + WS_WSB), a.in[12], a.in[9], a.in[10], Y, tid, wave, lane);
    {
        const int cp = tid & 255;
        f32x2 w[CW];
#pragma unroll
        for (int k = 0; k < CW; ++k) w[k] = *(const f32x2*)(a.in[5] + k * DC + 2 * cp);
        const f32x2 cb = *(const f32x2*)(a.in[6] + 2 * cp);
        for (int it = blockIdx.x; it < M / 32; it += gridDim.x)
            conv_item(lds, it, Ab, SZ, Y, w, cb, a.in[7], a.in[8], tid, wave, lane);
    }
}

__global__ void __launch_bounds__(NTHR, 2) fwd_megakernel(Args a) {
    extern __shared__ __attribute__((aligned(16))) unsigned char lds_raw[];
    LAS unsigned char* lds = (LAS unsigned char*)lds_raw;
    cg::grid_group grid = cg::this_grid();
#define FRESH_IDS int tid = threadIdx.x; asm volatile("" : "+v"(tid)); const int lane = tid & 63, wave = __builtin_amdgcn_readfirstlane(tid >> 6); (void)lane; (void)wave;
    unsigned char* ws = a.ws;
    const int G = gridDim.x;
    if (threadIdx.x < 32) ((LAS unsigned*)(lds + MISC_OFF))[threadIdx.x] = 0u;
    __syncthreads();
    const XcdBarrier bar = xcd_barrier_post((unsigned*)(ws + WS_BAR), (volatile LAS unsigned*)(lds + MISC_OFF));
    if (ws == nullptr) grid.sync();
#define GRID_BAR() xcd_barrier(bar)

#ifndef NO_P0
    for (int rep = 0; rep < REP_P0; ++rep) { FRESH_IDS p0_prologue(a, lds, wave, lane); }
#endif
    GRID_BAR();

#ifndef NO_P1
    for (int rep = 0; rep < REP_P1; ++rep) {
#ifndef NO_PE
    {
        pg8::Gemm g{(const bf16*)(ws + WS_PB), (const bf16*)(ws + WS_WPLE), M, D, DPLE}; pg8::StaticOrder S; S.init(M, D, G, (int)blockIdx.x);
        pg8::EpiBf16<0> E{(bf16*)(ws + WS_PE), D, nullptr, 0, 0, 1.f};
        pg8::gemm_phase<pg8::EpiBf16<0>, pg8::StaticOrder, PG8_ALIGN, PG8_SP2>(lds, g, S, E);
    }
#endif
#ifndef NO_IN
    {
        pg8::Gemm g{(const bf16*)(ws + WS_H), (const bf16*)(ws + WS_WIN), M, DIN, D}; pg8::StaticOrder S; S.init(M, DIN, G, (int)blockIdx.x);
        pg8::EpiP1 E{(bf16*)(ws + WS_AB), (bf16*)(ws + WS_SZ), (bf16*)(ws + WS_UG), (bf16*)(ws + WS_GV)};
        pg8::gemm_phase<pg8::EpiP1, pg8::StaticOrder, PG8_ALIGN, PG8_SP2>(lds, g, S, E);
    }
#endif
    }
#endif
    GRID_BAR();

#ifndef NO_P2
    for (int rep = 0; rep < REP_P2; ++rep) { FRESH_IDS p2_mixer(a, lds, tid, wave, lane); }
#endif
    GRID_BAR();

#ifndef NO_P3
    for (int rep = 0; rep < REP_P3; ++rep)
    {
        pg8::Gemm g{(const bf16*)(ws + WS_Y), (const bf16*)(ws + WS_WOUT), M, D, D}; pg8::StaticOrder S; S.init(M, D, G, (int)blockIdx.x);
        pg8::EpiP3 E{(const bf16*)(ws + WS_H), (float*)(ws + WS_R), (bf16*)(ws + WS_RB), (float*)(ws + WS_STATSP), ALPHA};
        pg8::gemm_phase<pg8::EpiP3, pg8::StaticOrder, false, PG8_SP2>(lds, g, S, E);
    }
#endif
    GRID_BAR();

#ifndef NO_P4
    for (int rep = 0; rep < REP_P4; ++rep)
    {
        pg8::Gemm g{(const bf16*)(ws + WS_RB), (const bf16*)(ws + WS_WG), M, D, D}; pg8::StaticOrder S; S.init(M, D, G, (int)blockIdx.x);
        pg8::EpiP4 E{(const float*)(ws + WS_R), (const bf16*)(ws + WS_PE), (const float*)(ws + WS_STATSP), (const float*)(ws + WS_CP1), (const float*)(ws + WS_CP2), a.in[18], a.in[14], a.in[15], a.out, LN_EPS};
        pg8::gemm_phase<pg8::EpiP4, pg8::StaticOrder, false, PG8_SP2>(lds, g, S, E);
    }
#endif
}

extern "C" void kernel_launch(void* const* d_in, const int* in_sizes, int n_in, void* d_out, int out_size, void* d_ws, size_t ws_size, hipStream_t stream) {
    static int grid = 0;
    if (grid == 0) {
        if (n_in != 19 || in_sizes[0] != M * D || out_size != M * D || ws_size < WS_END) { fprintf(stderr, "kernel_launch: unexpected shapes (n_in %d, in0 %d, out %d, ws %zu)\n", n_in, n_in > 0 ? in_sizes[0] : -1, out_size, ws_size); grid = -1; return; }
        int dev = 0, cus = 0, per_cu = 0;
        if (hipGetDevice(&dev) != hipSuccess || hipDeviceGetAttribute(&cus, hipDeviceAttributeMultiprocessorCount, dev) != hipSuccess) { fprintf(stderr, "kernel_launch: device query failed\n"); grid = -1; return; }
        if (hipFuncSetAttribute((const void*)fwd_megakernel, hipFuncAttributeMaxDynamicSharedMemorySize, LDS_BYTES) != hipSuccess) { fprintf(stderr, "kernel_launch: hipFuncSetAttribute failed\n"); grid = -1; return; }
        if (hipOccupancyMaxActiveBlocksPerMultiprocessor(&per_cu, (const void*)fwd_megakernel, NTHR, LDS_BYTES) != hipSuccess || per_cu < 1) { fprintf(stderr, "kernel_launch: occupancy query says %d\n", per_cu); per_cu = 1; }
        (void)hipGetLastError();
        grid = cus * 1;
    }
    if (grid < 0) return;
    Args a{};
    for (int i = 0; i < 19; ++i) a.in[i] = (const float*)d_in[i];
    a.out = (float*)d_out; a.ws = (unsigned char*)d_ws;
    if (hipMemsetAsync((char*)d_ws + WS_BAR, 0, BAR_ZERO_BYTES, stream) != hipSuccess) { fprintf(stderr, "kernel_launch: memset failed\n"); return; }
    void* args[] = {&a};
    hipError_t e = hipLaunchCooperativeKernel((const void*)fwd_megakernel, dim3(grid), dim3(NTHR), args, LDS_BYTES, stream);
    if (e != hipSuccess) fprintf(stderr, "kernel_launch: cooperative launch failed: %s (grid %d)\n", hipGetErrorString(e), grid);
}
```

```cpp
#include <hip/hip_runtime.h>
#include <hip/hip_cooperative_groups.h>
#include <cstdio>
#include <cstdint>
namespace cg = cooperative_groups;
namespace pg8 {
#define PG8_LAS __attribute__((address_space(3)))
typedef unsigned short bf16_t;
typedef short bf16x8 __attribute__((ext_vector_type(8)));
typedef float f32x4 __attribute__((ext_vector_type(4)));
typedef unsigned u32x4 __attribute__((ext_vector_type(4)));
constexpr int BM = 256, BK = 64, HALF = 128, HTB = HALF * BK * 2  , STAGE_BYTES = 8 * HTB, NXCD = 8, WGM = 8;

__host__ __device__ __forceinline__ int lds_byte(int r, int c) { const int st = (r >> 4) * 2 + (c >> 5), rr = r & 15, cc = c & 31, ob = rr * 64 + cc * 2; return st * 1024 + (ob ^ (((ob >> 9) & 1) << 5)); }
__host__ __device__ __forceinline__ void stage_rc(int b, int& R, int& C) { const int st = b / 1024, sb = b % 1024, swz = sb ^ (((sb >> 9) & 1) << 5); R = (st >> 1) * 16 + swz / 64; C = (st & 1) * 32 + (swz % 64) / 2; }
__host__ __device__ __forceinline__ int perm32(int rho) { const int n = rho >> 4, i = rho & 15; return 8 * (i >> 2) + 4 * n + (i & 3); }

struct Unit { int pm, pn; };
struct Gemm { const bf16_t* A; const bf16_t* Bt; int M, N, K; };

struct StaticOrder {
    int nM, nN, nwg, G, c;
    __host__ __device__ void init(int M, int N, int G_, int c_) { nM = M / BM; nN = N / BM; nwg = nM * nN; G = G_; c = c_; }
    __host__ __device__ bool next(int i, Unit& u) const {
        const long L = (long)i * G + c; if (L >= nwg) return false;
        int wgid = (int)L; { const int q = nwg / NXCD, r = nwg % NXCD, xcd = wgid % NXCD, off = wgid / NXCD; wgid = (xcd < r ? xcd * (q + 1) : r * (q + 1) + (xcd - r) * q) + off; }
        const int nig = WGM * nN, gid = wgid / nig, fm = gid * WGM, gsz = (nM - fm) < WGM ? (nM - fm) : WGM;
        u.pm = fm + ((wgid % nig) % gsz); u.pn = (wgid % nig) / gsz; return true;
    }
    __device__ __forceinline__ void a_ready(const Unit&) const {}
    __device__ __forceinline__ void done(const Unit&) const {}
};

__device__ __forceinline__ unsigned cvt_pk_bf16(float lo, float hi) { unsigned r; asm volatile("v_cvt_pk_bf16_f32 %0, %1, %2" : "=v"(r) : "v"(lo), "v"(hi)); return r; }
typedef float f32x2 __attribute__((ext_vector_type(2)));
__device__ __forceinline__ f32x2 gelu_pk(f32x2 v) {
    const f32x2 av = __builtin_elementwise_abs(v), d = av * 0.2316418882f + 1.0f;
    f32x2 t; t.x = __builtin_amdgcn_rcpf(d.x); t.y = __builtin_amdgcn_rcpf(d.y);
    f32x2 q = t * 0.5307027145f + (-0.7265760135f); q = q * t + 0.7107068705f; q = q * t + (-0.142248368f); q = q * t + 0.127414796f; q = q * t;
    const f32x2 s = (v * v) * (-0.72134752044f);
    f32x2 e; e.x = __builtin_amdgcn_exp2f(s.x); e.y = __builtin_amdgcn_exp2f(s.y);
    const f32x2 m = v * (q * e), r = v - m;
    f32x2 o; o.x = v.x < 0.f ? m.x : r.x; o.y = v.y < 0.f ? m.y : r.y; return o;
}

template <int ACT  > struct EpiBf16 {
    static constexpr bool PERM = true, AFTER_DRAIN = false; static_assert(ACT == 0 || ACT == 1, "EpiBf16: ACT is 0 (none) or 1 (gelu_pk)");
    bf16_t* O; int ldc; const float* bias; int split_cols; size_t split_stride; float scale0;
    __device__ __forceinline__ void operator()(const f32x4 (&acc)[2][2][4][2], const Unit& u, int wr, int wc, int fr, int fq) const {
        const int row0 = u.pm * BM + wr * 64 + fr; int colt = u.pn * BM; bf16_t* base = O;
        float sc = 1.f; if (split_cols) { const int t = colt / split_cols; base += (size_t)t * split_stride; colt -= t * split_cols; if (t == 0) sc = scale0; }
        const int col0 = colt + wc * 32 + 8 * fq, bcol0 = u.pn * BM + wc * 32 + 8 * fq;
        f32x4 bv[2][2];
#pragma unroll
        for (int bj = 0; bj < 2; ++bj)
#pragma unroll
            for (int n = 0; n < 2; ++n) bv[bj][n] = bias ? *(const f32x4*)(bias + bcol0 + bj * HALF + 4 * n) : (f32x4){0.f, 0.f, 0.f, 0.f};
#pragma unroll
        for (int ai = 0; ai < 2; ++ai)
#pragma unroll
            for (int m = 0; m < 4; ++m) { bf16_t* rowp = base + (size_t)(row0 + ai * HALF + m * 16) * ldc + col0;
#pragma unroll
                for (int bj = 0; bj < 2; ++bj) { f32x4 v0 = acc[ai][bj][m][0] + bv[bj][0], v1 = acc[ai][bj][m][1] + bv[bj][1];
                    if (ACT == 1) { f32x2 a = gelu_pk((f32x2){v0[0], v0[1]}), b = gelu_pk((f32x2){v0[2], v0[3]}), c = gelu_pk((f32x2){v1[0], v1[1]}), d = gelu_pk((f32x2){v1[2], v1[3]});
                        v0 = (f32x4){a.x, a.y, b.x, b.y}; v1 = (f32x4){c.x, c.y, d.x, d.y}; }
                    v0 = v0 * sc; v1 = v1 * sc; u32x4 w; w.x = cvt_pk_bf16(v0[0], v0[1]); w.y = cvt_pk_bf16(v0[2], v0[3]); w.z = cvt_pk_bf16(v1[0], v1[1]); w.w = cvt_pk_bf16(v1[2], v1[3]);
                    *(u32x4*)(rowp + bj * HALF) = w; } }
    }
};
__device__ __forceinline__ float sigm(float x) { return __builtin_amdgcn_rcpf(1.0f + __builtin_amdgcn_exp2f(-1.44269504089f * x)); }
__device__ __forceinline__ f32x4 sigm4(f32x4 v) { return (f32x4){sigm(v[0]), sigm(v[1]), sigm(v[2]), sigm(v[3])}; }
__device__ __forceinline__ f32x4 gelu4(f32x4 v) { const f32x2 a = gelu_pk((f32x2){v[0], v[1]}), b = gelu_pk((f32x2){v[2], v[3]}); return (f32x4){a.x, a.y, b.x, b.y}; }
__device__ __forceinline__ u32x4 pack8(f32x4 v0, f32x4 v1) { u32x4 w; w.x = cvt_pk_bf16(v0[0], v0[1]); w.y = cvt_pk_bf16(v0[2], v0[3]); w.z = cvt_pk_bf16(v1[0], v1[1]); w.w = cvt_pk_bf16(v1[2], v1[3]); return w; }
__device__ __forceinline__ f32x4 unpk_lo(u32x4 w) { return (f32x4){__uint_as_float(w.x << 16), __uint_as_float(w.x & 0xffff0000u), __uint_as_float(w.y << 16), __uint_as_float(w.y & 0xffff0000u)}; }
__device__ __forceinline__ f32x4 unpk_hi(u32x4 w) { return (f32x4){__uint_as_float(w.z << 16), __uint_as_float(w.z & 0xffff0000u), __uint_as_float(w.w << 16), __uint_as_float(w.w & 0xffff0000u)}; }

struct EpiP1 {
    static constexpr bool PERM = true, AFTER_DRAIN = false;
    bf16_t *Ab, *SZ, *UG, *GV;
    __device__ __forceinline__ void operator()(const f32x4 (&acc)[2][2][4][2], const Unit& u, int wr, int wc, int fr, int fq) const {
        const int row0 = u.pm * BM + wr * 64 + fr, pn = u.pn, cl = wc * 32 + 8 * fq;
        if (pn < 4 || (pn >= 6 && pn < 10)) {
            const bool glu = pn < 4; bf16_t* base = glu ? Ab : UG; const int colt = 128 * (glu ? pn : pn - 6) + cl;
#pragma unroll
            for (int ai = 0; ai < 2; ++ai)
#pragma unroll
                for (int m = 0; m < 4; ++m) { bf16_t* rowp = base + (size_t)(row0 + ai * HALF + m * 16) * 512 + colt;
                    const f32x4 v0 = acc[ai][0][m][0], v1 = acc[ai][0][m][1], g0 = acc[ai][1][m][0], g1 = acc[ai][1][m][1];
                    f32x4 o0, o1;
                    if (glu) { o0 = v0 * sigm4(g0); o1 = v1 * sigm4(g1); }
                    else { o0 = gelu4(v0) * (g0 * sigm4(g0)); o1 = gelu4(v1) * (g1 * sigm4(g1)); }
                    *(u32x4*)rowp = pack8(o0, o1); }
        } else {
            const bool sil = pn < 6; bf16_t* base = sil ? SZ : GV; const int colt = 256 * (sil ? pn - 4 : pn - 10) + cl;
#pragma unroll
            for (int ai = 0; ai < 2; ++ai)
#pragma unroll
                for (int m = 0; m < 4; ++m) { bf16_t* rowp = base + (size_t)(row0 + ai * HALF + m * 16) * 512 + colt;
#pragma unroll
                    for (int bj = 0; bj < 2; ++bj) { const f32x4 v0 = acc[ai][bj][m][0], v1 = acc[ai][bj][m][1]; f32x4 o0, o1;
                        if (sil) { o0 = v0 * sigm4(v0); o1 = v1 * sigm4(v1); } else { o0 = gelu4(v0); o1 = gelu4(v1); }
                        *(u32x4*)(rowp + bj * HALF) = pack8(o0, o1); } }
        }
    }
};

struct EpiP3 {
    static constexpr bool PERM = true, AFTER_DRAIN = true;
    const bf16_t* H; bf16_t* RB; float* statsP; float alpha;
    __device__ __forceinline__ void fused(f32x4 (&acc)[2][2][4][2], const Unit& u, int wr, int wc, int fr, int fq, PG8_LAS unsigned char* lds, int wid, int lane) const {
        PG8_LAS f32x2* P = (PG8_LAS f32x2*)lds;
        const int col0 = u.pn * BM + wc * 32 + 8 * fq;
#pragma unroll
        for (int ai = 0; ai < 2; ++ai)
#pragma unroll
            for (int m = 0; m < 4; ++m) { const int r = ai * HALF + wr * 64 + m * 16 + fr; const size_t off = (size_t)(u.pm * BM + r) * 1024 + col0; float s1 = 0.f, s2 = 0.f;
#pragma unroll
                for (int bj = 0; bj < 2; ++bj) { const u32x4 hh = *(const u32x4*)(H + off + bj * HALF);
                    const f32x4 v0 = acc[ai][bj][m][0] + alpha * unpk_lo(hh), v1 = acc[ai][bj][m][1] + alpha * unpk_hi(hh);
                    *(u32x4*)(RB + off + bj * HALF) = pack8(v0, v1);
                    s1 += (v0[0] + v0[1]) + (v0[2] + v0[3]) + (v1[0] + v1[1]) + (v1[2] + v1[3]);
                    s2 += (v0[0] * v0[0] + v0[1] * v0[1]) + (v0[2] * v0[2] + v0[3] * v0[3]) + (v1[0] * v1[0] + v1[1] * v1[1]) + (v1[2] * v1[2] + v1[3] * v1[3]); }
                s1 += __shfl_xor(s1, 16); s1 += __shfl_xor(s1, 32); s2 += __shfl_xor(s2, 16); s2 += __shfl_xor(s2, 32);
                if (fq == 0) P[r * 4 + wc] = (f32x2){s1, s2}; }
        __syncthreads();
        const int tid = wid * 64 + lane;
        if (tid < 256) { const f32x2 a = P[tid * 4 + 0], b = P[tid * 4 + 1], c = P[tid * 4 + 2], d = P[tid * 4 + 3];
            *(f32x2*)(statsP + (size_t)(u.pm * BM + tid) * 8 + u.pn * 2) = (f32x2){(a.x + b.x) + (c.x + d.x), (a.y + b.y) + (c.y + d.y)}; }
    }
};

struct EpiP4 {
    static constexpr bool PERM = true, AFTER_DRAIN = true;
    const bf16_t* RB; const bf16_t* PE; const float* statsP; const float* cp1; const float* cp2; const float* bgate; const float* g; const float* b; float* out; float eps;
    __device__ __forceinline__ void fused(f32x4 (&acc)[2][2][4][2], const Unit& u, int wr, int wc, int fr, int fq, PG8_LAS unsigned char* lds, int wid, int lane) const {
        PG8_LAS float* C = (PG8_LAS float*)lds;
        PG8_LAS f32x2* T = (PG8_LAS f32x2*)(lds + 2048);
        const int tid = wid * 64 + lane;
        { const int col = tid & 255, which = tid >> 8; const float* cp = cp1 + which * (16 * 1024); float s = 0.f;
#pragma unroll
          for (int kb = 0; kb < 16; ++kb) s += cp[kb * 1024 + u.pn * BM + col];
          if (which) s += bgate[u.pn * BM + col];
          C[which * 256 + col] = s; }
        if (tid < 256) { const float* sp = statsP + (size_t)(u.pm * BM + tid) * 8; const f32x4 a = *(const f32x4*)sp, bq = *(const f32x4*)(sp + 4);
            const float s1 = (a[0] + a[2]) + (bq[0] + bq[2]), s2 = (a[1] + a[3]) + (bq[1] + bq[3]);
            const float mu = s1 * (1.0f / 1024.0f); float var = s2 * (1.0f / 1024.0f) - mu * mu; var = var < 0.f ? 0.f : var;
            T[tid] = (f32x2){mu, 1.0f / sqrtf(var + eps)}; }
        __syncthreads();
#pragma unroll
        for (int bj = 0; bj < 2; ++bj) {
            const int cl = wc * 32 + 8 * fq + bj * HALF, gc = u.pn * BM + cl;
            const f32x4 c1a = *(const PG8_LAS f32x4*)(C + cl), c1b = *(const PG8_LAS f32x4*)(C + cl + 4), c2a = *(const PG8_LAS f32x4*)(C + 256 + cl), c2b = *(const PG8_LAS f32x4*)(C + 256 + cl + 4);
            const f32x4 ga = *(const f32x4*)(g + gc), gb = *(const f32x4*)(g + gc + 4), ba = *(const f32x4*)(b + gc), bb = *(const f32x4*)(b + gc + 4);
#pragma unroll
            for (int ai = 0; ai < 2; ++ai)
#pragma unroll
                for (int m = 0; m < 4; ++m) { const int r = ai * HALF + wr * 64 + m * 16 + fr; const f32x2 sr = T[r]; const size_t off = (size_t)(u.pm * BM + r) * 1024 + gc;
                    const u32x4 rw = *(const u32x4*)(RB + off); const f32x4 r0 = unpk_lo(rw), r1 = unpk_hi(rw); const u32x4 pw = *(const u32x4*)(PE + off);
                    const f32x4 p0 = unpk_lo(pw), p1 = unpk_hi(pw);
                    const f32x4 gp0 = (acc[ai][bj][m][0] - sr.x * c1a) * sr.y + c2a, gp1 = (acc[ai][bj][m][1] - sr.x * c1b) * sr.y + c2b;
                    const f32x4 h0 = (r0 - sr.x) * sr.y * ga + ba, h1 = (r1 - sr.x) * sr.y * gb + bb;
                    *(f32x4*)(out + off) = h0 + sigm4(gp0) * p0; *(f32x4*)(out + off + 4) = h1 + sigm4(gp1) * p1; }
        }
    }
};

template <class Epi, class Sched, bool ALIGN_EPI = false, bool SP2 = false>
__device__ __forceinline__ void gemm_phase(PG8_LAS unsigned char* lds, const Gemm g, const Sched& S, const Epi& E) {
    int tid_ = threadIdx.x; asm volatile("" : "+v"(tid_));
    const int tid = tid_, wid = __builtin_amdgcn_readfirstlane(tid >> 6), lane = tid & 63, wr = wid >> 2, wc = wid & 3, fr = lane & 15, fq = lane >> 4;
    const int K = g.K, nt = K / BK;
    unsigned voffA[2], voffB[2];
#pragma unroll
    for (int i = 0; i < 2; ++i) { int R, C; stage_rc(tid * 16 + i * 8192, R, C); const int Rb = Epi::PERM ? ((R & ~31) + perm32(R & 31)) : R;
        voffA[i] = (unsigned)(R * K + C) * 2u; voffB[i] = (unsigned)(Rb * K + C) * 2u; }
    const size_t kstep = (size_t)(BK * 2);
    const size_t hstep = (size_t)HALF * K * 2;
    const size_t tstep = 2 * hstep;
    const unsigned ldsw = (unsigned)wid * 1024u;
    const int aoff = lds_byte(wr * 64 + fr, fq * 8), boff = lds_byte(wc * 32 + fr, fq * 8);
#define PG8_SA(b, h) (((b) * 2 + (h)) * HTB)
#define PG8_SB(b, h) ((4 + (b) * 2 + (h)) * HTB)
#define PG8_STAGE(bufoff, gbase, voff) do { _Pragma("unroll") for (int _i = 0; _i < 2; ++_i) \
        __builtin_amdgcn_global_load_lds((const unsigned*)((const char*)(gbase) + (voff)[_i]), (PG8_LAS unsigned*)(lds + (bufoff) + ldsw + _i * 8192), 16, 0, 0); } while (0)
#define PG8_LDA(dst, b, h) do { _Pragma("unroll") for (int m = 0; m < 4; ++m) _Pragma("unroll") for (int k = 0; k < 2; ++k) dst[m][k] = *(const PG8_LAS bf16x8*)(lds + PG8_SA(b, h) + aoff + m * 2048 + k * 1024); } while (0)
#define PG8_LDB(dst, b, h) do { _Pragma("unroll") for (int n = 0; n < 2; ++n) _Pragma("unroll") for (int k = 0; k < 2; ++k) dst[n][k] = *(const PG8_LAS bf16x8*)(lds + PG8_SB(b, h) + boff + n * 2048 + k * 1024); } while (0)
#define PG8_MMA(ai, bj, At, Bt) do { __builtin_amdgcn_s_setprio(1); _Pragma("unroll") for (int m = 0; m < 4; ++m) _Pragma("unroll") for (int n = 0; n < 2; ++n) _Pragma("unroll") for (int k = 0; k < 2; ++k) \
        acc[ai][bj][m][n] = __builtin_amdgcn_mfma_f32_16x16x32_bf16(Bt[n][k], At[m][k], acc[ai][bj][m][n], 0, 0, 0); __builtin_amdgcn_s_setprio(0); } while (0)
#define PG8_WAIT_V(n) asm volatile("s_waitcnt vmcnt(" #n ")" ::: "memory")
#define PG8_WAIT_L(n) asm volatile("s_waitcnt lgkmcnt(" #n ")" ::: "memory")
#define PG8_BAR __builtin_amdgcn_s_barrier()
#define PG8_SCHED __builtin_amdgcn_sched_barrier(0)
    Unit cur, nxt; int ui = 0;
    if (!S.next(0, cur)) return;
    f32x4 acc[2][2][4][2];
#pragma unroll
    for (int a = 0; a < 2; ++a)
#pragma unroll
        for (int b = 0; b < 2; ++b)
#pragma unroll
            for (int m = 0; m < 4; ++m)
#pragma unroll
                for (int n = 0; n < 2; ++n) acc[a][b][m][n] = (f32x4){0.f, 0.f, 0.f, 0.f};
    bf16x8 At[4][2], B0[2][2], B1[2][2];
    const char* cA = (const char*)g.A + (size_t)cur.pm * tstep; const char* cB = (const char*)g.Bt + (size_t)cur.pn * tstep;
    S.a_ready(cur);
    if constexpr (SP2) {
        PG8_STAGE(PG8_SB(0, 0), cB, voffB); PG8_STAGE(PG8_SB(0, 1), cB + hstep, voffB); PG8_STAGE(PG8_SA(0, 0), cA, voffA); PG8_STAGE(PG8_SA(0, 1), cA + hstep, voffA);
        if (wr == 1) PG8_BAR;
        PG8_WAIT_V(2); PG8_BAR;
        PG8_STAGE(PG8_SB(1, 0), cB + kstep, voffB); PG8_STAGE(PG8_SA(1, 0), cA + kstep, voffA); PG8_STAGE(PG8_SB(1, 1), cB + hstep + kstep, voffB);
        PG8_WAIT_V(6); PG8_BAR;
    } else {
        PG8_STAGE(PG8_SB(0, 0), cB, voffB); PG8_STAGE(PG8_SA(0, 0), cA, voffA); PG8_STAGE(PG8_SB(0, 1), cB + hstep, voffB); PG8_STAGE(PG8_SA(0, 1), cA + hstep, voffA);
        if (wr == 1) PG8_BAR;
        PG8_WAIT_V(4); PG8_BAR;
        PG8_STAGE(PG8_SB(1, 0), cB + kstep, voffB); PG8_STAGE(PG8_SA(1, 0), cA + kstep, voffA); PG8_STAGE(PG8_SB(1, 1), cB + hstep + kstep, voffB);
        PG8_WAIT_V(6); PG8_BAR;
    }
    for (;;) {
        const bool has_next = S.next(ui + 1, nxt);
        const char* nA = has_next ? (const char*)g.A + (size_t)nxt.pm * tstep : cA; const char* nB = has_next ? (const char*)g.Bt + (size_t)nxt.pn * tstep : cB;
        for (int t = 0; t < nt; t += 2) {
            const bool last = (t == nt - 2);
            const char* a1 = cA + (size_t)(t + 1) * kstep;
            const char* a2 = last ? nA : cA + (size_t)(t + 2) * kstep; const char* b2 = last ? nB : cB + (size_t)(t + 2) * kstep;
            const char* a3 = a2 + kstep; const char* b3 = b2 + kstep;
            if (last && has_next) S.a_ready(nxt);
            if constexpr (SP2) {
            PG8_LDB(B0, 0, 0); PG8_LDB(B1, 0, 1); PG8_SCHED; PG8_LDA(At, 0, 0); PG8_STAGE(PG8_SA(1, 1), a1 + hstep, voffA);
            PG8_WAIT_V(8); PG8_WAIT_L(0); PG8_BAR; PG8_MMA(0, 0, At, B0); PG8_MMA(0, 1, At, B1); PG8_BAR; PG8_SCHED;
            PG8_LDA(At, 0, 1); PG8_STAGE(PG8_SB(0, 0), b2, voffB); PG8_STAGE(PG8_SB(0, 1), b2 + hstep, voffB); PG8_STAGE(PG8_SA(0, 0), a2, voffA);
            PG8_WAIT_V(8); PG8_WAIT_L(0); PG8_BAR; PG8_MMA(1, 0, At, B0); PG8_MMA(1, 1, At, B1); PG8_BAR; PG8_SCHED;
            PG8_LDB(B0, 1, 0); PG8_LDB(B1, 1, 1); PG8_SCHED; PG8_LDA(At, 1, 0); PG8_STAGE(PG8_SA(0, 1), a2 + hstep, voffA);
            PG8_WAIT_V(8); PG8_WAIT_L(0); PG8_BAR; PG8_MMA(0, 0, At, B0); PG8_MMA(0, 1, At, B1); PG8_BAR; PG8_SCHED;
            PG8_LDA(At, 1, 1); PG8_STAGE(PG8_SB(1, 0), b3, voffB); PG8_STAGE(PG8_SB(1, 1), b3 + hstep, voffB); PG8_STAGE(PG8_SA(1, 0), a3, voffA);
            PG8_WAIT_V(8); PG8_WAIT_L(0); PG8_BAR; PG8_MMA(1, 0, At, B0); PG8_MMA(1, 1, At, B1); PG8_BAR; PG8_SCHED;
            } else {
            PG8_LDB(B0, 0, 0); PG8_SCHED; PG8_LDA(At, 0, 0); PG8_STAGE(PG8_SA(1, 1), a1 + hstep, voffA);
            PG8_WAIT_L(8); PG8_BAR; PG8_WAIT_L(0); PG8_MMA(0, 0, At, B0); PG8_BAR; PG8_SCHED;
            PG8_LDB(B1, 0, 1); PG8_STAGE(PG8_SB(0, 0), b2, voffB);
            PG8_BAR; PG8_WAIT_L(0); PG8_MMA(0, 1, At, B1); PG8_BAR;
            PG8_LDA(At, 0, 1); PG8_STAGE(PG8_SA(0, 0), a2, voffA);
            PG8_BAR; PG8_WAIT_L(0); PG8_MMA(1, 0, At, B0); PG8_BAR; PG8_SCHED;
            PG8_STAGE(PG8_SB(0, 1), b2 + hstep, voffB);
            PG8_WAIT_V(6); PG8_BAR; PG8_MMA(1, 1, At, B1); PG8_BAR;
            PG8_LDB(B0, 1, 0); PG8_SCHED; PG8_LDA(At, 1, 0); PG8_STAGE(PG8_SA(0, 1), a2 + hstep, voffA);
            PG8_WAIT_L(8); PG8_BAR; PG8_WAIT_L(0); PG8_MMA(0, 0, At, B0); PG8_BAR; PG8_SCHED;
            PG8_LDB(B1, 1, 1); PG8_STAGE(PG8_SB(1, 0), b3, voffB);
            PG8_BAR; PG8_WAIT_L(0); PG8_MMA(0, 1, At, B1); PG8_BAR;
            PG8_LDA(At, 1, 1); PG8_STAGE(PG8_SA(1, 0), a3, voffA);
            PG8_BAR; PG8_WAIT_L(0); PG8_MMA(1, 0, At, B0); PG8_BAR; PG8_SCHED;
            PG8_STAGE(PG8_SB(1, 1), b3 + hstep, voffB);
            PG8_WAIT_V(6); PG8_BAR; PG8_MMA(1, 1, At, B1); PG8_BAR;
            }
        }
        if constexpr (ALIGN_EPI) { if (wr == 0) PG8_BAR; }
        if constexpr (!Epi::AFTER_DRAIN) { E(acc, cur, wr, wc, fr, fq); S.done(cur); }
        if (!has_next) break;
#pragma unroll
        for (int a = 0; a < 2; ++a)
#pragma unroll
            for (int b = 0; b < 2; ++b)
#pragma unroll
                for (int m = 0; m < 4; ++m)
#pragma unroll
                    for (int n = 0; n < 2; ++n) acc[a][b][m][n] = (f32x4){0.f, 0.f, 0.f, 0.f};
        cur = nxt; cA = nA; cB = nB; ++ui;
        if constexpr (ALIGN_EPI) { if (wr == 1) PG8_BAR; }
    }
    PG8_WAIT_V(0);
    if constexpr (!ALIGN_EPI) { if (wr == 0) PG8_BAR; }
    PG8_BAR;
    if constexpr (Epi::AFTER_DRAIN) { E.fused(acc, cur, wr, wc, fr, fq, lds, wid, lane); S.done(cur); }
#undef PG8_SA
#undef PG8_SB
#undef PG8_STAGE
#undef PG8_LDA
#undef PG8_LDB
#undef PG8_MMA
#undef PG8_WAIT_V
#undef PG8_WAIT_L
#undef PG8_BAR
#undef PG8_SCHED
}
}
#ifndef REP_SGU
#define REP_SGU 1
#endif
#ifndef REP_CONV
#define REP_CONV 1
#endif
#ifndef REP_P0
#define REP_P0 1
#endif
#ifndef REP_P1
#define REP_P1 1
#endif
#ifndef REP_P2
#define REP_P2 1
#endif
#ifndef REP_P3
#define REP_P3 1
#endif
#ifndef REP_P4
#define REP_P4 1
#endif
#ifndef PG8_SP2
#define PG8_SP2 true
#endif
#ifndef PG8_ALIGN
#define PG8_ALIGN true
#endif
#define LAS __attribute__((address_space(3)))
typedef unsigned short bf16;
typedef unsigned v4u __attribute__((ext_vector_type(4)));
typedef unsigned v2u __attribute__((ext_vector_type(2)));
typedef float f32x4 __attribute__((ext_vector_type(4)));
typedef float f32x2 __attribute__((ext_vector_type(2)));
typedef short bf16x8 __attribute__((ext_vector_type(8)));
#define LDS_WAIT() asm volatile("s_waitcnt lgkmcnt(0)" ::: "memory")

constexpr int NWAVES = 8, NTHR = 512;
constexpr int M = 16384, D = 1024, DIN = 3072, DPLE = 256, DC = 512, SEQ = 8192, CHUNK = 128, NHEAD = 8, CW = 31;
constexpr float LN_EPS = 1e-5f, ALPHA = 1.189207115002721f;
constexpr size_t MiB = 1u << 20;
constexpr size_t WS_CP1 = 0, WS_CP2 = 64 * 1024, WS_STATSP = 128 * 1024;
constexpr size_t WS_WSB = 1 * MiB;
constexpr size_t WS_WIN = 2 * MiB, WS_WOUT = 8 * MiB, WS_WG = 10 * MiB, WS_WPLE = 12 * MiB;
constexpr size_t WS_H = 16 * MiB, WS_PB = 48 * MiB, WS_PE = 56 * MiB, WS_Y = 88 * MiB, WS_RB = 120 * MiB;
constexpr size_t WS_AB = 152 * MiB, WS_SZ = 168 * MiB, WS_UG = 184 * MiB, WS_GV = 200 * MiB;
constexpr size_t WS_R = 152 * MiB;
constexpr size_t WS_END = 216 * MiB;
constexpr int LDS_BYTES = 147456;

__device__ __forceinline__ unsigned f2bf(float f) { unsigned u = __builtin_bit_cast(unsigned, f); return (u + 0x7fffu + ((u >> 16) & 1u)) >> 16; }
__device__ __forceinline__ unsigned pk2(float lo, float hi) { return f2bf(lo) | (f2bf(hi) << 16); }
__device__ __forceinline__ float bf_lo(unsigned u) { return __uint_as_float(u << 16); }
__device__ __forceinline__ float bf_hi(unsigned u) { return __uint_as_float(u & 0xffff0000u); }
__device__ __forceinline__ float wave_sum(float v) {
#pragma unroll
    for (int o = 1; o < 64; o <<= 1) v += __shfl_xor(v, o);
    return v;
}
__device__ __forceinline__ float sigm_f(float x) { return __builtin_amdgcn_rcpf(1.0f + __builtin_amdgcn_exp2f(-1.44269504089f * x)); }

#define GAS __attribute__((address_space(1)))
constexpr size_t WS_BAR = 768 * 1024, BAR_ZERO_BYTES = 16384;
constexpr int MISC_OFF = LDS_BYTES - 128;
#define XB_TMO      128
#define XB_XCNT(j)  (256  + 64 * (j))
#define XB_XSUB(j)  (1280 + 64 * (j))
#define XB_XGEN(j)  (2304 + 64 * (j))
#define XB_TOP      3328
#define XB_TOPGEN   3392
#define XCD_BAR_WORDS 3456
#define XB_SPIN_CAP (1u << 18)

__device__ __forceinline__ unsigned xb_ld(unsigned* p)              { return __hip_atomic_load(p, __ATOMIC_RELAXED, __HIP_MEMORY_SCOPE_AGENT); }
__device__ __forceinline__ unsigned xb_add(unsigned* p, unsigned v) { return __hip_atomic_fetch_add(p, v, __ATOMIC_RELAXED, __HIP_MEMORY_SCOPE_AGENT); }
__device__ __forceinline__ unsigned xb_xcc_id() { return (unsigned)__builtin_amdgcn_s_getreg((3 << 11) | 20) & 0xFu; }
#define XB_SPIN(cond, bar) do { unsigned _sp = 0; while (cond) { __builtin_amdgcn_s_sleep(1); \
    if ((++_sp & 255u) == 0u) { if (xb_ld(&(bar)[XB_TMO])) break; if (_sp > XB_SPIN_CAP) { atomicAdd(&(bar)[XB_TMO], 1u); break; } } } } while (0)

struct XcdBarrier {
    unsigned* bar; unsigned x;
    volatile LAS unsigned* st;
};

__device__ __forceinline__ XcdBarrier xcd_barrier_post(unsigned* bar, volatile LAS unsigned* st) {
    XcdBarrier b; b.bar = bar; b.x = xb_xcc_id(); b.st = st;
    if (threadIdx.x == 0) (void)xb_add(&bar[XB_XCNT(b.x)], 1u);
    return b;
}
__device__ __forceinline__ void xcd_barrier_complete(unsigned* bar, unsigned x, unsigned& nloc, unsigned& nx) {
    const unsigned G = gridDim.x * gridDim.y * gridDim.z;
    unsigned sum, cnt, mine, sp = 0u;
    for (;;) {
        sum = 0u; cnt = 0u; mine = 0u;
#pragma unroll
        for (unsigned j = 0; j < 16; ++j) { const unsigned c = xb_ld(&bar[XB_XCNT(j)]); sum += c; cnt += (c > 0u) ? 1u : 0u; mine = (j == x) ? c : mine; }
        if (sum == G) break;
        __builtin_amdgcn_s_sleep(1);
        if ((++sp & 255u) == 0u) { if (xb_ld(&bar[XB_TMO])) break; if (sp > XB_SPIN_CAP) { atomicAdd(&bar[XB_TMO], 1u); break; } }
    }
    nloc = mine > 0u ? mine : 1u; nx = cnt > 0u ? cnt : 1u;
}

__device__ __forceinline__ void xcd_barrier(const XcdBarrier& b) {
    asm volatile("s_waitcnt vmcnt(0)" ::: "memory");
    __syncthreads();
    if (threadIdx.x == 0) {
        unsigned* bar = b.bar;
        __builtin_amdgcn_s_waitcnt(0);
        unsigned nloc = b.st[0], nx = b.st[1];
        if (nloc == 0u) { xcd_barrier_complete(bar, b.x, nloc, nx); b.st[0] = nloc; b.st[1] = nx; }
        const unsigned old = xb_add(&bar[XB_XSUB(b.x)], 1u);
        const unsigned gen = old / nloc;
        if (old + 1u == (gen + 1u) * nloc) {
            __builtin_amdgcn_fence(__ATOMIC_RELEASE, "agent");
            asm volatile("s_waitcnt vmcnt(0)" ::: "memory");
            const unsigned og = xb_add(&bar[XB_TOP], 1u);
            const unsigned tg = og / nx;
            if (og + 1u == (tg + 1u) * nx) xb_add(&bar[XB_TOPGEN], 1u);
            else XB_SPIN(xb_ld(&bar[XB_TOPGEN]) == tg, bar);
            __builtin_amdgcn_fence(__ATOMIC_ACQUIRE, "agent");
            xb_add(&bar[XB_XGEN(b.x)], 1u);
            asm volatile("s_waitcnt vmcnt(0)" ::: "memory");
        } else {
            XB_SPIN(xb_ld(&bar[XB_XGEN(b.x)]) == gen, bar);
            __builtin_amdgcn_fence(__ATOMIC_ACQUIRE, "agent");
            asm volatile("s_waitcnt vmcnt(0)" ::: "memory");
        }
    }
    __syncthreads();
}

struct Args { const float* in[19]; float* out; unsigned char* ws; };

__device__ __forceinline__ int win_map(int n) {
    const int seg = n >> 9, o = n & 511, blk = o >> 7, w = o & 127;
    if (seg == 0) return 256 * blk + w;
    if (seg == 1) return 256 * blk + 128 + w;
    if (seg == 2) return 1024 + o;
    if (seg == 3) return 1536 + 256 * blk + w;
    if (seg == 5) return 1536 + 256 * blk + 128 + w;
    return 2560 + o;
}
template <bool GATE>
__device__ __forceinline__ void tr_item(const float* W, int K, int N, bf16* WT, int drow, LAS float* scr, int k0, int n0, int lane, const float* g, const float* b, float* cp1, float* cp2) {
#pragma unroll
    for (int i = 0; i < 32; ++i) { const int kk = 2 * i + (lane >> 5); scr[kk * 33 + (lane & 31)] = W[(size_t)(k0 + kk) * N + n0 + (lane & 31)]; }
    LDS_WAIT(); asm volatile("" ::: "memory");
    const int c = lane & 7;
    float gs[8];
#pragma unroll
    for (int e = 0; e < 8; ++e) gs[e] = GATE ? g[k0 + 8 * c + e] : 1.0f;
#pragma unroll
    for (int j = 0; j < 4; ++j) { const int n = (lane >> 3) + 8 * j; const LAS float* s = scr + (8 * c) * 33 + n;
        v4u o; o.x = pk2(s[0 * 33] * gs[0], s[1 * 33] * gs[1]); o.y = pk2(s[2 * 33] * gs[2], s[3 * 33] * gs[3]); o.z = pk2(s[4 * 33] * gs[4], s[5 * 33] * gs[5]); o.w = pk2(s[6 * 33] * gs[6], s[7 * 33] * gs[7]);
        *(v4u*)(WT + (size_t)(drow + n) * K + k0 + 8 * c) = o; }
    if (GATE) { const int n = lane & 31, half = lane >> 5; float s1 = 0.f, s2 = 0.f;
#pragma unroll 8
        for (int kk = 0; kk < 32; ++kk) { const int k = 32 * half + kk; const float w = scr[k * 33 + n]; s1 += g[k0 + k] * w; s2 += b[k0 + k] * w; }
        s1 += __shfl_xor(s1, 32); s2 += __shfl_xor(s2, 32);
        if (lane < 32) { cp1[(k0 >> 6) * N + n0 + n] = s1; cp2[(k0 >> 6) * N + n0 + n] = s2; } }
    LDS_WAIT(); asm volatile("" ::: "memory");
}

__device__ __forceinline__ void p0_prologue(const Args& a, LAS unsigned char* lds, int wave, int lane) {
    unsigned char* ws = a.ws;
    LAS float* scr = (LAS float*)(lds + wave * 16384);
    const int gw = blockIdx.x * NWAVES + wave, NGW = gridDim.x * NWAVES;
    constexpr int I_IN = (D / 64) * (DIN / 32), I_OUT = (D / 64) * (D / 32), I_G = I_OUT, I_PLE = (DPLE / 64) * (D / 32);
    constexpr int NITEMS = I_IN + I_OUT + I_G + I_PLE;
    for (int it = gw; it < NITEMS; it += NGW) {
        int r = it;
        if (r < I_IN) { const int nblk = DIN / 32, kb = r / nblk, nb = r % nblk; tr_item<false>(a.in[4], D, DIN, (bf16*)(ws + WS_WIN), win_map(32 * nb), scr, 64 * kb, 32 * nb, lane, nullptr, nullptr, nullptr, nullptr); continue; } r -= I_IN;
        if (r < I_OUT) { const int nblk = D / 32, kb = r / nblk, nb = r % nblk; tr_item<false>(a.in[13], D, D, (bf16*)(ws + WS_WOUT), 32 * nb, scr, 64 * kb, 32 * nb, lane, nullptr, nullptr, nullptr, nullptr); continue; } r -= I_OUT;
        if (r < I_G) { const int nblk = D / 32, kb = r / nblk, nb = r % nblk; tr_item<true>(a.in[17], D, D, (bf16*)(ws + WS_WG), 32 * nb, scr, 64 * kb, 32 * nb, lane, a.in[14], a.in[15], (float*)(ws + WS_CP1), (float*)(ws + WS_CP2)); continue; } r -= I_G;
        { const int nblk = D / 32, kb = r / nblk, nb = r % nblk; tr_item<false>(a.in[16], DPLE, D, (bf16*)(ws + WS_WPLE), 32 * nb, scr, 64 * kb, 32 * nb, lane, nullptr, nullptr, nullptr, nullptr); }
    }
    {
        const float* x = a.in[0]; bf16* H = (bf16*)(ws + WS_H);
        f32x4 gg[4], bb[4];
#pragma unroll
        for (int j = 0; j < 4; ++j) { gg[j] = *(const f32x4*)(a.in[2] + 4 * lane + 256 * j); bb[j] = *(const f32x4*)(a.in[3] + 4 * lane + 256 * j); }
        for (int m = gw; m < M; m += 2 * NGW) {
            const int m2 = m + NGW; const bool has2 = m2 < M;
            const f32x4* xr = (const f32x4*)(x + (size_t)m * D) + lane; const f32x4* xr2 = (const f32x4*)(x + (size_t)(has2 ? m2 : m) * D) + lane;
            f32x4 v[4], u[4]; float s = 0.f, t = 0.f;
#pragma unroll
            for (int j = 0; j < 4; ++j) v[j] = xr[64 * j];
#pragma unroll
            for (int j = 0; j < 4; ++j) u[j] = xr2[64 * j];
#pragma unroll
            for (int j = 0; j < 4; ++j) { s += (v[j][0] + v[j][1]) + (v[j][2] + v[j][3]); t += (u[j][0] + u[j][1]) + (u[j][2] + u[j][3]); }
            const float mean = wave_sum(s) * (1.f / D), mean2 = wave_sum(t) * (1.f / D); float s2 = 0.f, t2 = 0.f;
#pragma unroll
            for (int j = 0; j < 4; ++j) { v[j] = v[j] - mean; s2 += (v[j][0] * v[j][0] + v[j][1] * v[j][1]) + (v[j][2] * v[j][2] + v[j][3] * v[j][3]);
                                          u[j] = u[j] - mean2; t2 += (u[j][0] * u[j][0] + u[j][1] * u[j][1]) + (u[j][2] * u[j][2] + u[j][3] * u[j][3]); }
            const float rstd = 1.f / sqrtf(wave_sum(s2) * (1.f / D) + LN_EPS), rstd2 = 1.f / sqrtf(wave_sum(t2) * (1.f / D) + LN_EPS);
            v2u* o8 = (v2u*)(H + (size_t)m * D) + lane;
#pragma unroll
            for (int j = 0; j < 4; ++j) { const f32x4 y = v[j] * rstd * gg[j] + bb[j]; o8[64 * j] = (v2u){pk2(y[0], y[1]), pk2(y[2], y[3])}; }
            if (has2) { v2u* o9 = (v2u*)(H + (size_t)m2 * D) + lane;
#pragma unroll
                for (int j = 0; j < 4; ++j) { const f32x4 y = u[j] * rstd2 * gg[j] + bb[j]; o9[64 * j] = (v2u){pk2(y[0], y[1]), pk2(y[2], y[3])}; } }
        }
    }
    {
        const float* p = a.in[1]; bf16* Pb = (bf16*)(ws + WS_PB);
        const int gt = blockIdx.x * NTHR + threadIdx.x, NGT = gridDim.x * NTHR;
        for (int i = gt; i < M * DPLE / 8; i += NGT) { const f32x4 a0 = *(const f32x4*)(p + (size_t)i * 8), a1 = *(const f32x4*)(p + (size_t)i * 8 + 4);
            *(v4u*)(Pb + (size_t)i * 8) = (v4u){pk2(a0[0], a0[1]), pk2(a0[2], a0[3]), pk2(a1[0], a1[1]), pk2(a1[2], a1[3])}; }
        const float* wsrc = a.in[11]; bf16* Wsb = (bf16*)(ws + WS_WSB);
        for (int i = gt; i < NHEAD * CHUNK * CHUNK / 8; i += NGT) { const int t = (i >> 4) & 127, s0 = (i & 15) * 8;
            const f32x4 a0 = *(const f32x4*)(wsrc + (size_t)i * 8), a1 = *(const f32x4*)(wsrc + (size_t)i * 8 + 4);
            float e[8] = {a0[0], a0[1], a0[2], a0[3], a1[0], a1[1], a1[2], a1[3]};
#pragma unroll
            for (int k = 0; k < 8; ++k) e[k] = (s0 + k <= t) ? e[k] : 0.f;
            *(v4u*)(Wsb + (size_t)i * 8) = (v4u){pk2(e[0], e[1]), pk2(e[2], e[3]), pk2(e[4], e[5]), pk2(e[6], e[7])}; }
    }
}

template <int J> struct ConvStep {
    static __device__ __forceinline__ void run(f32x2 (&acc)[16], const f32x2 (&w)[CW], const LAS unsigned char* p) {
        const unsigned d = *(const LAS unsigned*)(p + J * 1024); const f32x2 v = (f32x2){bf_lo(d), bf_hi(d)};
#pragma unroll
        for (int k = 0; k < CW; ++k) { const int t = J - k; if (t >= 0 && t < 16) acc[t] += w[k] * v; }
        ConvStep<J + 1>::run(acc, w, p);
    }
};
template <> struct ConvStep<46> { static __device__ __forceinline__ void run(f32x2 (&)[16], const f32x2 (&)[CW], const LAS unsigned char*) {} };
__device__ __forceinline__ void conv_item(LAS unsigned char* lds, int it, const bf16* Ab, const bf16* SZ, bf16* Y, const f32x2 (&w)[CW], f32x2 cb,
                                          const float* lng, const float* lnb, int tid, int wave, int lane) {
    const int m0 = it * 32, t0 = m0 & (SEQ - 1);
    LAS unsigned char* in = lds; LAS float* outt = (LAS float*)(lds + 65536);
    {
        v4u v[8];
#pragma unroll
        for (int i = 0; i < 8; ++i) { const int q = tid + i * NTHR, row = q >> 6, c16 = q & 63; v[i] = (v4u){0u, 0u, 0u, 0u};
            if (q < 62 * 64 && t0 - 30 + row >= 0) v[i] = *(const v4u*)(Ab + (size_t)(m0 - 30 + row) * DC + c16 * 8); }
#pragma unroll
        for (int i = 0; i < 8; ++i) { const int q = tid + i * NTHR, row = q >> 6, c16 = q & 63; if (q < 62 * 64) *(LAS v4u*)(in + row * 1024 + c16 * 16) = v[i]; }
    }
    __syncthreads();
    const int cp = tid & 255, rh = tid >> 8;
    f32x2 acc[16];
#pragma unroll
    for (int t = 0; t < 16; ++t) acc[t] = (f32x2){0.f, 0.f};
    ConvStep<0>::run(acc, w, in + (16 * rh) * 1024 + cp * 4);
#pragma unroll
    for (int t = 0; t < 16; ++t) *(LAS f32x2*)(outt + (16 * rh + t) * DC + 2 * cp) = acc[t] + cb;
    __syncthreads();
    {
        f32x4 gg[2], bb[2]; v2u zz[4][2];
#pragma unroll
        for (int j = 0; j < 2; ++j) { const int c = 4 * lane + 256 * j; gg[j] = *(const f32x4*)(lng + c); bb[j] = *(const f32x4*)(lnb + c);
#pragma unroll
            for (int rr = 0; rr < 4; ++rr) zz[rr][j] = *(const v2u*)(SZ + (size_t)(m0 + 4 * wave + rr) * DC + c); }
#pragma unroll
        for (int rr = 0; rr < 4; ++rr) { const int row = 4 * wave + rr; const size_t m = (size_t)(m0 + row);
            f32x4 v[2]; float s = 0.f;
#pragma unroll
            for (int j = 0; j < 2; ++j) { v[j] = *(const LAS f32x4*)(outt + row * DC + 4 * lane + 256 * j); s += (v[j][0] + v[j][1]) + (v[j][2] + v[j][3]); }
            const float mean = wave_sum(s) * (1.f / DC); float s2 = 0.f;
#pragma unroll
            for (int j = 0; j < 2; ++j) { v[j] = v[j] - mean; s2 += (v[j][0] * v[j][0] + v[j][1] * v[j][1]) + (v[j][2] * v[j][2] + v[j][3] * v[j][3]); }
            const float rstd = 1.f / sqrtf(wave_sum(s2) * (1.f / DC) + LN_EPS);
#pragma unroll
            for (int j = 0; j < 2; ++j) { const int c = 4 * lane + 256 * j;
                f32x4 y = v[j] * rstd * gg[j] + bb[j];
                y = (f32x4){y[0] * sigm_f(y[0]), y[1] * sigm_f(y[1]), y[2] * sigm_f(y[2]), y[3] * sigm_f(y[3])};
                y = y * (f32x4){bf_lo(zz[rr][j].x), bf_hi(zz[rr][j].x), bf_lo(zz[rr][j].y), bf_hi(zz[rr][j].y)};
                *(v2u*)(Y + m * D + c) = (v2u){pk2(y[0], y[1]), pk2(y[2], y[3])}; } }
    }
    __syncthreads();
}

__device__ __forceinline__ void sgu_item(LAS unsigned char* lds, int it, const bf16* GV, const bf16* UG, const bf16* Wsb, const float* bs, const float* lng, const float* lnb, bf16* Y,
                                         int tid, int wave, int lane) {
    constexpr int RS = 516;
    const int c = it >> 1, hh = it & 1, m0 = c * CHUNK;
    {
        const f32x4 g0 = *(const f32x4*)(lng + 8 * lane), g1 = *(const f32x4*)(lng + 8 * lane + 4), b0 = *(const f32x4*)(lnb + 8 * lane), b1 = *(const f32x4*)(lnb + 8 * lane + 4);
        v4u raw[16];
#pragma unroll
        for (int i = 0; i < 16; ++i) raw[i] = *(const v4u*)(GV + (size_t)(m0 + 16 * wave + i) * DC + 8 * lane);
#pragma unroll
        for (int i = 0; i < 16; ++i) {
            f32x4 x0 = (f32x4){bf_lo(raw[i].x), bf_hi(raw[i].x), bf_lo(raw[i].y), bf_hi(raw[i].y)}, x1 = (f32x4){bf_lo(raw[i].z), bf_hi(raw[i].z), bf_lo(raw[i].w), bf_hi(raw[i].w)};
            const float s = (x0[0] + x0[1]) + (x0[2] + x0[3]) + (x1[0] + x1[1]) + (x1[2] + x1[3]);
            const float mean = wave_sum(s) * (1.f / DC);
            x0 = x0 - mean; x1 = x1 - mean;
            const float q = (x0[0] * x0[0] + x0[1] * x0[1]) + (x0[2] * x0[2] + x0[3] * x0[3]) + (x1[0] * x1[0] + x1[1] * x1[1]) + (x1[2] * x1[2] + x1[3] * x1[3]);
            const float rstd = 1.f / sqrtf(wave_sum(q) * (1.f / DC) + LN_EPS);
            x0 = x0 * rstd * g0 + b0; x1 = x1 * rstd * g1 + b1;
            if ((lane >> 5) == hh) { LAS unsigned* dst = (LAS unsigned*)(lds + (16 * wave + i) * RS + (lane & 31) * 16);
                dst[0] = pk2(x0[0], x0[1]); dst[1] = pk2(x0[2], x0[3]); dst[2] = pk2(x1[0], x1[1]); dst[3] = pk2(x1[2], x1[3]); }
        }
    }
    bf16x8 wf[20]; v2u ugv[8][2]; float biasv[8];
    const int hl = wave >> 1, dh = wave & 1, h = 4 * hh + hl, dbase = hl * 64 + dh * 32, fr = lane & 15, q = lane >> 4;
    {
        int n = 0;
#pragma unroll
        for (int tb = 0; tb < 8; ++tb)
#pragma unroll
            for (int ks = 0; ks < 4; ++ks) if (ks <= (tb >> 1)) { wf[n] = *(const bf16x8*)(Wsb + ((size_t)(h * CHUNK + 16 * tb + fr)) * CHUNK + 32 * ks + 8 * q); ++n; }
#pragma unroll
        for (int tb = 0; tb < 8; ++tb) { const int t = 16 * tb + fr; biasv[tb] = bs[h * CHUNK + t];
#pragma unroll
            for (int nb = 0; nb < 2; ++nb) ugv[tb][nb] = *(const v2u*)(UG + (size_t)(m0 + t) * DC + 256 * hh + dbase + 16 * nb + 4 * q); }
    }
    __syncthreads();
    {
        bf16x8 vf[2][4];
#pragma unroll
        for (int nb = 0; nb < 2; ++nb)
#pragma unroll
            for (int ks = 0; ks < 4; ++ks)
#pragma unroll
                for (int jj = 0; jj < 8; ++jj) vf[nb][ks][jj] = (short)*(const LAS unsigned short*)(lds + (32 * ks + 8 * q + jj) * RS + 2 * (dbase + 16 * nb + fr));
        f32x4 acc[8][2];
#pragma unroll
        for (int tb = 0; tb < 8; ++tb) { acc[tb][0] = (f32x4){0.f, 0.f, 0.f, 0.f}; acc[tb][1] = (f32x4){0.f, 0.f, 0.f, 0.f}; }
        int n = 0;
#pragma unroll
        for (int tb = 0; tb < 8; ++tb)
#pragma unroll
            for (int ks = 0; ks < 4; ++ks) if (ks <= (tb >> 1)) {
                acc[tb][0] = __builtin_amdgcn_mfma_f32_16x16x32_bf16(vf[0][ks], wf[n], acc[tb][0], 0, 0, 0);
                acc[tb][1] = __builtin_amdgcn_mfma_f32_16x16x32_bf16(vf[1][ks], wf[n], acc[tb][1], 0, 0, 0); ++n; }
#pragma unroll
        for (int tb = 0; tb < 8; ++tb) { const int t = 16 * tb + fr; const size_t m = (size_t)(m0 + t);
#pragma unroll
            for (int nb = 0; nb < 2; ++nb) { const int col = 256 * hh + dbase + 16 * nb + 4 * q; const v2u ug = ugv[tb][nb];
                const f32x4 o = (acc[tb][nb] + biasv[tb]) * (f32x4){bf_lo(ug.x), bf_hi(ug.x), bf_lo(ug.y), bf_hi(ug.y)};
                *(v2u*)(Y + m * D + DC + col) = (v2u){pk2(o[0], o[1]), pk2(o[2], o[3])}; } }
    }
    __syncthreads();
}

__device__ __forceinline__ void p2_mixer(const Args& a, LAS unsigned char* lds, int tid, int wave, int lane) {
    unsigned char* ws = a.ws;
    const bf16* Ab = (const bf16*)(ws + WS_AB); const bf16* SZ = (const bf16*)(ws + WS_SZ); const bf16* UG = (const bf16*)(ws + WS_UG); const bf16* GV = (const bf16*)(ws + WS_GV);
    bf16* Y = (bf16*)(ws + WS_Y);
    for (int rep = 0; rep < REP_SGU; ++rep)
    for (int it = blockIdx.x; it < M / CHUNK * 2; it += gridDim.x)
        sgu_item(lds, it, GV, UG, (const bf16*)(ws + WS_WSB), a.in[12], a.in[9], a.in[10], Y, tid, wave, lane);
    {
        const int cp = tid & 255;
        f32x2 w[CW];
#pragma unroll
        for (int k = 0; k < CW; ++k) w[k] = *(const f32x2*)(a.in[5] + k * DC + 2 * cp);
        const f32x2 cb = *(const f32x2*)(a.in[6] + 2 * cp);
        for (int rep = 0; rep < REP_CONV; ++rep)
        for (int it = blockIdx.x; it < M / 32; it += gridDim.x)
            conv_item(lds, it, Ab, SZ, Y, w, cb, a.in[7], a.in[8], tid, wave, lane);
    }
}

__global__ void __launch_bounds__(NTHR, 2) fwd_megakernel(Args a) {
    extern __shared__ __attribute__((aligned(16))) unsigned char lds_raw[];
    LAS unsigned char* lds = (LAS unsigned char*)lds_raw;
    cg::grid_group grid = cg::this_grid();
#define FRESH_IDS int tid = threadIdx.x; asm volatile("" : "+v"(tid)); const int lane = tid & 63, wave = __builtin_amdgcn_readfirstlane(tid >> 6); (void)lane; (void)wave;
    unsigned char* ws = a.ws;
    const int G = gridDim.x;
    if (threadIdx.x < 32) ((LAS unsigned*)(lds + MISC_OFF))[threadIdx.x] = 0u;
    __syncthreads();
    const XcdBarrier bar = xcd_barrier_post((unsigned*)(ws + WS_BAR), (volatile LAS unsigned*)(lds + MISC_OFF));
    if (ws == nullptr) grid.sync();
#define GRID_BAR() xcd_barrier(bar)

#ifndef NO_P0
    for (int rep = 0; rep < REP_P0; ++rep) { FRESH_IDS p0_prologue(a, lds, wave, lane); }
#endif
    GRID_BAR();

#ifndef NO_P1
    for (int rep = 0; rep < REP_P1; ++rep) {
#ifndef NO_PE
    {
        pg8::Gemm g{(const bf16*)(ws + WS_PB), (const bf16*)(ws + WS_WPLE), M, D, DPLE}; pg8::StaticOrder S; S.init(M, D, G, (int)blockIdx.x);
        pg8::EpiBf16<0> E{(bf16*)(ws + WS_PE), D, nullptr, 0, 0, 1.f};
        pg8::gemm_phase<pg8::EpiBf16<0>, pg8::StaticOrder, PG8_ALIGN, PG8_SP2>(lds, g, S, E);
    }
#endif
#ifndef NO_IN
    {
        pg8::Gemm g{(const bf16*)(ws + WS_H), (const bf16*)(ws + WS_WIN), M, DIN, D}; pg8::StaticOrder S; S.init(M, DIN, G, (int)blockIdx.x);
        pg8::EpiP1 E{(bf16*)(ws + WS_AB), (bf16*)(ws + WS_SZ), (bf16*)(ws + WS_UG), (bf16*)(ws + WS_GV)};
        pg8::gemm_phase<pg8::EpiP1, pg8::StaticOrder, PG8_ALIGN, PG8_SP2>(lds, g, S, E);
    }
#endif
    }
#endif
    GRID_BAR();

#ifndef NO_P2
    for (int rep = 0; rep < REP_P2; ++rep) { FRESH_IDS p2_mixer(a, lds, tid, wave, lane); }
#endif
    GRID_BAR();

#ifndef NO_P3
    for (int rep = 0; rep < REP_P3; ++rep)
    {
        pg8::Gemm g{(const bf16*)(ws + WS_Y), (const bf16*)(ws + WS_WOUT), M, D, D}; pg8::StaticOrder S; S.init(M, D, G, (int)blockIdx.x);
        pg8::EpiP3 E{(const bf16*)(ws + WS_H), (bf16*)(ws + WS_RB), (float*)(ws + WS_STATSP), ALPHA};
        pg8::gemm_phase<pg8::EpiP3, pg8::StaticOrder, false, PG8_SP2>(lds, g, S, E);
    }
#endif
    GRID_BAR();

#ifndef NO_P4
    for (int rep = 0; rep < REP_P4; ++rep)
    {
        pg8::Gemm g{(const bf16*)(ws + WS_RB), (const bf16*)(ws + WS_WG), M, D, D}; pg8::StaticOrder S; S.init(M, D, G, (int)blockIdx.x);
        pg8::EpiP4 E{(const bf16*)(ws + WS_RB), (const bf16*)(ws + WS_PE), (const float*)(ws + WS_STATSP), (const float*)(ws + WS_CP1), (const float*)(ws + WS_CP2), a.in[18], a.in[14], a.in[15], a.out, LN_EPS};
        pg8::gemm_phase<pg8::EpiP4, pg8::StaticOrder, false, PG8_SP2>(lds, g, S, E);
    }
#endif
}

extern "C" void kernel_launch(void* const* d_in, const int* in_sizes, int n_in, void* d_out, int out_size, void* d_ws, size_t ws_size, hipStream_t stream) {
    static int grid = 0;
    if (grid == 0) {
        if (n_in != 19 || in_sizes[0] != M * D || out_size != M * D || ws_size < WS_END) { fprintf(stderr, "kernel_launch: unexpected shapes (n_in %d, in0 %d, out %d, ws %zu)\n", n_in, n_in > 0 ? in_sizes[0] : -1, out_size, ws_size); grid = -1; return; }
        int dev = 0, cus = 0, per_cu = 0;
        if (hipGetDevice(&dev) != hipSuccess || hipDeviceGetAttribute(&cus, hipDeviceAttributeMultiprocessorCount, dev) != hipSuccess) { fprintf(stderr, "kernel_launch: device query failed\n"); grid = -1; return; }
        if (hipFuncSetAttribute((const void*)fwd_megakernel, hipFuncAttributeMaxDynamicSharedMemorySize, LDS_BYTES) != hipSuccess) { fprintf(stderr, "kernel_launch: hipFuncSetAttribute failed\n"); grid = -1; return; }
        if (hipOccupancyMaxActiveBlocksPerMultiprocessor(&per_cu, (const void*)fwd_megakernel, NTHR, LDS_BYTES) != hipSuccess || per_cu < 1) { fprintf(stderr, "kernel_launch: occupancy query says %d\n", per_cu); per_cu = 1; }
        (void)hipGetLastError();
        grid = cus * 1;
    }
    if (grid < 0) return;
    Args a{};
    for (int i = 0; i < 19; ++i) a.in[i] = (const float*)d_in[i];
    a.out = (float*)d_out; a.ws = (unsigned char*)d_ws;
    if (hipMemsetAsync((char*)d_ws + WS_BAR, 0, BAR_ZERO_BYTES, stream) != hipSuccess) { fprintf(stderr, "kernel_launch: memset failed\n"); return; }
    void* args[] = {&a};
    hipError_t e = hipLaunchCooperativeKernel((const void*)fwd_megakernel, dim3(grid), dim3(NTHR), args, LDS_BYTES, stream);
    if (e != hipSuccess) fprintf(stderr, "kernel_launch: cooperative launch failed: %s (grid %d)\n", hipGetErrorString(e), grid);
}
```

```cpp
#include <hip/hip_runtime.h>
#include <hip/hip_cooperative_groups.h>
#include <cstdio>
#include <cstdint>
namespace cg = cooperative_groups;
namespace pg8 {
#define PG8_LAS __attribute__((address_space(3)))
typedef unsigned short bf16_t;
typedef short bf16x8 __attribute__((ext_vector_type(8)));
typedef float f32x4 __attribute__((ext_vector_type(4)));
typedef unsigned u32x4 __attribute__((ext_vector_type(4)));
constexpr int BM = 256, BK = 64, HALF = 128, HTB = HALF * BK * 2  , STAGE_BYTES = 8 * HTB, NXCD = 8, WGM = 8;

__host__ __device__ __forceinline__ int lds_byte(int r, int c) { const int st = (r >> 4) * 2 + (c >> 5), rr = r & 15, cc = c & 31, ob = rr * 64 + cc * 2; return st * 1024 + (ob ^ (((ob >> 9) & 1) << 5)); }
__host__ __device__ __forceinline__ void stage_rc(int b, int& R, int& C) { const int st = b / 1024, sb = b % 1024, swz = sb ^ (((sb >> 9) & 1) << 5); R = (st >> 1) * 16 + swz / 64; C = (st & 1) * 32 + (swz % 64) / 2; }
__host__ __device__ __forceinline__ int perm32(int rho) { const int n = rho >> 4, i = rho & 15; return 8 * (i >> 2) + 4 * n + (i & 3); }

struct Unit { int pm, pn; };
struct Gemm { const bf16_t* A; const bf16_t* Bt; int M, N, K; };

struct StaticOrder {
    int nM, nN, nwg, G, c;
    __host__ __device__ void init(int M, int N, int G_, int c_) { nM = M / BM; nN = N / BM; nwg = nM * nN; G = G_; c = c_; }
    __host__ __device__ bool next(int i, Unit& u) const {
        const long L = (long)i * G + c; if (L >= nwg) return false;
        int wgid = (int)L; { const int q = nwg / NXCD, r = nwg % NXCD, xcd = wgid % NXCD, off = wgid / NXCD; wgid = (xcd < r ? xcd * (q + 1) : r * (q + 1) + (xcd - r) * q) + off; }
        const int nig = WGM * nN, gid = wgid / nig, fm = gid * WGM, gsz = (nM - fm) < WGM ? (nM - fm) : WGM;
        u.pm = fm + ((wgid % nig) % gsz); u.pn = (wgid % nig) / gsz; return true;
    }
    __device__ __forceinline__ void a_ready(const Unit&) const {}
    __device__ __forceinline__ void done(const Unit&) const {}
};

__device__ __forceinline__ unsigned cvt_pk_bf16(float lo, float hi) { unsigned r; asm volatile("v_cvt_pk_bf16_f32 %0, %1, %2" : "=v"(r) : "v"(lo), "v"(hi)); return r; }
typedef float f32x2 __attribute__((ext_vector_type(2)));
__device__ __forceinline__ f32x2 gelu_pk(f32x2 v) {
    const f32x2 av = __builtin_elementwise_abs(v), d = av * 0.2316418882f + 1.0f;
    f32x2 t; t.x = __builtin_amdgcn_rcpf(d.x); t.y = __builtin_amdgcn_rcpf(d.y);
    f32x2 q = t * 0.5307027145f + (-0.7265760135f); q = q * t + 0.7107068705f; q = q * t + (-0.142248368f); q = q * t + 0.127414796f; q = q * t;
    const f32x2 s = (v * v) * (-0.72134752044f);
    f32x2 e; e.x = __builtin_amdgcn_exp2f(s.x); e.y = __builtin_amdgcn_exp2f(s.y);
    const f32x2 m = v * (q * e), r = v - m;
    f32x2 o; o.x = v.x < 0.f ? m.x : r.x; o.y = v.y < 0.f ? m.y : r.y; return o;
}

template <int ACT  > struct EpiBf16 {
    static constexpr bool PERM = true, AFTER_DRAIN = false; static constexpr int REP = 1; static_assert(ACT == 0 || ACT == 1, "EpiBf16: ACT is 0 (none) or 1 (gelu_pk)");
    bf16_t* O; int ldc; const float* bias; int split_cols; size_t split_stride; float scale0;
    __device__ __forceinline__ void operator()(const f32x4 (&acc)[2][2][4][2], const Unit& u, int wr, int wc, int fr, int fq) const {
        const int row0 = u.pm * BM + wr * 64 + fr; int colt = u.pn * BM; bf16_t* base = O;
        float sc = 1.f; if (split_cols) { const int t = colt / split_cols; base += (size_t)t * split_stride; colt -= t * split_cols; if (t == 0) sc = scale0; }
        const int col0 = colt + wc * 32 + 8 * fq, bcol0 = u.pn * BM + wc * 32 + 8 * fq;
        f32x4 bv[2][2];
#pragma unroll
        for (int bj = 0; bj < 2; ++bj)
#pragma unroll
            for (int n = 0; n < 2; ++n) bv[bj][n] = bias ? *(const f32x4*)(bias + bcol0 + bj * HALF + 4 * n) : (f32x4){0.f, 0.f, 0.f, 0.f};
#pragma unroll
        for (int ai = 0; ai < 2; ++ai)
#pragma unroll
            for (int m = 0; m < 4; ++m) { bf16_t* rowp = base + (size_t)(row0 + ai * HALF + m * 16) * ldc + col0;
#pragma unroll
                for (int bj = 0; bj < 2; ++bj) { f32x4 v0 = acc[ai][bj][m][0] + bv[bj][0], v1 = acc[ai][bj][m][1] + bv[bj][1];
                    if (ACT == 1) { f32x2 a = gelu_pk((f32x2){v0[0], v0[1]}), b = gelu_pk((f32x2){v0[2], v0[3]}), c = gelu_pk((f32x2){v1[0], v1[1]}), d = gelu_pk((f32x2){v1[2], v1[3]});
                        v0 = (f32x4){a.x, a.y, b.x, b.y}; v1 = (f32x4){c.x, c.y, d.x, d.y}; }
                    v0 = v0 * sc; v1 = v1 * sc; u32x4 w; w.x = cvt_pk_bf16(v0[0], v0[1]); w.y = cvt_pk_bf16(v0[2], v0[3]); w.z = cvt_pk_bf16(v1[0], v1[1]); w.w = cvt_pk_bf16(v1[2], v1[3]);
                    *(u32x4*)(rowp + bj * HALF) = w; } }
    }
};
#ifndef REP_E1
#define REP_E1 1
#endif
#ifndef REP_E3
#define REP_E3 1
#endif
#ifndef REP_E4
#define REP_E4 1
#endif
__device__ __forceinline__ float sigm(float x) { return __builtin_amdgcn_rcpf(1.0f + __builtin_amdgcn_exp2f(-1.44269504089f * x)); }
__device__ __forceinline__ f32x4 sigm4(f32x4 v) { return (f32x4){sigm(v[0]), sigm(v[1]), sigm(v[2]), sigm(v[3])}; }
__device__ __forceinline__ f32x4 gelu4(f32x4 v) { const f32x2 a = gelu_pk((f32x2){v[0], v[1]}), b = gelu_pk((f32x2){v[2], v[3]}); return (f32x4){a.x, a.y, b.x, b.y}; }
__device__ __forceinline__ u32x4 pack8(f32x4 v0, f32x4 v1) { u32x4 w; w.x = cvt_pk_bf16(v0[0], v0[1]); w.y = cvt_pk_bf16(v0[2], v0[3]); w.z = cvt_pk_bf16(v1[0], v1[1]); w.w = cvt_pk_bf16(v1[2], v1[3]); return w; }
__device__ __forceinline__ f32x4 unpk_lo(u32x4 w) { return (f32x4){__uint_as_float(w.x << 16), __uint_as_float(w.x & 0xffff0000u), __uint_as_float(w.y << 16), __uint_as_float(w.y & 0xffff0000u)}; }
__device__ __forceinline__ f32x4 unpk_hi(u32x4 w) { return (f32x4){__uint_as_float(w.z << 16), __uint_as_float(w.z & 0xffff0000u), __uint_as_float(w.w << 16), __uint_as_float(w.w & 0xffff0000u)}; }

struct EpiP1 {
    static constexpr bool PERM = true, AFTER_DRAIN = false; static constexpr int REP = REP_E1;
    bf16_t *Ab, *SZ, *UG, *GV;
    __device__ __forceinline__ void operator()(const f32x4 (&acc)[2][2][4][2], const Unit& u, int wr, int wc, int fr, int fq) const {
        const int row0 = u.pm * BM + wr * 64 + fr, pn = u.pn, cl = wc * 32 + 8 * fq;
        if (pn < 4 || (pn >= 6 && pn < 10)) {
            const bool glu = pn < 4; bf16_t* base = glu ? Ab : UG; const int colt = 128 * (glu ? pn : pn - 6) + cl;
#pragma unroll
            for (int ai = 0; ai < 2; ++ai)
#pragma unroll
                for (int m = 0; m < 4; ++m) { bf16_t* rowp = base + (size_t)(row0 + ai * HALF + m * 16) * 512 + colt;
                    const f32x4 v0 = acc[ai][0][m][0], v1 = acc[ai][0][m][1], g0 = acc[ai][1][m][0], g1 = acc[ai][1][m][1];
                    f32x4 o0, o1;
                    if (glu) { o0 = v0 * sigm4(g0); o1 = v1 * sigm4(g1); }
                    else { o0 = gelu4(v0) * (g0 * sigm4(g0)); o1 = gelu4(v1) * (g1 * sigm4(g1)); }
                    *(u32x4*)rowp = pack8(o0, o1); }
        } else {
            const bool sil = pn < 6; bf16_t* base = sil ? SZ : GV; const int colt = 256 * (sil ? pn - 4 : pn - 10) + cl;
#pragma unroll
            for (int ai = 0; ai < 2; ++ai)
#pragma unroll
                for (int m = 0; m < 4; ++m) { bf16_t* rowp = base + (size_t)(row0 + ai * HALF + m * 16) * 512 + colt;
#pragma unroll
                    for (int bj = 0; bj < 2; ++bj) { const f32x4 v0 = acc[ai][bj][m][0], v1 = acc[ai][bj][m][1]; f32x4 o0, o1;
                        if (sil) { o0 = v0 * sigm4(v0); o1 = v1 * sigm4(v1); } else { o0 = gelu4(v0); o1 = gelu4(v1); }
                        *(u32x4*)(rowp + bj * HALF) = pack8(o0, o1); } }
        }
    }
};

struct EpiP3 {
    static constexpr bool PERM = true, AFTER_DRAIN = true; static constexpr int REP = REP_E3;
    const bf16_t* H; bf16_t* RB; float* statsP; float alpha;
    __device__ __forceinline__ void fused(f32x4 (&acc)[2][2][4][2], const Unit& u, int wr, int wc, int fr, int fq, PG8_LAS unsigned char* lds, int wid, int lane) const {
        PG8_LAS f32x2* P = (PG8_LAS f32x2*)lds;
        const int col0 = u.pn * BM + wc * 32 + 8 * fq;
        const size_t off0 = (size_t)(u.pm * BM + wr * 64 + fr) * 1024 + col0;
        u32x4 hv[2][4][2];
#pragma unroll
        for (int ai = 0; ai < 2; ++ai)
#pragma unroll
            for (int m = 0; m < 4; ++m)
#pragma unroll
                for (int bj = 0; bj < 2; ++bj) hv[ai][m][bj] = *(const u32x4*)(H + off0 + (size_t)(ai * HALF + m * 16) * 1024 + bj * HALF);
        asm volatile("" ::: "memory");
#pragma unroll
        for (int ai = 0; ai < 2; ++ai)
#pragma unroll
            for (int m = 0; m < 4; ++m) { const int r = ai * HALF + wr * 64 + m * 16 + fr; const size_t off = off0 + (size_t)(ai * HALF + m * 16) * 1024; float s1 = 0.f, s2 = 0.f;
#pragma unroll
                for (int bj = 0; bj < 2; ++bj) { const u32x4 hh = hv[ai][m][bj];
                    const f32x4 v0 = acc[ai][bj][m][0] + alpha * unpk_lo(hh), v1 = acc[ai][bj][m][1] + alpha * unpk_hi(hh);
                    *(u32x4*)(RB + off + bj * HALF) = pack8(v0, v1);
                    s1 += (v0[0] + v0[1]) + (v0[2] + v0[3]) + (v1[0] + v1[1]) + (v1[2] + v1[3]);
                    s2 += (v0[0] * v0[0] + v0[1] * v0[1]) + (v0[2] * v0[2] + v0[3] * v0[3]) + (v1[0] * v1[0] + v1[1] * v1[1]) + (v1[2] * v1[2] + v1[3] * v1[3]); }
                s1 += __shfl_xor(s1, 16); s1 += __shfl_xor(s1, 32); s2 += __shfl_xor(s2, 16); s2 += __shfl_xor(s2, 32);
                if (fq == 0) P[r * 4 + wc] = (f32x2){s1, s2}; }
        __syncthreads();
        const int tid = wid * 64 + lane;
        if (tid < 256) { const f32x2 a = P[tid * 4 + 0], b = P[tid * 4 + 1], c = P[tid * 4 + 2], d = P[tid * 4 + 3];
            *(f32x2*)(statsP + (size_t)(u.pm * BM + tid) * 8 + u.pn * 2) = (f32x2){(a.x + b.x) + (c.x + d.x), (a.y + b.y) + (c.y + d.y)}; }
    }
};

struct EpiP4 {
    static constexpr bool PERM = true, AFTER_DRAIN = true; static constexpr int REP = REP_E4;
    const bf16_t* RB; const bf16_t* PE; const float* statsP; const float* cp1; const float* cp2; const float* bgate; const float* g; const float* b; float* out; float eps;
    __device__ __forceinline__ void fused(f32x4 (&acc)[2][2][4][2], const Unit& u, int wr, int wc, int fr, int fq, PG8_LAS unsigned char* lds, int wid, int lane) const {
        PG8_LAS float* C = (PG8_LAS float*)lds;
        PG8_LAS f32x2* T = (PG8_LAS f32x2*)(lds + 2048);
        const int tid = wid * 64 + lane;
        const size_t off0 = (size_t)(u.pm * BM + wr * 64 + fr) * 1024 + u.pn * BM + wc * 32 + 8 * fq;
        u32x4 rw[2][2], pw[2][2];
#define P4_LOAD(s) do { _Pragma("unroll") for (int mm = 0; mm < 2; ++mm) { const size_t o_ = off0 + (size_t)((((s) >> 1) & 1) * HALF + (((s) & 1) * 2 + mm) * 16) * 1024 + ((s) >> 2) * HALF; \
            rw[(s) & 1][mm] = *(const u32x4*)(RB + o_); pw[(s) & 1][mm] = *(const u32x4*)(PE + o_); } } while (0)
        P4_LOAD(0);
        { const int col = tid & 255, which = tid >> 8; const float* cp = cp1 + which * (16 * 1024); float s = 0.f;
#pragma unroll
          for (int kb = 0; kb < 16; ++kb) s += cp[kb * 1024 + u.pn * BM + col];
          if (which) s += bgate[u.pn * BM + col];
          C[which * 256 + col] = s; }
        if (tid < 256) { const float* sp = statsP + (size_t)(u.pm * BM + tid) * 8; const f32x4 a = *(const f32x4*)sp, bq = *(const f32x4*)(sp + 4);
            const float s1 = (a[0] + a[2]) + (bq[0] + bq[2]), s2 = (a[1] + a[3]) + (bq[1] + bq[3]);
            const float mu = s1 * (1.0f / 1024.0f); float var = s2 * (1.0f / 1024.0f) - mu * mu; var = var < 0.f ? 0.f : var;
            T[tid] = (f32x2){mu, 1.0f / sqrtf(var + eps)}; }
        __syncthreads();
#pragma unroll
        for (int bj = 0; bj < 2; ++bj) {
            const int cl = wc * 32 + 8 * fq + bj * HALF, gc = u.pn * BM + cl;
            const f32x4 c1a = *(const PG8_LAS f32x4*)(C + cl), c1b = *(const PG8_LAS f32x4*)(C + cl + 4), c2a = *(const PG8_LAS f32x4*)(C + 256 + cl), c2b = *(const PG8_LAS f32x4*)(C + 256 + cl + 4);
            const f32x4 ga = *(const f32x4*)(g + gc), gb = *(const f32x4*)(g + gc + 4), ba = *(const f32x4*)(b + gc), bb = *(const f32x4*)(b + gc + 4);
#pragma unroll
            for (int s4 = 0; s4 < 4; ++s4) {
                const int s = bj * 4 + s4, ai = s4 >> 1, mh = s4 & 1;
                if (s + 1 < 8) P4_LOAD(s + 1);
                asm volatile("" ::: "memory");
#pragma unroll
                for (int mm = 0; mm < 2; ++mm) { const int m = 2 * mh + mm, r = ai * HALF + wr * 64 + m * 16 + fr; const f32x2 sr = T[r]; const size_t off = off0 + (size_t)(ai * HALF + m * 16) * 1024 + bj * HALF;
                    const f32x4 r0 = unpk_lo(rw[s & 1][mm]), r1 = unpk_hi(rw[s & 1][mm]), p0 = unpk_lo(pw[s & 1][mm]), p1 = unpk_hi(pw[s & 1][mm]);
                    const f32x4 gp0 = (acc[ai][bj][m][0] - sr.x * c1a) * sr.y + c2a, gp1 = (acc[ai][bj][m][1] - sr.x * c1b) * sr.y + c2b;
                    const f32x4 h0 = (r0 - sr.x) * sr.y * ga + ba, h1 = (r1 - sr.x) * sr.y * gb + bb;
                    *(f32x4*)(out + off) = h0 + sigm4(gp0) * p0; *(f32x4*)(out + off + 4) = h1 + sigm4(gp1) * p1; }
            }
        }
#undef P4_LOAD
    }
};


struct EpiNone {
    static constexpr bool PERM = true, AFTER_DRAIN = false; static constexpr int REP = 1;
    __device__ __forceinline__ void operator()(const f32x4 (&acc)[2][2][4][2], const Unit& u, int wr, int wc, int fr, int fq) const { asm volatile("" :: "v"(acc[0][0][0][0]), "v"(acc[1][1][3][1])); }
};
template <class Epi, class Sched, bool ALIGN_EPI = false, bool SP2 = false>
__device__ __forceinline__ void gemm_phase(PG8_LAS unsigned char* lds, const Gemm g, const Sched& S, const Epi& E) {
    int tid_ = threadIdx.x; asm volatile("" : "+v"(tid_));
    const int tid = tid_, wid = __builtin_amdgcn_readfirstlane(tid >> 6), lane = tid & 63, wr = wid >> 2, wc = wid & 3, fr = lane & 15, fq = lane >> 4;
    const int K = g.K, nt = K / BK;
    unsigned voffA[2], voffB[2];
#pragma unroll
    for (int i = 0; i < 2; ++i) { int R, C; stage_rc(tid * 16 + i * 8192, R, C); const int Rb = Epi::PERM ? ((R & ~31) + perm32(R & 31)) : R;
        voffA[i] = (unsigned)(R * K + C) * 2u; voffB[i] = (unsigned)(Rb * K + C) * 2u; }
    const size_t kstep = (size_t)(BK * 2);
    const size_t hstep = (size_t)HALF * K * 2;
    const size_t tstep = 2 * hstep;
    const unsigned ldsw = (unsigned)wid * 1024u;
    const int aoff = lds_byte(wr * 64 + fr, fq * 8), boff = lds_byte(wc * 32 + fr, fq * 8);
#define PG8_SA(b, h) (((b) * 2 + (h)) * HTB)
#define PG8_SB(b, h) ((4 + (b) * 2 + (h)) * HTB)
#define PG8_STAGE(bufoff, gbase, voff) do { _Pragma("unroll") for (int _i = 0; _i < 2; ++_i) \
        __builtin_amdgcn_global_load_lds((const unsigned*)((const char*)(gbase) + (voff)[_i]), (PG8_LAS unsigned*)(lds + (bufoff) + ldsw + _i * 8192), 16, 0, 0); } while (0)
#define PG8_LDA(dst, b, h) do { _Pragma("unroll") for (int m = 0; m < 4; ++m) _Pragma("unroll") for (int k = 0; k < 2; ++k) dst[m][k] = *(const PG8_LAS bf16x8*)(lds + PG8_SA(b, h) + aoff + m * 2048 + k * 1024); } while (0)
#define PG8_LDB(dst, b, h) do { _Pragma("unroll") for (int n = 0; n < 2; ++n) _Pragma("unroll") for (int k = 0; k < 2; ++k) dst[n][k] = *(const PG8_LAS bf16x8*)(lds + PG8_SB(b, h) + boff + n * 2048 + k * 1024); } while (0)
#define PG8_MMA(ai, bj, At, Bt) do { __builtin_amdgcn_s_setprio(1); _Pragma("unroll") for (int m = 0; m < 4; ++m) _Pragma("unroll") for (int n = 0; n < 2; ++n) _Pragma("unroll") for (int k = 0; k < 2; ++k) \
        acc[ai][bj][m][n] = __builtin_amdgcn_mfma_f32_16x16x32_bf16(Bt[n][k], At[m][k], acc[ai][bj][m][n], 0, 0, 0); __builtin_amdgcn_s_setprio(0); } while (0)
#define PG8_WAIT_V(n) asm volatile("s_waitcnt vmcnt(" #n ")" ::: "memory")
#define PG8_WAIT_L(n) asm volatile("s_waitcnt lgkmcnt(" #n ")" ::: "memory")
#define PG8_BAR __builtin_amdgcn_s_barrier()
#define PG8_SCHED __builtin_amdgcn_sched_barrier(0)
    Unit cur, nxt; int ui = 0;
    if (!S.next(0, cur)) return;
    f32x4 acc[2][2][4][2];
#pragma unroll
    for (int a = 0; a < 2; ++a)
#pragma unroll
        for (int b = 0; b < 2; ++b)
#pragma unroll
            for (int m = 0; m < 4; ++m)
#pragma unroll
                for (int n = 0; n < 2; ++n) acc[a][b][m][n] = (f32x4){0.f, 0.f, 0.f, 0.f};
    bf16x8 At[4][2], B0[2][2], B1[2][2];
    const char* cA = (const char*)g.A + (size_t)cur.pm * tstep; const char* cB = (const char*)g.Bt + (size_t)cur.pn * tstep;
    S.a_ready(cur);
    if constexpr (SP2) {
        PG8_STAGE(PG8_SB(0, 0), cB, voffB); PG8_STAGE(PG8_SB(0, 1), cB + hstep, voffB); PG8_STAGE(PG8_SA(0, 0), cA, voffA); PG8_STAGE(PG8_SA(0, 1), cA + hstep, voffA);
        if (wr == 1) PG8_BAR;
        PG8_WAIT_V(2); PG8_BAR;
        PG8_STAGE(PG8_SB(1, 0), cB + kstep, voffB); PG8_STAGE(PG8_SA(1, 0), cA + kstep, voffA); PG8_STAGE(PG8_SB(1, 1), cB + hstep + kstep, voffB);
        PG8_WAIT_V(6); PG8_BAR;
    } else {
        PG8_STAGE(PG8_SB(0, 0), cB, voffB); PG8_STAGE(PG8_SA(0, 0), cA, voffA); PG8_STAGE(PG8_SB(0, 1), cB + hstep, voffB); PG8_STAGE(PG8_SA(0, 1), cA + hstep, voffA);
        if (wr == 1) PG8_BAR;
        PG8_WAIT_V(4); PG8_BAR;
        PG8_STAGE(PG8_SB(1, 0), cB + kstep, voffB); PG8_STAGE(PG8_SA(1, 0), cA + kstep, voffA); PG8_STAGE(PG8_SB(1, 1), cB + hstep + kstep, voffB);
        PG8_WAIT_V(6); PG8_BAR;
    }
    for (;;) {
        const bool has_next = S.next(ui + 1, nxt);
        const char* nA = has_next ? (const char*)g.A + (size_t)nxt.pm * tstep : cA; const char* nB = has_next ? (const char*)g.Bt + (size_t)nxt.pn * tstep : cB;
        for (int t = 0; t < nt; t += 2) {
            const bool last = (t == nt - 2);
            const char* a1 = cA + (size_t)(t + 1) * kstep;
            const char* a2 = last ? nA : cA + (size_t)(t + 2) * kstep; const char* b2 = last ? nB : cB + (size_t)(t + 2) * kstep;
            const char* a3 = a2 + kstep; const char* b3 = b2 + kstep;
            if (last && has_next) S.a_ready(nxt);
            if constexpr (SP2) {
            PG8_LDB(B0, 0, 0); PG8_LDB(B1, 0, 1); PG8_SCHED; PG8_LDA(At, 0, 0); PG8_STAGE(PG8_SA(1, 1), a1 + hstep, voffA);
            PG8_WAIT_V(8); PG8_WAIT_L(0); PG8_BAR; PG8_MMA(0, 0, At, B0); PG8_MMA(0, 1, At, B1); PG8_BAR; PG8_SCHED;
            PG8_LDA(At, 0, 1); PG8_STAGE(PG8_SB(0, 0), b2, voffB); PG8_STAGE(PG8_SB(0, 1), b2 + hstep, voffB); PG8_STAGE(PG8_SA(0, 0), a2, voffA);
            PG8_WAIT_V(8); PG8_WAIT_L(0); PG8_BAR; PG8_MMA(1, 0, At, B0); PG8_MMA(1, 1, At, B1); PG8_BAR; PG8_SCHED;
            PG8_LDB(B0, 1, 0); PG8_LDB(B1, 1, 1); PG8_SCHED; PG8_LDA(At, 1, 0); PG8_STAGE(PG8_SA(0, 1), a2 + hstep, voffA);
            PG8_WAIT_V(8); PG8_WAIT_L(0); PG8_BAR; PG8_MMA(0, 0, At, B0); PG8_MMA(0, 1, At, B1); PG8_BAR; PG8_SCHED;
            PG8_LDA(At, 1, 1); PG8_STAGE(PG8_SB(1, 0), b3, voffB); PG8_STAGE(PG8_SB(1, 1), b3 + hstep, voffB); PG8_STAGE(PG8_SA(1, 0), a3, voffA);
            PG8_WAIT_V(8); PG8_WAIT_L(0); PG8_BAR; PG8_MMA(1, 0, At, B0); PG8_MMA(1, 1, At, B1); PG8_BAR; PG8_SCHED;
            } else {
            PG8_LDB(B0, 0, 0); PG8_SCHED; PG8_LDA(At, 0, 0); PG8_STAGE(PG8_SA(1, 1), a1 + hstep, voffA);
            PG8_WAIT_L(8); PG8_BAR; PG8_WAIT_L(0); PG8_MMA(0, 0, At, B0); PG8_BAR; PG8_SCHED;
            PG8_LDB(B1, 0, 1); PG8_STAGE(PG8_SB(0, 0), b2, voffB);
            PG8_BAR; PG8_WAIT_L(0); PG8_MMA(0, 1, At, B1); PG8_BAR;
            PG8_LDA(At, 0, 1); PG8_STAGE(PG8_SA(0, 0), a2, voffA);
            PG8_BAR; PG8_WAIT_L(0); PG8_MMA(1, 0, At, B0); PG8_BAR; PG8_SCHED;
            PG8_STAGE(PG8_SB(0, 1), b2 + hstep, voffB);
            PG8_WAIT_V(6); PG8_BAR; PG8_MMA(1, 1, At, B1); PG8_BAR;
            PG8_LDB(B0, 1, 0); PG8_SCHED; PG8_LDA(At, 1, 0); PG8_STAGE(PG8_SA(0, 1), a2 + hstep, voffA);
            PG8_WAIT_L(8); PG8_BAR; PG8_WAIT_L(0); PG8_MMA(0, 0, At, B0); PG8_BAR; PG8_SCHED;
            PG8_LDB(B1, 1, 1); PG8_STAGE(PG8_SB(1, 0), b3, voffB);
            PG8_BAR; PG8_WAIT_L(0); PG8_MMA(0, 1, At, B1); PG8_BAR;
            PG8_LDA(At, 1, 1); PG8_STAGE(PG8_SA(1, 0), a3, voffA);
            PG8_BAR; PG8_WAIT_L(0); PG8_MMA(1, 0, At, B0); PG8_BAR; PG8_SCHED;
            PG8_STAGE(PG8_SB(1, 1), b3 + hstep, voffB);
            PG8_WAIT_V(6); PG8_BAR; PG8_MMA(1, 1, At, B1); PG8_BAR;
            }
        }
        if constexpr (ALIGN_EPI) { if (wr == 0) PG8_BAR; }
        if constexpr (!Epi::AFTER_DRAIN) { E(acc, cur, wr, wc, fr, fq); if constexpr (Epi::REP > 1) { asm volatile("" ::: "memory"); E(acc, cur, wr, wc, fr, fq); } S.done(cur); }
        if (!has_next) break;
#pragma unroll
        for (int a = 0; a < 2; ++a)
#pragma unroll
            for (int b = 0; b < 2; ++b)
#pragma unroll
                for (int m = 0; m < 4; ++m)
#pragma unroll
                    for (int n = 0; n < 2; ++n) acc[a][b][m][n] = (f32x4){0.f, 0.f, 0.f, 0.f};
        cur = nxt; cA = nA; cB = nB; ++ui;
        if constexpr (ALIGN_EPI) { if (wr == 1) PG8_BAR; }
    }
    PG8_WAIT_V(0);
    if constexpr (!ALIGN_EPI) { if (wr == 0) PG8_BAR; }
    PG8_BAR;
    if constexpr (Epi::AFTER_DRAIN) { E.fused(acc, cur, wr, wc, fr, fq, lds, wid, lane); if constexpr (Epi::REP > 1) { __syncthreads(); E.fused(acc, cur, wr, wc, fr, fq, lds, wid, lane); } S.done(cur); }
#undef PG8_SA
#undef PG8_SB
#undef PG8_STAGE
#undef PG8_LDA
#undef PG8_LDB
#undef PG8_MMA
#undef PG8_WAIT_V
#undef PG8_WAIT_L
#undef PG8_BAR
#undef PG8_SCHED
}
}
#ifndef REP_SGU
#define REP_SGU 1
#endif
#ifndef REP_CONV
#define REP_CONV 1
#endif
#ifndef REP_P0
#define REP_P0 1
#endif
#ifndef REP_P1
#define REP_P1 1
#endif
#ifndef REP_P2
#define REP_P2 1
#endif
#ifndef REP_P3
#define REP_P3 1
#endif
#ifndef REP_P4
#define REP_P4 1
#endif
#ifndef PG8_SP2
#define PG8_SP2 true
#endif
#ifndef PG8_ALIGN
#define PG8_ALIGN true
#endif
#define LAS __attribute__((address_space(3)))
typedef unsigned short bf16;
typedef unsigned v4u __attribute__((ext_vector_type(4)));
typedef unsigned v2u __attribute__((ext_vector_type(2)));
typedef float f32x4 __attribute__((ext_vector_type(4)));
typedef float f32x2 __attribute__((ext_vector_type(2)));
typedef short bf16x8 __attribute__((ext_vector_type(8)));
#define LDS_WAIT() asm volatile("s_waitcnt lgkmcnt(0)" ::: "memory")

constexpr int NWAVES = 8, NTHR = 512;
constexpr int M = 16384, D = 1024, DIN = 3072, DPLE = 256, DC = 512, SEQ = 8192, CHUNK = 128, NHEAD = 8, CW = 31;
constexpr float LN_EPS = 1e-5f, ALPHA = 1.189207115002721f;
constexpr size_t MiB = 1u << 20;
constexpr size_t WS_CP1 = 0, WS_CP2 = 64 * 1024, WS_STATSP = 128 * 1024;
constexpr size_t WS_WSB = 1 * MiB;
constexpr size_t WS_WIN = 2 * MiB, WS_WOUT = 8 * MiB, WS_WG = 10 * MiB, WS_WPLE = 12 * MiB;
constexpr size_t WS_H = 16 * MiB, WS_PB = 48 * MiB, WS_PE = 56 * MiB, WS_Y = 88 * MiB, WS_RB = 120 * MiB;
constexpr size_t WS_AB = 152 * MiB, WS_SZ = 168 * MiB, WS_UG = 184 * MiB, WS_GV = 200 * MiB;
constexpr size_t WS_R = 152 * MiB;
constexpr size_t WS_END = 216 * MiB;
constexpr int LDS_BYTES = 147456;

__device__ __forceinline__ unsigned f2bf(float f) { unsigned u = __builtin_bit_cast(unsigned, f); return (u + 0x7fffu + ((u >> 16) & 1u)) >> 16; }
__device__ __forceinline__ unsigned pk2(float lo, float hi) { unsigned r; asm volatile("v_cvt_pk_bf16_f32 %0, %1, %2" : "=v"(r) : "v"(lo), "v"(hi)); return r; }
__device__ __forceinline__ float bf_lo(unsigned u) { return __uint_as_float(u << 16); }
__device__ __forceinline__ float bf_hi(unsigned u) { return __uint_as_float(u & 0xffff0000u); }
template <int CTRL> __device__ __forceinline__ float dpp_addc(float v) {
    return v + __builtin_bit_cast(float, __builtin_amdgcn_update_dpp(0, __builtin_bit_cast(int, v), CTRL, 0xF, 0xF, true));
}
__device__ __forceinline__ float wave_sum(float v) {
    v = dpp_addc<0xB1>(v);
    v = dpp_addc<0x4E>(v);
    v = dpp_addc<0x141>(v);
    v = dpp_addc<0x140>(v);
    const int vi = __builtin_bit_cast(int, v);
    const float r0 = __builtin_bit_cast(float, __builtin_amdgcn_readlane(vi, 0)), r1 = __builtin_bit_cast(float, __builtin_amdgcn_readlane(vi, 16)),
                r2 = __builtin_bit_cast(float, __builtin_amdgcn_readlane(vi, 32)), r3 = __builtin_bit_cast(float, __builtin_amdgcn_readlane(vi, 48));
    return (r0 + r1) + (r2 + r3);
}
__device__ __forceinline__ float sigm_f(float x) { return __builtin_amdgcn_rcpf(1.0f + __builtin_amdgcn_exp2f(-1.44269504089f * x)); }

#define GAS __attribute__((address_space(1)))
constexpr size_t WS_BAR = 768 * 1024, BAR_ZERO_BYTES = 16384;
constexpr int MISC_OFF = LDS_BYTES - 128;
#define XB_TMO      128
#define XB_XCNT(j)  (256  + 64 * (j))
#define XB_XSUB(j)  (1280 + 64 * (j))
#define XB_XGEN(j)  (2304 + 64 * (j))
#define XB_TOP      3328
#define XB_TOPGEN   3392
#define XCD_BAR_WORDS 3456
#define XB_SPIN_CAP (1u << 18)

__device__ __forceinline__ unsigned xb_ld(unsigned* p)              { return __hip_atomic_load(p, __ATOMIC_RELAXED, __HIP_MEMORY_SCOPE_AGENT); }
__device__ __forceinline__ unsigned xb_add(unsigned* p, unsigned v) { return __hip_atomic_fetch_add(p, v, __ATOMIC_RELAXED, __HIP_MEMORY_SCOPE_AGENT); }
__device__ __forceinline__ unsigned xb_xcc_id() { return (unsigned)__builtin_amdgcn_s_getreg((3 << 11) | 20) & 0xFu; }
#define XB_SPIN(cond, bar) do { unsigned _sp = 0; while (cond) { __builtin_amdgcn_s_sleep(1); \
    if ((++_sp & 255u) == 0u) { if (xb_ld(&(bar)[XB_TMO])) break; if (_sp > XB_SPIN_CAP) { atomicAdd(&(bar)[XB_TMO], 1u); break; } } } } while (0)

struct XcdBarrier {
    unsigned* bar; unsigned x;
    volatile LAS unsigned* st;
};

__device__ __forceinline__ XcdBarrier xcd_barrier_post(unsigned* bar, volatile LAS unsigned* st) {
    XcdBarrier b; b.bar = bar; b.x = xb_xcc_id(); b.st = st;
    if (threadIdx.x == 0) (void)xb_add(&bar[XB_XCNT(b.x)], 1u);
    return b;
}
__device__ __forceinline__ void xcd_barrier_complete(unsigned* bar, unsigned x, unsigned& nloc, unsigned& nx) {
    const unsigned G = gridDim.x * gridDim.y * gridDim.z;
    unsigned sum, cnt, mine, sp = 0u;
    for (;;) {
        sum = 0u; cnt = 0u; mine = 0u;
#pragma unroll
        for (unsigned j = 0; j < 16; ++j) { const unsigned c = xb_ld(&bar[XB_XCNT(j)]); sum += c; cnt += (c > 0u) ? 1u : 0u; mine = (j == x) ? c : mine; }
        if (sum == G) break;
        __builtin_amdgcn_s_sleep(1);
        if ((++sp & 255u) == 0u) { if (xb_ld(&bar[XB_TMO])) break; if (sp > XB_SPIN_CAP) { atomicAdd(&bar[XB_TMO], 1u); break; } }
    }
    nloc = mine > 0u ? mine : 1u; nx = cnt > 0u ? cnt : 1u;
}

__device__ __forceinline__ void xcd_barrier(const XcdBarrier& b) {
    asm volatile("s_waitcnt vmcnt(0)" ::: "memory");
    __syncthreads();
    if (threadIdx.x == 0) {
        unsigned* bar = b.bar;
        __builtin_amdgcn_s_waitcnt(0);
        unsigned nloc = b.st[0], nx = b.st[1];
        if (nloc == 0u) { xcd_barrier_complete(bar, b.x, nloc, nx); b.st[0] = nloc; b.st[1] = nx; }
        const unsigned old = xb_add(&bar[XB_XSUB(b.x)], 1u);
        const unsigned gen = old / nloc;
        if (old + 1u == (gen + 1u) * nloc) {
            __builtin_amdgcn_fence(__ATOMIC_RELEASE, "agent");
            asm volatile("s_waitcnt vmcnt(0)" ::: "memory");
            const unsigned og = xb_add(&bar[XB_TOP], 1u);
            const unsigned tg = og / nx;
            if (og + 1u == (tg + 1u) * nx) xb_add(&bar[XB_TOPGEN], 1u);
            else XB_SPIN(xb_ld(&bar[XB_TOPGEN]) == tg, bar);
            __builtin_amdgcn_fence(__ATOMIC_ACQUIRE, "agent");
            xb_add(&bar[XB_XGEN(b.x)], 1u);
            asm volatile("s_waitcnt vmcnt(0)" ::: "memory");
        } else {
            XB_SPIN(xb_ld(&bar[XB_XGEN(b.x)]) == gen, bar);
            __builtin_amdgcn_fence(__ATOMIC_ACQUIRE, "agent");
            asm volatile("s_waitcnt vmcnt(0)" ::: "memory");
        }
    }
    __syncthreads();
}

struct Args { const float* in[19]; float* out; unsigned char* ws; };

__device__ __forceinline__ int win_map(int n) {
    const int seg = n >> 9, o = n & 511, blk = o >> 7, w = o & 127;
    if (seg == 0) return 256 * blk + w;
    if (seg == 1) return 256 * blk + 128 + w;
    if (seg == 2) return 1024 + o;
    if (seg == 3) return 1536 + 256 * blk + w;
    if (seg == 5) return 1536 + 256 * blk + 128 + w;
    return 2560 + o;
}
template <bool GATE>
__device__ __forceinline__ void tr_item(const float* W, int K, int N, bf16* WT, int drow, LAS float* scr, int k0, int n0, int lane, const float* g, const float* b, float* cp1, float* cp2) {
#pragma unroll
    for (int i = 0; i < 32; ++i) { const int kk = 2 * i + (lane >> 5); scr[kk * 33 + (lane & 31)] = W[(size_t)(k0 + kk) * N + n0 + (lane & 31)]; }
    LDS_WAIT(); asm volatile("" ::: "memory");
    const int c = lane & 7;
    float gs[8];
#pragma unroll
    for (int e = 0; e < 8; ++e) gs[e] = GATE ? g[k0 + 8 * c + e] : 1.0f;
#pragma unroll
    for (int j = 0; j < 4; ++j) { const int n = (lane >> 3) + 8 * j; const LAS float* s = scr + (8 * c) * 33 + n;
        v4u o; o.x = pk2(s[0 * 33] * gs[0], s[1 * 33] * gs[1]); o.y = pk2(s[2 * 33] * gs[2], s[3 * 33] * gs[3]); o.z = pk2(s[4 * 33] * gs[4], s[5 * 33] * gs[5]); o.w = pk2(s[6 * 33] * gs[6], s[7 * 33] * gs[7]);
        *(v4u*)(WT + (size_t)(drow + n) * K + k0 + 8 * c) = o; }
    if (GATE) { const int n = lane & 31, half = lane >> 5; float s1 = 0.f, s2 = 0.f;
#pragma unroll 8
        for (int kk = 0; kk < 32; ++kk) { const int k = 32 * half + kk; const float w = scr[k * 33 + n]; s1 += g[k0 + k] * w; s2 += b[k0 + k] * w; }
        s1 += __shfl_xor(s1, 32); s2 += __shfl_xor(s2, 32);
        if (lane < 32) { cp1[(k0 >> 6) * N + n0 + n] = s1; cp2[(k0 >> 6) * N + n0 + n] = s2; } }
    LDS_WAIT(); asm volatile("" ::: "memory");
}

__device__ __forceinline__ void p0_prologue(const Args& a, LAS unsigned char* lds, int wave, int lane) {
    unsigned char* ws = a.ws;
    LAS float* scr = (LAS float*)(lds + wave * 16384);
    const int gw = blockIdx.x * NWAVES + wave, NGW = gridDim.x * NWAVES;
    constexpr int I_IN = (D / 64) * (DIN / 32), I_OUT = (D / 64) * (D / 32), I_G = I_OUT, I_PLE = (DPLE / 64) * (D / 32);
    constexpr int NITEMS = I_IN + I_OUT + I_G + I_PLE;
    const float* x = a.in[0]; bf16* H = (bf16*)(ws + WS_H);
    f32x4 xv[8][4];
    const bool xl = (gridDim.x % 8 == 0) && (M / 8) % (int)gridDim.x == 0;
    const int rbase = xl ? (int)(blockIdx.x % 8) * (M / 8) + (int)(blockIdx.x / 8) * NWAVES + wave : gw, rstep = xl ? (int)gridDim.x : NGW, rend = xl ? (int)(blockIdx.x % 8 + 1) * (M / 8) : M;
#pragma unroll
    for (int r = 0; r < 8; ++r) { const int mr = rbase + r * rstep; const f32x4* xr = (const f32x4*)(x + (size_t)(mr < rend ? mr : rbase) * D) + lane;
#pragma unroll
        for (int j = 0; j < 4; ++j) xv[r][j] = xr[64 * j]; }
    for (int it = gw; it < NITEMS; it += NGW) {
        int r = it;
        if (r < I_IN) { const int nblk = DIN / 32, kb = r / nblk, nb = r % nblk; tr_item<false>(a.in[4], D, DIN, (bf16*)(ws + WS_WIN), win_map(32 * nb), scr, 64 * kb, 32 * nb, lane, nullptr, nullptr, nullptr, nullptr); continue; } r -= I_IN;
        if (r < I_OUT) { const int nblk = D / 32, kb = r / nblk, nb = r % nblk; tr_item<false>(a.in[13], D, D, (bf16*)(ws + WS_WOUT), 32 * nb, scr, 64 * kb, 32 * nb, lane, nullptr, nullptr, nullptr, nullptr); continue; } r -= I_OUT;
        if (r < I_G) { const int nblk = D / 32, kb = r / nblk, nb = r % nblk; tr_item<true>(a.in[17], D, D, (bf16*)(ws + WS_WG), 32 * nb, scr, 64 * kb, 32 * nb, lane, a.in[14], a.in[15], (float*)(ws + WS_CP1), (float*)(ws + WS_CP2)); continue; } r -= I_G;
        { const int nblk = D / 32, kb = r / nblk, nb = r % nblk; tr_item<false>(a.in[16], DPLE, D, (bf16*)(ws + WS_WPLE), 32 * nb, scr, 64 * kb, 32 * nb, lane, nullptr, nullptr, nullptr, nullptr); }
    }
    {
        f32x4 gg[4], bb[4];
#pragma unroll
        for (int j = 0; j < 4; ++j) { gg[j] = *(const f32x4*)(a.in[2] + 4 * lane + 256 * j); bb[j] = *(const f32x4*)(a.in[3] + 4 * lane + 256 * j); }
        for (int m = rbase; m < rend; m += 8 * rstep) {
            if (m != rbase) {
#pragma unroll
                for (int r = 0; r < 8; ++r) { const int mr = m + r * rstep; const f32x4* xr = (const f32x4*)(x + (size_t)(mr < rend ? mr : m) * D) + lane;
#pragma unroll
                    for (int j = 0; j < 4; ++j) xv[r][j] = xr[64 * j]; }
            }
#pragma unroll
            for (int r = 0; r < 8; ++r) { float s = 0.f;
#pragma unroll
                for (int j = 0; j < 4; ++j) s += (xv[r][j][0] + xv[r][j][1]) + (xv[r][j][2] + xv[r][j][3]);
                const float mean = wave_sum(s) * (1.f / D); float s2 = 0.f;
#pragma unroll
                for (int j = 0; j < 4; ++j) { xv[r][j] = xv[r][j] - mean; s2 += (xv[r][j][0] * xv[r][j][0] + xv[r][j][1] * xv[r][j][1]) + (xv[r][j][2] * xv[r][j][2] + xv[r][j][3] * xv[r][j][3]); }
                const float rstd = 1.f / sqrtf(wave_sum(s2) * (1.f / D) + LN_EPS);
                if (m + r * rstep < rend) { v2u* o8 = (v2u*)(H + (size_t)(m + r * rstep) * D) + lane;
#pragma unroll
                    for (int j = 0; j < 4; ++j) { const f32x4 y = xv[r][j] * rstd * gg[j] + bb[j]; o8[64 * j] = (v2u){pk2(y[0], y[1]), pk2(y[2], y[3])}; } } }
        }
    }
    {
        const float* p = a.in[1]; bf16* Pb = (bf16*)(ws + WS_PB);
        const int gt = blockIdx.x * NTHR + threadIdx.x, NGT = gridDim.x * NTHR;
        for (int i0 = gt; i0 < M * DPLE / 8; i0 += 4 * NGT) {
            f32x4 a0[4], a1[4];
#pragma unroll
            for (int r = 0; r < 4; ++r) { const int i = i0 + r * NGT; const bool ok = i < M * DPLE / 8; const size_t o = (size_t)(ok ? i : i0) * 8; a0[r] = *(const f32x4*)(p + o); a1[r] = *(const f32x4*)(p + o + 4); }
#pragma unroll
            for (int r = 0; r < 4; ++r) { const int i = i0 + r * NGT; if (i < M * DPLE / 8)
                *(v4u*)(Pb + (size_t)i * 8) = (v4u){pk2(a0[r][0], a0[r][1]), pk2(a0[r][2], a0[r][3]), pk2(a1[r][0], a1[r][1]), pk2(a1[r][2], a1[r][3])}; }
        }
        const float* wsrc = a.in[11]; bf16* Wsb = (bf16*)(ws + WS_WSB);
        for (int i = gt; i < NHEAD * CHUNK * CHUNK / 8; i += NGT) { const int t = (i >> 4) & 127, s0 = (i & 15) * 8;
            const f32x4 a0 = *(const f32x4*)(wsrc + (size_t)i * 8), a1 = *(const f32x4*)(wsrc + (size_t)i * 8 + 4);
            float e[8] = {a0[0], a0[1], a0[2], a0[3], a1[0], a1[1], a1[2], a1[3]};
#pragma unroll
            for (int k = 0; k < 8; ++k) e[k] = (s0 + k <= t) ? e[k] : 0.f;
            *(v4u*)(Wsb + (size_t)i * 8) = (v4u){pk2(e[0], e[1]), pk2(e[2], e[3]), pk2(e[4], e[5]), pk2(e[6], e[7])}; }
    }
}

template <int J> struct ConvStep {
    static __device__ __forceinline__ void run(f32x2 (&acc)[16], const f32x2 (&w)[CW], const LAS unsigned char* p) {
        const unsigned d = *(const LAS unsigned*)(p + J * 1024); const f32x2 v = (f32x2){bf_lo(d), bf_hi(d)};
#pragma unroll
        for (int k = 0; k < CW; ++k) { const int t = J - k; if (t >= 0 && t < 16) acc[t] += w[k] * v; }
        ConvStep<J + 1>::run(acc, w, p);
    }
};
template <> struct ConvStep<46> { static __device__ __forceinline__ void run(f32x2 (&)[16], const f32x2 (&)[CW], const LAS unsigned char*) {} };
__device__ __forceinline__ void conv_tile_load(v4u (&pf)[8], int it, const bf16* Ab, int tid) {
    const int m0 = it * 32, t0 = m0 & (SEQ - 1);
#pragma unroll
    for (int i = 0; i < 8; ++i) { const int q = tid + i * NTHR, row = q >> 6, c16 = q & 63; pf[i] = (v4u){0u, 0u, 0u, 0u};
        if (q < 62 * 64 && t0 - 30 + row >= 0) pf[i] = *(const v4u*)(Ab + (size_t)(m0 - 30 + row) * DC + c16 * 8); }
}
__device__ __forceinline__ void conv_item(LAS unsigned char* lds, int it, int it_next, v4u (&pf)[8], const bf16* Ab, const bf16* SZ, bf16* Y, const f32x2 (&w)[CW], f32x2 cb,
                                          const float* lng, const float* lnb, int tid, int wave, int lane) {
    const int m0 = it * 32;
    LAS unsigned char* in = lds; LAS float* outt = (LAS float*)(lds + 65536);
#pragma unroll
    for (int i = 0; i < 8; ++i) { const int q = tid + i * NTHR, row = q >> 6, c16 = q & 63; if (q < 62 * 64) *(LAS v4u*)(in + row * 1024 + c16 * 16) = pf[i]; }
    __syncthreads();
    if (it_next >= 0) conv_tile_load(pf, it_next, Ab, tid);
    f32x4 gg[2], bb[2]; v2u zz[4][2];
#pragma unroll
    for (int j = 0; j < 2; ++j) { const int c = 4 * lane + 256 * j; gg[j] = *(const f32x4*)(lng + c); bb[j] = *(const f32x4*)(lnb + c);
#pragma unroll
        for (int rr = 0; rr < 4; ++rr) zz[rr][j] = *(const v2u*)(SZ + (size_t)(m0 + 4 * wave + rr) * DC + c); }
    const int cp = tid & 255, rh = tid >> 8;
    f32x2 acc[16];
#pragma unroll
    for (int t = 0; t < 16; ++t) acc[t] = (f32x2){0.f, 0.f};
    ConvStep<0>::run(acc, w, in + (16 * rh) * 1024 + cp * 4);
#pragma unroll
    for (int t = 0; t < 16; ++t) *(LAS f32x2*)(outt + (16 * rh + t) * DC + 2 * cp) = acc[t] + cb;
    __syncthreads();
    {
#pragma unroll
        for (int rr = 0; rr < 4; ++rr) { const int row = 4 * wave + rr; const size_t m = (size_t)(m0 + row);
            f32x4 v[2]; float s = 0.f;
#pragma unroll
            for (int j = 0; j < 2; ++j) { v[j] = *(const LAS f32x4*)(outt + row * DC + 4 * lane + 256 * j); s += (v[j][0] + v[j][1]) + (v[j][2] + v[j][3]); }
            const float mean = wave_sum(s) * (1.f / DC); float s2 = 0.f;
#pragma unroll
            for (int j = 0; j < 2; ++j) { v[j] = v[j] - mean; s2 += (v[j][0] * v[j][0] + v[j][1] * v[j][1]) + (v[j][2] * v[j][2] + v[j][3] * v[j][3]); }
            const float rstd = 1.f / sqrtf(wave_sum(s2) * (1.f / DC) + LN_EPS);
#pragma unroll
            for (int j = 0; j < 2; ++j) { const int c = 4 * lane + 256 * j;
                f32x4 y = v[j] * rstd * gg[j] + bb[j];
                y = (f32x4){y[0] * sigm_f(y[0]), y[1] * sigm_f(y[1]), y[2] * sigm_f(y[2]), y[3] * sigm_f(y[3])};
                y = y * (f32x4){bf_lo(zz[rr][j].x), bf_hi(zz[rr][j].x), bf_lo(zz[rr][j].y), bf_hi(zz[rr][j].y)};
                *(v2u*)(Y + m * D + c) = (v2u){pk2(y[0], y[1]), pk2(y[2], y[3])}; } }
    }
    __syncthreads();
}

__device__ __forceinline__ void sgu_item(LAS unsigned char* lds, int it, const bf16* GV, const bf16* UG, const bf16* Wsb, const float* bs, const float* lng, const float* lnb, bf16* Y,
                                         int tid, int wave, int lane) {
    constexpr int RS = 516;
    const int c = it >> 1, hh = it & 1, m0 = c * CHUNK;
    {
        const f32x4 g0 = *(const f32x4*)(lng + 8 * lane), g1 = *(const f32x4*)(lng + 8 * lane + 4), b0 = *(const f32x4*)(lnb + 8 * lane), b1 = *(const f32x4*)(lnb + 8 * lane + 4);
        v4u raw[16];
#pragma unroll
        for (int i = 0; i < 16; ++i) raw[i] = *(const v4u*)(GV + (size_t)(m0 + 16 * wave + i) * DC + 8 * lane);
#pragma unroll
        for (int i = 0; i < 16; ++i) {
            f32x4 x0 = (f32x4){bf_lo(raw[i].x), bf_hi(raw[i].x), bf_lo(raw[i].y), bf_hi(raw[i].y)}, x1 = (f32x4){bf_lo(raw[i].z), bf_hi(raw[i].z), bf_lo(raw[i].w), bf_hi(raw[i].w)};
            const float s = (x0[0] + x0[1]) + (x0[2] + x0[3]) + (x1[0] + x1[1]) + (x1[2] + x1[3]);
            const float mean = wave_sum(s) * (1.f / DC);
            x0 = x0 - mean; x1 = x1 - mean;
            const float q = (x0[0] * x0[0] + x0[1] * x0[1]) + (x0[2] * x0[2] + x0[3] * x0[3]) + (x1[0] * x1[0] + x1[1] * x1[1]) + (x1[2] * x1[2] + x1[3] * x1[3]);
            const float rstd = 1.f / sqrtf(wave_sum(q) * (1.f / DC) + LN_EPS);
            x0 = x0 * rstd * g0 + b0; x1 = x1 * rstd * g1 + b1;
            if ((lane >> 5) == hh) { LAS unsigned* dst = (LAS unsigned*)(lds + (16 * wave + i) * RS + (lane & 31) * 16);
                dst[0] = pk2(x0[0], x0[1]); dst[1] = pk2(x0[2], x0[3]); dst[2] = pk2(x1[0], x1[1]); dst[3] = pk2(x1[2], x1[3]); }
        }
    }
    bf16x8 wf[20]; v2u ugv[8][2]; float biasv[8];
    const int hl = wave >> 1, dh = wave & 1, h = 4 * hh + hl, dbase = hl * 64 + dh * 32, fr = lane & 15, q = lane >> 4;
    {
        int n = 0;
#pragma unroll
        for (int tb = 0; tb < 8; ++tb)
#pragma unroll
            for (int ks = 0; ks < 4; ++ks) if (ks <= (tb >> 1)) { wf[n] = *(const bf16x8*)(Wsb + ((size_t)(h * CHUNK + 16 * tb + fr)) * CHUNK + 32 * ks + 8 * q); ++n; }
#pragma unroll
        for (int tb = 0; tb < 8; ++tb) { const int t = 16 * tb + fr; biasv[tb] = bs[h * CHUNK + t];
#pragma unroll
            for (int nb = 0; nb < 2; ++nb) ugv[tb][nb] = *(const v2u*)(UG + (size_t)(m0 + t) * DC + 256 * hh + dbase + 16 * nb + 4 * q); }
    }
    __syncthreads();
    {
        bf16x8 vf[2][4];
#pragma unroll
        for (int nb = 0; nb < 2; ++nb)
#pragma unroll
            for (int ks = 0; ks < 4; ++ks)
#pragma unroll
                for (int jj = 0; jj < 8; ++jj) vf[nb][ks][jj] = (short)*(const LAS unsigned short*)(lds + (32 * ks + 8 * q + jj) * RS + 2 * (dbase + 16 * nb + fr));
        f32x4 acc[8][2];
#pragma unroll
        for (int tb = 0; tb < 8; ++tb) { acc[tb][0] = (f32x4){0.f, 0.f, 0.f, 0.f}; acc[tb][1] = (f32x4){0.f, 0.f, 0.f, 0.f}; }
        int n = 0;
#pragma unroll
        for (int tb = 0; tb < 8; ++tb)
#pragma unroll
            for (int ks = 0; ks < 4; ++ks) if (ks <= (tb >> 1)) {
                acc[tb][0] = __builtin_amdgcn_mfma_f32_16x16x32_bf16(vf[0][ks], wf[n], acc[tb][0], 0, 0, 0);
                acc[tb][1] = __builtin_amdgcn_mfma_f32_16x16x32_bf16(vf[1][ks], wf[n], acc[tb][1], 0, 0, 0); ++n; }
#pragma unroll
        for (int tb = 0; tb < 8; ++tb) { const int t = 16 * tb + fr; const size_t m = (size_t)(m0 + t);
#pragma unroll
            for (int nb = 0; nb < 2; ++nb) { const int col = 256 * hh + dbase + 16 * nb + 4 * q; const v2u ug = ugv[tb][nb];
                const f32x4 o = (acc[tb][nb] + biasv[tb]) * (f32x4){bf_lo(ug.x), bf_hi(ug.x), bf_lo(ug.y), bf_hi(ug.y)};
                *(v2u*)(Y + m * D + DC + col) = (v2u){pk2(o[0], o[1]), pk2(o[2], o[3])}; } }
    }
    __syncthreads();
}

__device__ __forceinline__ void p2_mixer(const Args& a, LAS unsigned char* lds, int tid, int wave, int lane) {
    unsigned char* ws = a.ws;
    const bf16* Ab = (const bf16*)(ws + WS_AB); const bf16* SZ = (const bf16*)(ws + WS_SZ); const bf16* UG = (const bf16*)(ws + WS_UG); const bf16* GV = (const bf16*)(ws + WS_GV);
    bf16* Y = (bf16*)(ws + WS_Y);
    const bool xl = (gridDim.x % 8 == 0);
    const int xq = blockIdx.x % 8, lq = blockIdx.x / 8, nl = gridDim.x / 8;
    for (int j = xl ? lq : (int)blockIdx.x; j < (xl ? M / CHUNK * 2 / 8 : M / CHUNK * 2); j += xl ? nl : (int)gridDim.x) { const int it = xl ? xq * (M / CHUNK * 2 / 8) + j : j;
        sgu_item(lds, it, GV, UG, (const bf16*)(ws + WS_WSB), a.in[12], a.in[9], a.in[10], Y, tid, wave, lane); }
    {
        const int cp = tid & 255;
        f32x2 w[CW];
#pragma unroll
        for (int k = 0; k < CW; ++k) w[k] = *(const f32x2*)(a.in[5] + k * DC + 2 * cp);
        const f32x2 cb = *(const f32x2*)(a.in[6] + 2 * cp);
        v4u pf[8];
        constexpr int NCI = M / 32, NCIX = NCI / 8;
        const int first = xl ? xq * NCIX + lq : (int)blockIdx.x, step = xl ? nl : (int)gridDim.x, last = xl ? (xq + 1) * NCIX : NCI;
        if (first < last) conv_tile_load(pf, first, Ab, tid);
        for (int rep = 0; rep < REP_CONV; ++rep)
        for (int it = first; it < last; it += step) { const int nx = it + step < last ? it + step : ((REP_CONV > 1 && rep + 1 < REP_CONV) ? first : -1);
            conv_item(lds, it, nx, pf, Ab, SZ, Y, w, cb, a.in[7], a.in[8], tid, wave, lane); }
    }
}

__global__ void __launch_bounds__(NTHR, 2) fwd_megakernel(Args a) {
    extern __shared__ __attribute__((aligned(16))) unsigned char lds_raw[];
    LAS unsigned char* lds = (LAS unsigned char*)lds_raw;
    cg::grid_group grid = cg::this_grid();
#define FRESH_IDS int tid = threadIdx.x; asm volatile("" : "+v"(tid)); const int lane = tid & 63, wave = __builtin_amdgcn_readfirstlane(tid >> 6); (void)lane; (void)wave;
    unsigned char* ws = a.ws;
    const int G = gridDim.x;
    if (threadIdx.x < 32) ((LAS unsigned*)(lds + MISC_OFF))[threadIdx.x] = 0u;
    __syncthreads();
    const XcdBarrier bar = xcd_barrier_post((unsigned*)(ws + WS_BAR), (volatile LAS unsigned*)(lds + MISC_OFF));
    if (ws == nullptr) grid.sync();
#define GRID_BAR() xcd_barrier(bar)

#ifndef NO_P0
    for (int rep = 0; rep < REP_P0; ++rep) { FRESH_IDS p0_prologue(a, lds, wave, lane); }
#endif
    GRID_BAR();

#ifndef NO_P1
    for (int rep = 0; rep < REP_P1; ++rep) {
#ifndef NO_PE
    {
        pg8::Gemm g{(const bf16*)(ws + WS_PB), (const bf16*)(ws + WS_WPLE), M, D, DPLE}; pg8::StaticOrder S; S.init(M, D, G, (int)blockIdx.x);
        pg8::EpiBf16<0> E{(bf16*)(ws + WS_PE), D, nullptr, 0, 0, 1.f};
        pg8::gemm_phase<pg8::EpiBf16<0>, pg8::StaticOrder, PG8_ALIGN, PG8_SP2>(lds, g, S, E);
    }
#endif
#ifndef NO_IN
    {
        pg8::Gemm g{(const bf16*)(ws + WS_H), (const bf16*)(ws + WS_WIN), M, DIN, D}; pg8::StaticOrder S; S.init(M, DIN, G, (int)blockIdx.x);
        pg8::EpiP1 E{(bf16*)(ws + WS_AB), (bf16*)(ws + WS_SZ), (bf16*)(ws + WS_UG), (bf16*)(ws + WS_GV)};
        pg8::gemm_phase<pg8::EpiP1, pg8::StaticOrder, PG8_ALIGN, PG8_SP2>(lds, g, S, E);
    }
#endif
    }
#endif
    GRID_BAR();

#ifndef NO_P2
    for (int rep = 0; rep < REP_P2; ++rep) { FRESH_IDS p2_mixer(a, lds, tid, wave, lane); }
#endif
    GRID_BAR();

#ifndef NO_P3
    for (int rep = 0; rep < REP_P3; ++rep)
    {
        pg8::Gemm g{(const bf16*)(ws + WS_Y), (const bf16*)(ws + WS_WOUT), M, D, D}; pg8::StaticOrder S; S.init(M, D, G, (int)blockIdx.x);
#ifdef PROBE_K3
        { pg8::EpiNone E0; pg8::gemm_phase<pg8::EpiNone, pg8::StaticOrder, false, PG8_SP2>(lds, g, S, E0); }
#endif
        pg8::EpiP3 E{(const bf16*)(ws + WS_H), (bf16*)(ws + WS_RB), (float*)(ws + WS_STATSP), ALPHA};
        pg8::gemm_phase<pg8::EpiP3, pg8::StaticOrder, false, PG8_SP2>(lds, g, S, E);
    }
#endif
    GRID_BAR();

#ifndef NO_P4
    for (int rep = 0; rep < REP_P4; ++rep)
    {
        pg8::Gemm g{(const bf16*)(ws + WS_RB), (const bf16*)(ws + WS_WG), M, D, D}; pg8::StaticOrder S; S.init(M, D, G, (int)blockIdx.x);
        pg8::EpiP4 E{(const bf16*)(ws + WS_RB), (const bf16*)(ws + WS_PE), (const float*)(ws + WS_STATSP), (const float*)(ws + WS_CP1), (const float*)(ws + WS_CP2), a.in[18], a.in[14], a.in[15], a.out, LN_EPS};
        pg8::gemm_phase<pg8::EpiP4, pg8::StaticOrder, false, PG8_SP2>(lds, g, S, E);
    }
#endif
}

extern "C" void kernel_launch(void* const* d_in, const int* in_sizes, int n_in, void* d_out, int out_size, void* d_ws, size_t ws_size, hipStream_t stream) {
    static int grid = 0;
    if (grid == 0) {
        if (n_in != 19 || in_sizes[0] != M * D || out_size != M * D || ws_size < WS_END) { fprintf(stderr, "kernel_launch: unexpected shapes (n_in %d, in0 %d, out %d, ws %zu)\n", n_in, n_in > 0 ? in_sizes[0] : -1, out_size, ws_size); grid = -1; return; }
        int dev = 0, cus = 0, per_cu = 0;
        if (hipGetDevice(&dev) != hipSuccess || hipDeviceGetAttribute(&cus, hipDeviceAttributeMultiprocessorCount, dev) != hipSuccess) { fprintf(stderr, "kernel_launch: device query failed\n"); grid = -1; return; }
        if (hipFuncSetAttribute((const void*)fwd_megakernel, hipFuncAttributeMaxDynamicSharedMemorySize, LDS_BYTES) != hipSuccess) { fprintf(stderr, "kernel_launch: hipFuncSetAttribute failed\n"); grid = -1; return; }
        if (hipOccupancyMaxActiveBlocksPerMultiprocessor(&per_cu, (const void*)fwd_megakernel, NTHR, LDS_BYTES) != hipSuccess || per_cu < 1) { fprintf(stderr, "kernel_launch: occupancy query says %d\n", per_cu); per_cu = 1; }
        (void)hipGetLastError();
        grid = cus * 1;
    }
    if (grid < 0) return;
    Args a{};
    for (int i = 0; i < 19; ++i) a.in[i] = (const float*)d_in[i];
    a.out = (float*)d_out; a.ws = (unsigned char*)d_ws;
    if (hipMemsetAsync((char*)d_ws + WS_BAR, 0, BAR_ZERO_BYTES, stream) != hipSuccess) { fprintf(stderr, "kernel_launch: memset failed\n"); return; }
    void* args[] = {&a};
    hipError_t e = hipLaunchCooperativeKernel((const void*)fwd_megakernel, dim3(grid), dim3(NTHR), args, LDS_BYTES, stream);
    if (e != hipSuccess) fprintf(stderr, "kernel_launch: cooperative launch failed: %s (grid %d)\n", hipGetErrorString(e), grid);
}
```

```cpp
#include <hip/hip_runtime.h>
#include <hip/hip_cooperative_groups.h>
#include <cstdio>
#include <cstdint>
namespace cg = cooperative_groups;
namespace pg8 {
#define PG8_LAS __attribute__((address_space(3)))
typedef unsigned short bf16_t;
typedef short bf16x8 __attribute__((ext_vector_type(8)));
typedef float f32x4 __attribute__((ext_vector_type(4)));
typedef unsigned u32x4 __attribute__((ext_vector_type(4)));
constexpr int BM = 256, BK = 64, HALF = 128, HTB = HALF * BK * 2  , STAGE_BYTES = 8 * HTB, NXCD = 8, WGM = 8;

__host__ __device__ __forceinline__ int lds_byte(int r, int c) { const int st = (r >> 4) * 2 + (c >> 5), rr = r & 15, cc = c & 31, ob = rr * 64 + cc * 2; return st * 1024 + (ob ^ (((ob >> 9) & 1) << 5)); }
__host__ __device__ __forceinline__ void stage_rc(int b, int& R, int& C) { const int st = b / 1024, sb = b % 1024, swz = sb ^ (((sb >> 9) & 1) << 5); R = (st >> 1) * 16 + swz / 64; C = (st & 1) * 32 + (swz % 64) / 2; }
__host__ __device__ __forceinline__ int perm32(int rho) { const int n = rho >> 4, i = rho & 15; return 8 * (i >> 2) + 4 * n + (i & 3); }

struct Unit { int pm, pn; };
struct Gemm { const bf16_t* A; const bf16_t* Bt; int M, N, K; };

struct StaticOrder {
    int nM, nN, nwg, G, c;
    __host__ __device__ void init(int M, int N, int G_, int c_) { nM = M / BM; nN = N / BM; nwg = nM * nN; G = G_; c = c_; }
    __host__ __device__ bool next(int i, Unit& u) const {
        const long L = (long)i * G + c; if (L >= nwg) return false;
        int wgid = (int)L; { const int q = nwg / NXCD, r = nwg % NXCD, xcd = wgid % NXCD, off = wgid / NXCD; wgid = (xcd < r ? xcd * (q + 1) : r * (q + 1) + (xcd - r) * q) + off; }
        const int nig = WGM * nN, gid = wgid / nig, fm = gid * WGM, gsz = (nM - fm) < WGM ? (nM - fm) : WGM;
        u.pm = fm + ((wgid % nig) % gsz); u.pn = (wgid % nig) / gsz; return true;
    }
    __device__ __forceinline__ void a_ready(const Unit&) const {}
    __device__ __forceinline__ void done(const Unit&) const {}
};

__device__ __forceinline__ unsigned cvt_pk_bf16(float lo, float hi) { unsigned r; asm volatile("v_cvt_pk_bf16_f32 %0, %1, %2" : "=v"(r) : "v"(lo), "v"(hi)); return r; }
typedef float f32x2 __attribute__((ext_vector_type(2)));
__device__ __forceinline__ f32x2 gelu_pk(f32x2 v) {
    const f32x2 av = __builtin_elementwise_abs(v), d = av * 0.2316418882f + 1.0f;
    f32x2 t; t.x = __builtin_amdgcn_rcpf(d.x); t.y = __builtin_amdgcn_rcpf(d.y);
    f32x2 q = t * 0.5307027145f + (-0.7265760135f); q = q * t + 0.7107068705f; q = q * t + (-0.142248368f); q = q * t + 0.127414796f; q = q * t;
    const f32x2 s = (v * v) * (-0.72134752044f);
    f32x2 e; e.x = __builtin_amdgcn_exp2f(s.x); e.y = __builtin_amdgcn_exp2f(s.y);
    const f32x2 m = v * (q * e), r = v - m;
    f32x2 o; o.x = v.x < 0.f ? m.x : r.x; o.y = v.y < 0.f ? m.y : r.y; return o;
}

template <int ACT  > struct EpiBf16 {
    static constexpr bool PERM = true, AFTER_DRAIN = false; static constexpr int REP = 1; static_assert(ACT == 0 || ACT == 1, "EpiBf16: ACT is 0 (none) or 1 (gelu_pk)");
    bf16_t* O; int ldc; const float* bias; int split_cols; size_t split_stride; float scale0;
    __device__ __forceinline__ void operator()(const f32x4 (&acc)[2][2][4][2], const Unit& u, int wr, int wc, int fr, int fq) const {
        const int row0 = u.pm * BM + wr * 64 + fr; int colt = u.pn * BM; bf16_t* base = O;
        float sc = 1.f; if (split_cols) { const int t = colt / split_cols; base += (size_t)t * split_stride; colt -= t * split_cols; if (t == 0) sc = scale0; }
        const int col0 = colt + wc * 32 + 8 * fq, bcol0 = u.pn * BM + wc * 32 + 8 * fq;
        f32x4 bv[2][2];
#pragma unroll
        for (int bj = 0; bj < 2; ++bj)
#pragma unroll
            for (int n = 0; n < 2; ++n) bv[bj][n] = bias ? *(const f32x4*)(bias + bcol0 + bj * HALF + 4 * n) : (f32x4){0.f, 0.f, 0.f, 0.f};
#pragma unroll
        for (int ai = 0; ai < 2; ++ai)
#pragma unroll
            for (int m = 0; m < 4; ++m) { bf16_t* rowp = base + (size_t)(row0 + ai * HALF + m * 16) * ldc + col0;
#pragma unroll
                for (int bj = 0; bj < 2; ++bj) { f32x4 v0 = acc[ai][bj][m][0] + bv[bj][0], v1 = acc[ai][bj][m][1] + bv[bj][1];
                    if (ACT == 1) { f32x2 a = gelu_pk((f32x2){v0[0], v0[1]}), b = gelu_pk((f32x2){v0[2], v0[3]}), c = gelu_pk((f32x2){v1[0], v1[1]}), d = gelu_pk((f32x2){v1[2], v1[3]});
                        v0 = (f32x4){a.x, a.y, b.x, b.y}; v1 = (f32x4){c.x, c.y, d.x, d.y}; }
                    v0 = v0 * sc; v1 = v1 * sc; u32x4 w; w.x = cvt_pk_bf16(v0[0], v0[1]); w.y = cvt_pk_bf16(v0[2], v0[3]); w.z = cvt_pk_bf16(v1[0], v1[1]); w.w = cvt_pk_bf16(v1[2], v1[3]);
                    *(u32x4*)(rowp + bj * HALF) = w; } }
    }
};
#ifndef REP_E1
#define REP_E1 1
#endif
#ifndef REP_E3
#define REP_E3 1
#endif
#ifndef REP_E4
#define REP_E4 1
#endif
__device__ __forceinline__ float sigm(float x) { return __builtin_amdgcn_rcpf(1.0f + __builtin_amdgcn_exp2f(-1.44269504089f * x)); }
__device__ __forceinline__ f32x4 sigm4(f32x4 v) { return (f32x4){sigm(v[0]), sigm(v[1]), sigm(v[2]), sigm(v[3])}; }
__device__ __forceinline__ f32x4 gelu4(f32x4 v) { const f32x2 a = gelu_pk((f32x2){v[0], v[1]}), b = gelu_pk((f32x2){v[2], v[3]}); return (f32x4){a.x, a.y, b.x, b.y}; }
__device__ __forceinline__ u32x4 pack8(f32x4 v0, f32x4 v1) { u32x4 w; w.x = cvt_pk_bf16(v0[0], v0[1]); w.y = cvt_pk_bf16(v0[2], v0[3]); w.z = cvt_pk_bf16(v1[0], v1[1]); w.w = cvt_pk_bf16(v1[2], v1[3]); return w; }
__device__ __forceinline__ f32x4 unpk_lo(u32x4 w) { return (f32x4){__uint_as_float(w.x << 16), __uint_as_float(w.x & 0xffff0000u), __uint_as_float(w.y << 16), __uint_as_float(w.y & 0xffff0000u)}; }
__device__ __forceinline__ f32x4 unpk_hi(u32x4 w) { return (f32x4){__uint_as_float(w.z << 16), __uint_as_float(w.z & 0xffff0000u), __uint_as_float(w.w << 16), __uint_as_float(w.w & 0xffff0000u)}; }

struct EpiP1 {
    static constexpr bool PERM = true, AFTER_DRAIN = false; static constexpr int REP = REP_E1;
    bf16_t *Ab, *SZ, *UG, *GV;
    __device__ __forceinline__ void operator()(const f32x4 (&acc)[2][2][4][2], const Unit& u, int wr, int wc, int fr, int fq) const {
        const int row0 = u.pm * BM + wr * 64 + fr, pn = u.pn, cl = wc * 32 + 8 * fq;
        if (pn < 4 || (pn >= 6 && pn < 10)) {
            const bool glu = pn < 4; bf16_t* base = glu ? Ab : UG; const int colt = 128 * (glu ? pn : pn - 6) + cl;
#pragma unroll
            for (int ai = 0; ai < 2; ++ai)
#pragma unroll
                for (int m = 0; m < 4; ++m) { bf16_t* rowp = base + (size_t)(row0 + ai * HALF + m * 16) * 512 + colt;
                    const f32x4 v0 = acc[ai][0][m][0], v1 = acc[ai][0][m][1], g0 = acc[ai][1][m][0], g1 = acc[ai][1][m][1];
                    f32x4 o0, o1;
                    if (glu) { o0 = v0 * sigm4(g0); o1 = v1 * sigm4(g1); }
                    else { o0 = gelu4(v0) * (g0 * sigm4(g0)); o1 = gelu4(v1) * (g1 * sigm4(g1)); }
                    *(u32x4*)rowp = pack8(o0, o1); }
        } else {
            const bool sil = pn < 6; bf16_t* base = sil ? SZ : GV; const int colt = 256 * (sil ? pn - 4 : pn - 10) + cl;
#pragma unroll
            for (int ai = 0; ai < 2; ++ai)
#pragma unroll
                for (int m = 0; m < 4; ++m) { bf16_t* rowp = base + (size_t)(row0 + ai * HALF + m * 16) * 512 + colt;
#pragma unroll
                    for (int bj = 0; bj < 2; ++bj) { const f32x4 v0 = acc[ai][bj][m][0], v1 = acc[ai][bj][m][1]; f32x4 o0, o1;
                        if (sil) { o0 = v0 * sigm4(v0); o1 = v1 * sigm4(v1); } else { o0 = gelu4(v0); o1 = gelu4(v1); }
                        *(u32x4*)(rowp + bj * HALF) = pack8(o0, o1); } }
        }
    }
};

struct EpiP3 {
    static constexpr bool PERM = true, AFTER_DRAIN = true; static constexpr int REP = REP_E3;
    const bf16_t* H; bf16_t* RB; float* statsP; float alpha;
    __device__ __forceinline__ void fused(f32x4 (&acc)[2][2][4][2], const Unit& u, int wr, int wc, int fr, int fq, PG8_LAS unsigned char* lds, int wid, int lane) const {
        PG8_LAS f32x2* P = (PG8_LAS f32x2*)lds;
        const int col0 = u.pn * BM + wc * 32 + 8 * fq;
        const size_t off0 = (size_t)(u.pm * BM + wr * 64 + fr) * 1024 + col0;
        u32x4 hv[2][4][2];
#pragma unroll
        for (int ai = 0; ai < 2; ++ai)
#pragma unroll
            for (int m = 0; m < 4; ++m)
#pragma unroll
                for (int bj = 0; bj < 2; ++bj) hv[ai][m][bj] = *(const u32x4*)(H + off0 + (size_t)(ai * HALF + m * 16) * 1024 + bj * HALF);
        asm volatile("" ::: "memory");
#pragma unroll
        for (int ai = 0; ai < 2; ++ai)
#pragma unroll
            for (int m = 0; m < 4; ++m) { const int r = ai * HALF + wr * 64 + m * 16 + fr; const size_t off = off0 + (size_t)(ai * HALF + m * 16) * 1024; float s1 = 0.f, s2 = 0.f;
#pragma unroll
                for (int bj = 0; bj < 2; ++bj) { const u32x4 hh = hv[ai][m][bj];
                    const f32x4 v0 = acc[ai][bj][m][0] + alpha * unpk_lo(hh), v1 = acc[ai][bj][m][1] + alpha * unpk_hi(hh);
                    *(u32x4*)(RB + off + bj * HALF) = pack8(v0, v1);
                    s1 += (v0[0] + v0[1]) + (v0[2] + v0[3]) + (v1[0] + v1[1]) + (v1[2] + v1[3]);
                    s2 += (v0[0] * v0[0] + v0[1] * v0[1]) + (v0[2] * v0[2] + v0[3] * v0[3]) + (v1[0] * v1[0] + v1[1] * v1[1]) + (v1[2] * v1[2] + v1[3] * v1[3]); }
                s1 += __shfl_xor(s1, 16); s1 += __shfl_xor(s1, 32); s2 += __shfl_xor(s2, 16); s2 += __shfl_xor(s2, 32);
                if (fq == 0) P[r * 4 + wc] = (f32x2){s1, s2}; }
        __syncthreads();
        const int tid = wid * 64 + lane;
        if (tid < 256) { const f32x2 a = P[tid * 4 + 0], b = P[tid * 4 + 1], c = P[tid * 4 + 2], d = P[tid * 4 + 3];
            *(f32x2*)(statsP + (size_t)(u.pm * BM + tid) * 8 + u.pn * 2) = (f32x2){(a.x + b.x) + (c.x + d.x), (a.y + b.y) + (c.y + d.y)}; }
    }
};

struct EpiP4 {
    static constexpr bool PERM = true, AFTER_DRAIN = true; static constexpr int REP = REP_E4;
    const bf16_t* RB; const bf16_t* PE; const float* statsP; const float* cp1; const float* cp2; const float* bgate; const float* g; const float* b; float* out; float eps;
    __device__ __forceinline__ void fused(f32x4 (&acc)[2][2][4][2], const Unit& u, int wr, int wc, int fr, int fq, PG8_LAS unsigned char* lds, int wid, int lane) const {
        PG8_LAS float* C = (PG8_LAS float*)lds;
        PG8_LAS f32x2* T = (PG8_LAS f32x2*)(lds + 2048);
        const int tid = wid * 64 + lane;
        const size_t off0 = (size_t)(u.pm * BM + wr * 64 + fr) * 1024 + u.pn * BM + wc * 32 + 8 * fq;
        u32x4 rw[2][2], pw[2][2];
#define P4_LOAD(s) do { _Pragma("unroll") for (int mm = 0; mm < 2; ++mm) { const size_t o_ = off0 + (size_t)((((s) >> 1) & 1) * HALF + (((s) & 1) * 2 + mm) * 16) * 1024 + ((s) >> 2) * HALF; \
            rw[(s) & 1][mm] = *(const u32x4*)(RB + o_); pw[(s) & 1][mm] = *(const u32x4*)(PE + o_); } } while (0)
        P4_LOAD(0);
        { const int col = tid & 255, which = tid >> 8; const float* cp = cp1 + which * (16 * 1024); float s = 0.f;
#pragma unroll
          for (int kb = 0; kb < 16; ++kb) s += cp[kb * 1024 + u.pn * BM + col];
          if (which) s += bgate[u.pn * BM + col];
          C[which * 256 + col] = s; }
        if (tid < 256) { const float* sp = statsP + (size_t)(u.pm * BM + tid) * 8; const f32x4 a = *(const f32x4*)sp, bq = *(const f32x4*)(sp + 4);
            const float s1 = (a[0] + a[2]) + (bq[0] + bq[2]), s2 = (a[1] + a[3]) + (bq[1] + bq[3]);
            const float mu = s1 * (1.0f / 1024.0f); float var = s2 * (1.0f / 1024.0f) - mu * mu; var = var < 0.f ? 0.f : var;
            T[tid] = (f32x2){mu, 1.0f / sqrtf(var + eps)}; }
        __syncthreads();
#pragma unroll
        for (int bj = 0; bj < 2; ++bj) {
            const int cl = wc * 32 + 8 * fq + bj * HALF, gc = u.pn * BM + cl;
            const f32x4 c1a = *(const PG8_LAS f32x4*)(C + cl), c1b = *(const PG8_LAS f32x4*)(C + cl + 4), c2a = *(const PG8_LAS f32x4*)(C + 256 + cl), c2b = *(const PG8_LAS f32x4*)(C + 256 + cl + 4);
            const f32x4 ga = *(const f32x4*)(g + gc), gb = *(const f32x4*)(g + gc + 4), ba = *(const f32x4*)(b + gc), bb = *(const f32x4*)(b + gc + 4);
#pragma unroll
            for (int s4 = 0; s4 < 4; ++s4) {
                const int s = bj * 4 + s4, ai = s4 >> 1, mh = s4 & 1;
                if (s + 1 < 8) P4_LOAD(s + 1);
                asm volatile("" ::: "memory");
#pragma unroll
                for (int mm = 0; mm < 2; ++mm) { const int m = 2 * mh + mm, r = ai * HALF + wr * 64 + m * 16 + fr; const f32x2 sr = T[r]; const size_t off = off0 + (size_t)(ai * HALF + m * 16) * 1024 + bj * HALF;
                    const f32x4 r0 = unpk_lo(rw[s & 1][mm]), r1 = unpk_hi(rw[s & 1][mm]), p0 = unpk_lo(pw[s & 1][mm]), p1 = unpk_hi(pw[s & 1][mm]);
                    const f32x4 gp0 = (acc[ai][bj][m][0] - sr.x * c1a) * sr.y + c2a, gp1 = (acc[ai][bj][m][1] - sr.x * c1b) * sr.y + c2b;
                    const f32x4 h0 = (r0 - sr.x) * sr.y * ga + ba, h1 = (r1 - sr.x) * sr.y * gb + bb;
                    *(f32x4*)(out + off) = h0 + sigm4(gp0) * p0; *(f32x4*)(out + off + 4) = h1 + sigm4(gp1) * p1; }
            }
        }
#undef P4_LOAD
    }
};


struct EpiNone {
    static constexpr bool PERM = true, AFTER_DRAIN = false; static constexpr int REP = 1;
    __device__ __forceinline__ void operator()(const f32x4 (&acc)[2][2][4][2], const Unit& u, int wr, int wc, int fr, int fq) const { asm volatile("" :: "v"(acc[0][0][0][0]), "v"(acc[1][1][3][1])); }
};
template <class Epi, class Sched, bool ALIGN_EPI = false, bool SP2 = false>
__device__ __forceinline__ void gemm_phase(PG8_LAS unsigned char* lds, const Gemm g, const Sched& S, const Epi& E) {
    int tid_ = threadIdx.x; asm volatile("" : "+v"(tid_));
    const int tid = tid_, wid = __builtin_amdgcn_readfirstlane(tid >> 6), lane = tid & 63, wr = wid >> 2, wc = wid & 3, fr = lane & 15, fq = lane >> 4;
    const int K = g.K, nt = K / BK;
    unsigned voffA[2], voffB[2];
#pragma unroll
    for (int i = 0; i < 2; ++i) { int R, C; stage_rc(tid * 16 + i * 8192, R, C); const int Rb = Epi::PERM ? ((R & ~31) + perm32(R & 31)) : R;
        voffA[i] = (unsigned)(R * K + C) * 2u; voffB[i] = (unsigned)(Rb * K + C) * 2u; }
    const size_t kstep = (size_t)(BK * 2);
    const size_t hstep = (size_t)HALF * K * 2;
    const size_t tstep = 2 * hstep;
    const unsigned ldsw = (unsigned)wid * 1024u;
    const int aoff = lds_byte(wr * 64 + fr, fq * 8), boff = lds_byte(wc * 32 + fr, fq * 8);
#define PG8_SA(b, h) (((b) * 2 + (h)) * HTB)
#define PG8_SB(b, h) ((4 + (b) * 2 + (h)) * HTB)
#define PG8_STAGE(bufoff, gbase, voff) do { _Pragma("unroll") for (int _i = 0; _i < 2; ++_i) \
        __builtin_amdgcn_global_load_lds((const unsigned*)((const char*)(gbase) + (voff)[_i]), (PG8_LAS unsigned*)(lds + (bufoff) + ldsw + _i * 8192), 16, 0, 0); } while (0)
#define PG8_LDA(dst, b, h) do { _Pragma("unroll") for (int m = 0; m < 4; ++m) _Pragma("unroll") for (int k = 0; k < 2; ++k) dst[m][k] = *(const PG8_LAS bf16x8*)(lds + PG8_SA(b, h) + aoff + m * 2048 + k * 1024); } while (0)
#define PG8_LDB(dst, b, h) do { _Pragma("unroll") for (int n = 0; n < 2; ++n) _Pragma("unroll") for (int k = 0; k < 2; ++k) dst[n][k] = *(const PG8_LAS bf16x8*)(lds + PG8_SB(b, h) + boff + n * 2048 + k * 1024); } while (0)
#define PG8_MMA(ai, bj, At, Bt) do { __builtin_amdgcn_s_setprio(1); _Pragma("unroll") for (int m = 0; m < 4; ++m) _Pragma("unroll") for (int n = 0; n < 2; ++n) _Pragma("unroll") for (int k = 0; k < 2; ++k) \
        acc[ai][bj][m][n] = __builtin_amdgcn_mfma_f32_16x16x32_bf16(Bt[n][k], At[m][k], acc[ai][bj][m][n], 0, 0, 0); __builtin_amdgcn_s_setprio(0); } while (0)
#define PG8_WAIT_V(n) asm volatile("s_waitcnt vmcnt(" #n ")" ::: "memory")
#define PG8_WAIT_L(n) asm volatile("s_waitcnt lgkmcnt(" #n ")" ::: "memory")
#define PG8_BAR __builtin_amdgcn_s_barrier()
#define PG8_SCHED __builtin_amdgcn_sched_barrier(0)
    Unit cur, nxt; int ui = 0;
    if (!S.next(0, cur)) return;
    f32x4 acc[2][2][4][2];
#pragma unroll
    for (int a = 0; a < 2; ++a)
#pragma unroll
        for (int b = 0; b < 2; ++b)
#pragma unroll
            for (int m = 0; m < 4; ++m)
#pragma unroll
                for (int n = 0; n < 2; ++n) acc[a][b][m][n] = (f32x4){0.f, 0.f, 0.f, 0.f};
    bf16x8 At[4][2], B0[2][2], B1[2][2];
    const char* cA = (const char*)g.A + (size_t)cur.pm * tstep; const char* cB = (const char*)g.Bt + (size_t)cur.pn * tstep;
    S.a_ready(cur);
    if constexpr (SP2) {
        PG8_STAGE(PG8_SB(0, 0), cB, voffB); PG8_STAGE(PG8_SB(0, 1), cB + hstep, voffB); PG8_STAGE(PG8_SA(0, 0), cA, voffA); PG8_STAGE(PG8_SA(0, 1), cA + hstep, voffA);
        if (wr == 1) PG8_BAR;
        PG8_WAIT_V(2); PG8_BAR;
        PG8_STAGE(PG8_SB(1, 0), cB + kstep, voffB); PG8_STAGE(PG8_SA(1, 0), cA + kstep, voffA); PG8_STAGE(PG8_SB(1, 1), cB + hstep + kstep, voffB);
        PG8_WAIT_V(6); PG8_BAR;
    } else {
        PG8_STAGE(PG8_SB(0, 0), cB, voffB); PG8_STAGE(PG8_SA(0, 0), cA, voffA); PG8_STAGE(PG8_SB(0, 1), cB + hstep, voffB); PG8_STAGE(PG8_SA(0, 1), cA + hstep, voffA);
        if (wr == 1) PG8_BAR;
        PG8_WAIT_V(4); PG8_BAR;
        PG8_STAGE(PG8_SB(1, 0), cB + kstep, voffB); PG8_STAGE(PG8_SA(1, 0), cA + kstep, voffA); PG8_STAGE(PG8_SB(1, 1), cB + hstep + kstep, voffB);
        PG8_WAIT_V(6); PG8_BAR;
    }
    for (;;) {
        const bool has_next = S.next(ui + 1, nxt);
        const char* nA = has_next ? (const char*)g.A + (size_t)nxt.pm * tstep : cA; const char* nB = has_next ? (const char*)g.Bt + (size_t)nxt.pn * tstep : cB;
        for (int t = 0; t < nt; t += 2) {
            const bool last = (t == nt - 2);
            const char* a1 = cA + (size_t)(t + 1) * kstep;
            const char* a2 = last ? nA : cA + (size_t)(t + 2) * kstep; const char* b2 = last ? nB : cB + (size_t)(t + 2) * kstep;
            const char* a3 = a2 + kstep; const char* b3 = b2 + kstep;
            if (last && has_next) S.a_ready(nxt);
            if constexpr (SP2) {
            PG8_LDB(B0, 0, 0); PG8_LDB(B1, 0, 1); PG8_SCHED; PG8_LDA(At, 0, 0); PG8_STAGE(PG8_SA(1, 1), a1 + hstep, voffA);
            PG8_WAIT_V(8); PG8_WAIT_L(0); PG8_BAR; PG8_MMA(0, 0, At, B0); PG8_MMA(0, 1, At, B1); PG8_BAR; PG8_SCHED;
            PG8_LDA(At, 0, 1); PG8_STAGE(PG8_SB(0, 0), b2, voffB); PG8_STAGE(PG8_SB(0, 1), b2 + hstep, voffB); PG8_STAGE(PG8_SA(0, 0), a2, voffA);
            PG8_WAIT_V(8); PG8_WAIT_L(0); PG8_BAR; PG8_MMA(1, 0, At, B0); PG8_MMA(1, 1, At, B1); PG8_BAR; PG8_SCHED;
            PG8_LDB(B0, 1, 0); PG8_LDB(B1, 1, 1); PG8_SCHED; PG8_LDA(At, 1, 0); PG8_STAGE(PG8_SA(0, 1), a2 + hstep, voffA);
            PG8_WAIT_V(8); PG8_WAIT_L(0); PG8_BAR; PG8_MMA(0, 0, At, B0); PG8_MMA(0, 1, At, B1); PG8_BAR; PG8_SCHED;
            PG8_LDA(At, 1, 1); PG8_STAGE(PG8_SB(1, 0), b3, voffB); PG8_STAGE(PG8_SB(1, 1), b3 + hstep, voffB); PG8_STAGE(PG8_SA(1, 0), a3, voffA);
            PG8_WAIT_V(8); PG8_WAIT_L(0); PG8_BAR; PG8_MMA(1, 0, At, B0); PG8_MMA(1, 1, At, B1); PG8_BAR; PG8_SCHED;
            } else {
            PG8_LDB(B0, 0, 0); PG8_SCHED; PG8_LDA(At, 0, 0); PG8_STAGE(PG8_SA(1, 1), a1 + hstep, voffA);
            PG8_WAIT_L(8); PG8_BAR; PG8_WAIT_L(0); PG8_MMA(0, 0, At, B0); PG8_BAR; PG8_SCHED;
            PG8_LDB(B1, 0, 1); PG8_STAGE(PG8_SB(0, 0), b2, voffB);
            PG8_BAR; PG8_WAIT_L(0); PG8_MMA(0, 1, At, B1); PG8_BAR;
            PG8_LDA(At, 0, 1); PG8_STAGE(PG8_SA(0, 0), a2, voffA);
            PG8_BAR; PG8_WAIT_L(0); PG8_MMA(1, 0, At, B0); PG8_BAR; PG8_SCHED;
            PG8_STAGE(PG8_SB(0, 1), b2 + hstep, voffB);
            PG8_WAIT_V(6); PG8_BAR; PG8_MMA(1, 1, At, B1); PG8_BAR;
            PG8_LDB(B0, 1, 0); PG8_SCHED; PG8_LDA(At, 1, 0); PG8_STAGE(PG8_SA(0, 1), a2 + hstep, voffA);
            PG8_WAIT_L(8); PG8_BAR; PG8_WAIT_L(0); PG8_MMA(0, 0, At, B0); PG8_BAR; PG8_SCHED;
            PG8_LDB(B1, 1, 1); PG8_STAGE(PG8_SB(1, 0), b3, voffB);
            PG8_BAR; PG8_WAIT_L(0); PG8_MMA(0, 1, At, B1); PG8_BAR;
            PG8_LDA(At, 1, 1); PG8_STAGE(PG8_SA(1, 0), a3, voffA);
            PG8_BAR; PG8_WAIT_L(0); PG8_MMA(1, 0, At, B0); PG8_BAR; PG8_SCHED;
            PG8_STAGE(PG8_SB(1, 1), b3 + hstep, voffB);
            PG8_WAIT_V(6); PG8_BAR; PG8_MMA(1, 1, At, B1); PG8_BAR;
            }
        }
        if constexpr (ALIGN_EPI) { if (wr == 0) PG8_BAR; }
        if constexpr (!Epi::AFTER_DRAIN) { E(acc, cur, wr, wc, fr, fq); if constexpr (Epi::REP > 1) { asm volatile("" ::: "memory"); E(acc, cur, wr, wc, fr, fq); } S.done(cur); }
        if (!has_next) break;
#pragma unroll
        for (int a = 0; a < 2; ++a)
#pragma unroll
            for (int b = 0; b < 2; ++b)
#pragma unroll
                for (int m = 0; m < 4; ++m)
#pragma unroll
                    for (int n = 0; n < 2; ++n) acc[a][b][m][n] = (f32x4){0.f, 0.f, 0.f, 0.f};
        cur = nxt; cA = nA; cB = nB; ++ui;
        if constexpr (ALIGN_EPI) { if (wr == 1) PG8_BAR; }
    }
    PG8_WAIT_V(0);
    if constexpr (!ALIGN_EPI) { if (wr == 0) PG8_BAR; }
    PG8_BAR;
    if constexpr (Epi::AFTER_DRAIN) { E.fused(acc, cur, wr, wc, fr, fq, lds, wid, lane); if constexpr (Epi::REP > 1) { __syncthreads(); E.fused(acc, cur, wr, wc, fr, fq, lds, wid, lane); } S.done(cur); }
#undef PG8_SA
#undef PG8_SB
#undef PG8_STAGE
#undef PG8_LDA
#undef PG8_LDB
#undef PG8_MMA
#undef PG8_WAIT_V
#undef PG8_WAIT_L
#undef PG8_BAR
#undef PG8_SCHED
}
}
#ifndef REP_TR
#define REP_TR 1
#endif
#ifndef REP_SGU
#define REP_SGU 1
#endif
#ifndef REP_CONV
#define REP_CONV 1
#endif
#ifndef REP_P0
#define REP_P0 1
#endif
#ifndef REP_P1
#define REP_P1 1
#endif
#ifndef REP_P2
#define REP_P2 1
#endif
#ifndef REP_P3
#define REP_P3 1
#endif
#ifndef REP_P4
#define REP_P4 1
#endif
#ifndef PG8_SP2
#define PG8_SP2 true
#endif
#ifndef PG8_ALIGN
#define PG8_ALIGN true
#endif
#define LAS __attribute__((address_space(3)))
typedef unsigned short bf16;
typedef unsigned v4u __attribute__((ext_vector_type(4)));
typedef unsigned v2u __attribute__((ext_vector_type(2)));
typedef float f32x4 __attribute__((ext_vector_type(4)));
typedef float f32x2 __attribute__((ext_vector_type(2)));
typedef short bf16x8 __attribute__((ext_vector_type(8)));
#define LDS_WAIT() asm volatile("s_waitcnt lgkmcnt(0)" ::: "memory")

constexpr int NWAVES = 8, NTHR = 512;
constexpr int M = 16384, D = 1024, DIN = 3072, DPLE = 256, DC = 512, SEQ = 8192, CHUNK = 128, NHEAD = 8, CW = 31;
constexpr float LN_EPS = 1e-5f, ALPHA = 1.189207115002721f;
constexpr size_t MiB = 1u << 20;
constexpr size_t WS_CP1 = 0, WS_CP2 = 64 * 1024, WS_STATSP = 128 * 1024;
constexpr size_t WS_WSB = 1 * MiB;
constexpr size_t WS_WIN = 2 * MiB, WS_WOUT = 8 * MiB, WS_WG = 10 * MiB, WS_WPLE = 12 * MiB;
constexpr size_t WS_H = 16 * MiB, WS_PB = 48 * MiB, WS_PE = 56 * MiB, WS_Y = 88 * MiB, WS_RB = 120 * MiB;
constexpr size_t WS_AB = 152 * MiB, WS_SZ = 168 * MiB, WS_UG = 184 * MiB, WS_GV = 200 * MiB;
constexpr size_t WS_R = 152 * MiB;
constexpr size_t WS_END = 216 * MiB;
constexpr int LDS_BYTES = 147456;

__device__ __forceinline__ unsigned f2bf(float f) { unsigned u = __builtin_bit_cast(unsigned, f); return (u + 0x7fffu + ((u >> 16) & 1u)) >> 16; }
__device__ __forceinline__ unsigned pk2(float lo, float hi) { unsigned r; asm volatile("v_cvt_pk_bf16_f32 %0, %1, %2" : "=v"(r) : "v"(lo), "v"(hi)); return r; }
__device__ __forceinline__ float bf_lo(unsigned u) { return __uint_as_float(u << 16); }
__device__ __forceinline__ float bf_hi(unsigned u) { return __uint_as_float(u & 0xffff0000u); }
template <int CTRL> __device__ __forceinline__ float dpp_addc(float v) {
    return v + __builtin_bit_cast(float, __builtin_amdgcn_update_dpp(0, __builtin_bit_cast(int, v), CTRL, 0xF, 0xF, true));
}
__device__ __forceinline__ float wave_sum(float v) {
    v = dpp_addc<0xB1>(v);
    v = dpp_addc<0x4E>(v);
    v = dpp_addc<0x141>(v);
    v = dpp_addc<0x140>(v);
    const int vi = __builtin_bit_cast(int, v);
    const float r0 = __builtin_bit_cast(float, __builtin_amdgcn_readlane(vi, 0)), r1 = __builtin_bit_cast(float, __builtin_amdgcn_readlane(vi, 16)),
                r2 = __builtin_bit_cast(float, __builtin_amdgcn_readlane(vi, 32)), r3 = __builtin_bit_cast(float, __builtin_amdgcn_readlane(vi, 48));
    return (r0 + r1) + (r2 + r3);
}
__device__ __forceinline__ float sigm_f(float x) { return __builtin_amdgcn_rcpf(1.0f + __builtin_amdgcn_exp2f(-1.44269504089f * x)); }

#define GAS __attribute__((address_space(1)))
constexpr size_t WS_BAR = 768 * 1024, BAR_ZERO_BYTES = 16384;
constexpr int MISC_OFF = LDS_BYTES - 128;
#define XB_TMO      128
#define XB_XCNT(j)  (256  + 64 * (j))
#define XB_XSUB(j)  (1280 + 64 * (j))
#define XB_XGEN(j)  (2304 + 64 * (j))
#define XB_TOP      3328
#define XB_TOPGEN   3392
#define XCD_BAR_WORDS 3456
#define XB_SPIN_CAP (1u << 18)

__device__ __forceinline__ unsigned xb_ld(unsigned* p)              { return __hip_atomic_load(p, __ATOMIC_RELAXED, __HIP_MEMORY_SCOPE_AGENT); }
__device__ __forceinline__ unsigned xb_add(unsigned* p, unsigned v) { return __hip_atomic_fetch_add(p, v, __ATOMIC_RELAXED, __HIP_MEMORY_SCOPE_AGENT); }
__device__ __forceinline__ unsigned xb_xcc_id() { return (unsigned)__builtin_amdgcn_s_getreg((3 << 11) | 20) & 0xFu; }
#define XB_SPIN(cond, bar) do { unsigned _sp = 0; while (cond) { __builtin_amdgcn_s_sleep(1); \
    if ((++_sp & 255u) == 0u) { if (xb_ld(&(bar)[XB_TMO])) break; if (_sp > XB_SPIN_CAP) { atomicAdd(&(bar)[XB_TMO], 1u); break; } } } } while (0)

struct XcdBarrier {
    unsigned* bar; unsigned x;
    volatile LAS unsigned* st;
};

__device__ __forceinline__ XcdBarrier xcd_barrier_post(unsigned* bar, volatile LAS unsigned* st) {
    XcdBarrier b; b.bar = bar; b.x = xb_xcc_id(); b.st = st;
    if (threadIdx.x == 0) (void)xb_add(&bar[XB_XCNT(b.x)], 1u);
    return b;
}
__device__ __forceinline__ void xcd_barrier_complete(unsigned* bar, unsigned x, unsigned& nloc, unsigned& nx) {
    const unsigned G = gridDim.x * gridDim.y * gridDim.z;
    unsigned sum, cnt, mine, sp = 0u;
    for (;;) {
        sum = 0u; cnt = 0u; mine = 0u;
#pragma unroll
        for (unsigned j = 0; j < 16; ++j) { const unsigned c = xb_ld(&bar[XB_XCNT(j)]); sum += c; cnt += (c > 0u) ? 1u : 0u; mine = (j == x) ? c : mine; }
        if (sum == G) break;
        __builtin_amdgcn_s_sleep(1);
        if ((++sp & 255u) == 0u) { if (xb_ld(&bar[XB_TMO])) break; if (sp > XB_SPIN_CAP) { atomicAdd(&bar[XB_TMO], 1u); break; } }
    }
    nloc = mine > 0u ? mine : 1u; nx = cnt > 0u ? cnt : 1u;
}

__device__ __forceinline__ void xcd_barrier(const XcdBarrier& b) {
    asm volatile("s_waitcnt vmcnt(0)" ::: "memory");
    __syncthreads();
    if (threadIdx.x == 0) {
        unsigned* bar = b.bar;
        __builtin_amdgcn_s_waitcnt(0);
        unsigned nloc = b.st[0], nx = b.st[1];
        if (nloc == 0u) { xcd_barrier_complete(bar, b.x, nloc, nx); b.st[0] = nloc; b.st[1] = nx; }
        const unsigned old = xb_add(&bar[XB_XSUB(b.x)], 1u);
        const unsigned gen = old / nloc;
        if (old + 1u == (gen + 1u) * nloc) {
            __builtin_amdgcn_fence(__ATOMIC_RELEASE, "agent");
            asm volatile("s_waitcnt vmcnt(0)" ::: "memory");
            const unsigned og = xb_add(&bar[XB_TOP], 1u);
            const unsigned tg = og / nx;
            if (og + 1u == (tg + 1u) * nx) xb_add(&bar[XB_TOPGEN], 1u);
            else XB_SPIN(xb_ld(&bar[XB_TOPGEN]) == tg, bar);
            __builtin_amdgcn_fence(__ATOMIC_ACQUIRE, "agent");
            xb_add(&bar[XB_XGEN(b.x)], 1u);
            asm volatile("s_waitcnt vmcnt(0)" ::: "memory");
        } else {
            XB_SPIN(xb_ld(&bar[XB_XGEN(b.x)]) == gen, bar);
            __builtin_amdgcn_fence(__ATOMIC_ACQUIRE, "agent");
            asm volatile("s_waitcnt vmcnt(0)" ::: "memory");
        }
    }
    __syncthreads();
}

struct Args { const float* in[19]; float* out; unsigned char* ws; };

__device__ __forceinline__ int win_map(int n) {
    const int seg = n >> 9, o = n & 511, blk = o >> 7, w = o & 127;
    if (seg == 0) return 256 * blk + w;
    if (seg == 1) return 256 * blk + 128 + w;
    if (seg == 2) return 1024 + o;
    if (seg == 3) return 1536 + 256 * blk + w;
    if (seg == 5) return 1536 + 256 * blk + 128 + w;
    return 2560 + o;
}
template <bool GATE>
__device__ __forceinline__ void tr_item(const float* W, int K, int N, bf16* WT, int drow, LAS float* scr, int k0, int n0, int lane, const float* g, const float* b, float* cp1, float* cp2) {
#pragma unroll
    for (int i = 0; i < 32; ++i) { const int kk = 2 * i + (lane >> 5); scr[kk * 33 + (lane & 31)] = W[(size_t)(k0 + kk) * N + n0 + (lane & 31)]; }
    LDS_WAIT(); asm volatile("" ::: "memory");
    const int c = lane & 7;
    float gs[8];
#pragma unroll
    for (int e = 0; e < 8; ++e) gs[e] = GATE ? g[k0 + 8 * c + e] : 1.0f;
#pragma unroll
    for (int j = 0; j < 4; ++j) { const int n = (lane >> 3) + 8 * j; const LAS float* s = scr + (8 * c) * 33 + n;
        v4u o; o.x = pk2(s[0 * 33] * gs[0], s[1 * 33] * gs[1]); o.y = pk2(s[2 * 33] * gs[2], s[3 * 33] * gs[3]); o.z = pk2(s[4 * 33] * gs[4], s[5 * 33] * gs[5]); o.w = pk2(s[6 * 33] * gs[6], s[7 * 33] * gs[7]);
        *(v4u*)(WT + (size_t)(drow + n) * K + k0 + 8 * c) = o; }
    if (GATE) { const int n = lane & 31, half = lane >> 5; float s1 = 0.f, s2 = 0.f;
#pragma unroll 8
        for (int kk = 0; kk < 32; ++kk) { const int k = 32 * half + kk; const float w = scr[k * 33 + n]; s1 += g[k0 + k] * w; s2 += b[k0 + k] * w; }
        s1 += __shfl_xor(s1, 32); s2 += __shfl_xor(s2, 32);
        if (lane < 32) { cp1[(k0 >> 6) * N + n0 + n] = s1; cp2[(k0 >> 6) * N + n0 + n] = s2; } }
    LDS_WAIT(); asm volatile("" ::: "memory");
}

__device__ __forceinline__ void p0_prologue(const Args& a, LAS unsigned char* lds, int wave, int lane) {
    unsigned char* ws = a.ws;
    LAS float* scr = (LAS float*)(lds + wave * 16384);
    const int gw = blockIdx.x * NWAVES + wave, NGW = gridDim.x * NWAVES;
    constexpr int I_IN = (D / 64) * (DIN / 32), I_OUT = (D / 64) * (D / 32), I_G = I_OUT, I_PLE = (DPLE / 64) * (D / 32);
    constexpr int NITEMS = I_IN + I_OUT + I_G + I_PLE;
    const float* x = a.in[0]; bf16* H = (bf16*)(ws + WS_H);
    f32x4 xv[8][4];
    const bool xl = (gridDim.x % 8 == 0) && (M / 8) % (int)gridDim.x == 0;
    const int rbase = xl ? (int)(blockIdx.x % 8) * (M / 8) + ((int)(blockIdx.x / 8) * NWAVES + wave) * 8 : gw, rstep = xl ? 1 : NGW, rend = xl ? rbase + 8 : M;
#pragma unroll
    for (int r = 0; r < 8; ++r) { const int mr = rbase + r * rstep; const f32x4* xr = (const f32x4*)(x + (size_t)(mr < rend ? mr : rbase) * D) + lane;
#pragma unroll
        for (int j = 0; j < 4; ++j) xv[r][j] = xr[64 * j]; }
    for (int rep = 0; rep < REP_TR; ++rep)
    for (int it = gw; it < NITEMS; it += NGW) {
        int r = it;
        if (r < I_IN) { const int nblk = DIN / 32, kb = r / nblk, nb = r % nblk; tr_item<false>(a.in[4], D, DIN, (bf16*)(ws + WS_WIN), win_map(32 * nb), scr, 64 * kb, 32 * nb, lane, nullptr, nullptr, nullptr, nullptr); continue; } r -= I_IN;
        if (r < I_OUT) { const int nblk = D / 32, kb = r / nblk, nb = r % nblk; tr_item<false>(a.in[13], D, D, (bf16*)(ws + WS_WOUT), 32 * nb, scr, 64 * kb, 32 * nb, lane, nullptr, nullptr, nullptr, nullptr); continue; } r -= I_OUT;
        if (r < I_G) { const int nblk = D / 32, kb = r / nblk, nb = r % nblk; tr_item<true>(a.in[17], D, D, (bf16*)(ws + WS_WG), 32 * nb, scr, 64 * kb, 32 * nb, lane, a.in[14], a.in[15], (float*)(ws + WS_CP1), (float*)(ws + WS_CP2)); continue; } r -= I_G;
        { const int nblk = D / 32, kb = r / nblk, nb = r % nblk; tr_item<false>(a.in[16], DPLE, D, (bf16*)(ws + WS_WPLE), 32 * nb, scr, 64 * kb, 32 * nb, lane, nullptr, nullptr, nullptr, nullptr); }
    }
    {
        f32x4 gg[4], bb[4];
#pragma unroll
        for (int j = 0; j < 4; ++j) { gg[j] = *(const f32x4*)(a.in[2] + 4 * lane + 256 * j); bb[j] = *(const f32x4*)(a.in[3] + 4 * lane + 256 * j); }
        for (int m = rbase; m < rend; m += xl ? (1 << 30) : 8 * rstep) {
            if (m != rbase) {
#pragma unroll
                for (int r = 0; r < 8; ++r) { const int mr = m + r * rstep; const f32x4* xr = (const f32x4*)(x + (size_t)(mr < rend ? mr : m) * D) + lane;
#pragma unroll
                    for (int j = 0; j < 4; ++j) xv[r][j] = xr[64 * j]; }
            }
#pragma unroll
            for (int r = 0; r < 8; ++r) { float s = 0.f;
#pragma unroll
                for (int j = 0; j < 4; ++j) s += (xv[r][j][0] + xv[r][j][1]) + (xv[r][j][2] + xv[r][j][3]);
                const float mean = wave_sum(s) * (1.f / D); float s2 = 0.f;
#pragma unroll
                for (int j = 0; j < 4; ++j) { xv[r][j] = xv[r][j] - mean; s2 += (xv[r][j][0] * xv[r][j][0] + xv[r][j][1] * xv[r][j][1]) + (xv[r][j][2] * xv[r][j][2] + xv[r][j][3] * xv[r][j][3]); }
                const float rstd = 1.f / sqrtf(wave_sum(s2) * (1.f / D) + LN_EPS);
                if (m + r * rstep < rend) { v2u* o8 = (v2u*)(H + (size_t)(m + r * rstep) * D) + lane;
#pragma unroll
                    for (int j = 0; j < 4; ++j) { const f32x4 y = xv[r][j] * rstd * gg[j] + bb[j]; o8[64 * j] = (v2u){pk2(y[0], y[1]), pk2(y[2], y[3])}; } } }
        }
    }
    {
        const float* p = a.in[1]; bf16* Pb = (bf16*)(ws + WS_PB);
        const int gt = blockIdx.x * NTHR + threadIdx.x, NGT = gridDim.x * NTHR;
        for (int i0 = gt; i0 < M * DPLE / 8; i0 += 4 * NGT) {
            f32x4 a0[4], a1[4];
#pragma unroll
            for (int r = 0; r < 4; ++r) { const int i = i0 + r * NGT; const bool ok = i < M * DPLE / 8; const size_t o = (size_t)(ok ? i : i0) * 8; a0[r] = *(const f32x4*)(p + o); a1[r] = *(const f32x4*)(p + o + 4); }
#pragma unroll
            for (int r = 0; r < 4; ++r) { const int i = i0 + r * NGT; if (i < M * DPLE / 8)
                *(v4u*)(Pb + (size_t)i * 8) = (v4u){pk2(a0[r][0], a0[r][1]), pk2(a0[r][2], a0[r][3]), pk2(a1[r][0], a1[r][1]), pk2(a1[r][2], a1[r][3])}; }
        }
        const float* wsrc = a.in[11]; bf16* Wsb = (bf16*)(ws + WS_WSB);
        for (int i = gt; i < NHEAD * CHUNK * CHUNK / 8; i += NGT) { const int t = (i >> 4) & 127, s0 = (i & 15) * 8;
            const f32x4 a0 = *(const f32x4*)(wsrc + (size_t)i * 8), a1 = *(const f32x4*)(wsrc + (size_t)i * 8 + 4);
            float e[8] = {a0[0], a0[1], a0[2], a0[3], a1[0], a1[1], a1[2], a1[3]};
#pragma unroll
            for (int k = 0; k < 8; ++k) e[k] = (s0 + k <= t) ? e[k] : 0.f;
            *(v4u*)(Wsb + (size_t)i * 8) = (v4u){pk2(e[0], e[1]), pk2(e[2], e[3]), pk2(e[4], e[5]), pk2(e[6], e[7])}; }
    }
}

template <int J> struct ConvStep {
    static __device__ __forceinline__ void run(f32x2 (&acc)[16], const f32x2 (&w)[CW], const LAS unsigned char* p) {
        const unsigned d = *(const LAS unsigned*)(p + J * 1024); const f32x2 v = (f32x2){bf_lo(d), bf_hi(d)};
#pragma unroll
        for (int k = 0; k < CW; ++k) { const int t = J - k; if (t >= 0 && t < 16) acc[t] += w[k] * v; }
        ConvStep<J + 1>::run(acc, w, p);
    }
};
template <> struct ConvStep<46> { static __device__ __forceinline__ void run(f32x2 (&)[16], const f32x2 (&)[CW], const LAS unsigned char*) {} };
__device__ __forceinline__ void conv_tile_load(v4u (&pf)[8], int it, const bf16* Ab, int tid) {
    const int m0 = it * 32, t0 = m0 & (SEQ - 1);
#pragma unroll
    for (int i = 0; i < 8; ++i) { const int q = tid + i * NTHR, row = q >> 6, c16 = q & 63; pf[i] = (v4u){0u, 0u, 0u, 0u};
        if (q < 62 * 64 && t0 - 30 + row >= 0) pf[i] = *(const v4u*)(Ab + (size_t)(m0 - 30 + row) * DC + c16 * 8); }
}
__device__ __forceinline__ void conv_item(LAS unsigned char* lds, int it, int it_next, v4u (&pf)[8], const bf16* Ab, const bf16* SZ, bf16* Y, const f32x2 (&w)[CW], f32x2 cb,
                                          const float* lng, const float* lnb, int tid, int wave, int lane) {
    const int m0 = it * 32;
    LAS unsigned char* in = lds; LAS float* outt = (LAS float*)(lds + 65536);
#pragma unroll
    for (int i = 0; i < 8; ++i) { const int q = tid + i * NTHR, row = q >> 6, c16 = q & 63; if (q < 62 * 64) *(LAS v4u*)(in + row * 1024 + c16 * 16) = pf[i]; }
    __syncthreads();
    if (it_next >= 0) conv_tile_load(pf, it_next, Ab, tid);
    f32x4 gg[2], bb[2]; v2u zz[4][2];
#pragma unroll
    for (int j = 0; j < 2; ++j) { const int c = 4 * lane + 256 * j; gg[j] = *(const f32x4*)(lng + c); bb[j] = *(const f32x4*)(lnb + c);
#pragma unroll
        for (int rr = 0; rr < 4; ++rr) zz[rr][j] = *(const v2u*)(SZ + (size_t)(m0 + 4 * wave + rr) * DC + c); }
    const int cp = tid & 255, rh = tid >> 8;
    f32x2 acc[16];
#pragma unroll
    for (int t = 0; t < 16; ++t) acc[t] = (f32x2){0.f, 0.f};
    ConvStep<0>::run(acc, w, in + (16 * rh) * 1024 + cp * 4);
#pragma unroll
    for (int t = 0; t < 16; ++t) *(LAS f32x2*)(outt + (16 * rh + t) * DC + 2 * cp) = acc[t] + cb;
    __syncthreads();
    {
#pragma unroll
        for (int rr = 0; rr < 4; ++rr) { const int row = 4 * wave + rr; const size_t m = (size_t)(m0 + row);
            f32x4 v[2]; float s = 0.f;
#pragma unroll
            for (int j = 0; j < 2; ++j) { v[j] = *(const LAS f32x4*)(outt + row * DC + 4 * lane + 256 * j); s += (v[j][0] + v[j][1]) + (v[j][2] + v[j][3]); }
            const float mean = wave_sum(s) * (1.f / DC); float s2 = 0.f;
#pragma unroll
            for (int j = 0; j < 2; ++j) { v[j] = v[j] - mean; s2 += (v[j][0] * v[j][0] + v[j][1] * v[j][1]) + (v[j][2] * v[j][2] + v[j][3] * v[j][3]); }
            const float rstd = 1.f / sqrtf(wave_sum(s2) * (1.f / DC) + LN_EPS);
#pragma unroll
            for (int j = 0; j < 2; ++j) { const int c = 4 * lane + 256 * j;
                f32x4 y = v[j] * rstd * gg[j] + bb[j];
                y = (f32x4){y[0] * sigm_f(y[0]), y[1] * sigm_f(y[1]), y[2] * sigm_f(y[2]), y[3] * sigm_f(y[3])};
                y = y * (f32x4){bf_lo(zz[rr][j].x), bf_hi(zz[rr][j].x), bf_lo(zz[rr][j].y), bf_hi(zz[rr][j].y)};
                *(v2u*)(Y + m * D + c) = (v2u){pk2(y[0], y[1]), pk2(y[2], y[3])}; } }
    }
    __syncthreads();
}

__device__ __forceinline__ void sgu_item(LAS unsigned char* lds, int it, const bf16* GV, const bf16* UG, const bf16* Wsb, const float* bs, const float* lng, const float* lnb, bf16* Y,
                                         int tid, int wave, int lane) {
    constexpr int RS = 516;
    const int c = it >> 1, hh = it & 1, m0 = c * CHUNK;
    {
        const f32x4 g0 = *(const f32x4*)(lng + 8 * lane), g1 = *(const f32x4*)(lng + 8 * lane + 4), b0 = *(const f32x4*)(lnb + 8 * lane), b1 = *(const f32x4*)(lnb + 8 * lane + 4);
        v4u raw[16];
#pragma unroll
        for (int i = 0; i < 16; ++i) raw[i] = *(const v4u*)(GV + (size_t)(m0 + 16 * wave + i) * DC + 8 * lane);
#pragma unroll
        for (int i = 0; i < 16; ++i) {
            f32x4 x0 = (f32x4){bf_lo(raw[i].x), bf_hi(raw[i].x), bf_lo(raw[i].y), bf_hi(raw[i].y)}, x1 = (f32x4){bf_lo(raw[i].z), bf_hi(raw[i].z), bf_lo(raw[i].w), bf_hi(raw[i].w)};
            const float s = (x0[0] + x0[1]) + (x0[2] + x0[3]) + (x1[0] + x1[1]) + (x1[2] + x1[3]);
            const float mean = wave_sum(s) * (1.f / DC);
            x0 = x0 - mean; x1 = x1 - mean;
            const float q = (x0[0] * x0[0] + x0[1] * x0[1]) + (x0[2] * x0[2] + x0[3] * x0[3]) + (x1[0] * x1[0] + x1[1] * x1[1]) + (x1[2] * x1[2] + x1[3] * x1[3]);
            const float rstd = 1.f / sqrtf(wave_sum(q) * (1.f / DC) + LN_EPS);
            x0 = x0 * rstd * g0 + b0; x1 = x1 * rstd * g1 + b1;
            if ((lane >> 5) == hh) { LAS unsigned* dst = (LAS unsigned*)(lds + (16 * wave + i) * RS + (lane & 31) * 16);
                dst[0] = pk2(x0[0], x0[1]); dst[1] = pk2(x0[2], x0[3]); dst[2] = pk2(x1[0], x1[1]); dst[3] = pk2(x1[2], x1[3]); }
        }
    }
    bf16x8 wf[20]; v2u ugv[8][2]; float biasv[8];
    const int hl = wave >> 1, dh = wave & 1, h = 4 * hh + hl, dbase = hl * 64 + dh * 32, fr = lane & 15, q = lane >> 4;
    {
        int n = 0;
#pragma unroll
        for (int tb = 0; tb < 8; ++tb)
#pragma unroll
            for (int ks = 0; ks < 4; ++ks) if (ks <= (tb >> 1)) { wf[n] = *(const bf16x8*)(Wsb + ((size_t)(h * CHUNK + 16 * tb + fr)) * CHUNK + 32 * ks + 8 * q); ++n; }
#pragma unroll
        for (int tb = 0; tb < 8; ++tb) { const int t = 16 * tb + fr; biasv[tb] = bs[h * CHUNK + t];
#pragma unroll
            for (int nb = 0; nb < 2; ++nb) ugv[tb][nb] = *(const v2u*)(UG + (size_t)(m0 + t) * DC + 256 * hh + dbase + 16 * nb + 4 * q); }
    }
    __syncthreads();
    {
        bf16x8 vf[2][4];
#pragma unroll
        for (int nb = 0; nb < 2; ++nb)
#pragma unroll
            for (int ks = 0; ks < 4; ++ks)
#pragma unroll
                for (int jj = 0; jj < 8; ++jj) vf[nb][ks][jj] = (short)*(const LAS unsigned short*)(lds + (32 * ks + 8 * q + jj) * RS + 2 * (dbase + 16 * nb + fr));
        f32x4 acc[8][2];
#pragma unroll
        for (int tb = 0; tb < 8; ++tb) { acc[tb][0] = (f32x4){0.f, 0.f, 0.f, 0.f}; acc[tb][1] = (f32x4){0.f, 0.f, 0.f, 0.f}; }
        int n = 0;
#pragma unroll
        for (int tb = 0; tb < 8; ++tb)
#pragma unroll
            for (int ks = 0; ks < 4; ++ks) if (ks <= (tb >> 1)) {
                acc[tb][0] = __builtin_amdgcn_mfma_f32_16x16x32_bf16(vf[0][ks], wf[n], acc[tb][0], 0, 0, 0);
                acc[tb][1] = __builtin_amdgcn_mfma_f32_16x16x32_bf16(vf[1][ks], wf[n], acc[tb][1], 0, 0, 0); ++n; }
#pragma unroll
        for (int tb = 0; tb < 8; ++tb) { const int t = 16 * tb + fr; const size_t m = (size_t)(m0 + t);
#pragma unroll
            for (int nb = 0; nb < 2; ++nb) { const int col = 256 * hh + dbase + 16 * nb + 4 * q; const v2u ug = ugv[tb][nb];
                const f32x4 o = (acc[tb][nb] + biasv[tb]) * (f32x4){bf_lo(ug.x), bf_hi(ug.x), bf_lo(ug.y), bf_hi(ug.y)};
                *(v2u*)(Y + m * D + DC + col) = (v2u){pk2(o[0], o[1]), pk2(o[2], o[3])}; } }
    }
    __syncthreads();
}

__device__ __forceinline__ void p2_mixer(const Args& a, LAS unsigned char* lds, int tid, int wave, int lane) {
    unsigned char* ws = a.ws;
    const bf16* Ab = (const bf16*)(ws + WS_AB); const bf16* SZ = (const bf16*)(ws + WS_SZ); const bf16* UG = (const bf16*)(ws + WS_UG); const bf16* GV = (const bf16*)(ws + WS_GV);
    bf16* Y = (bf16*)(ws + WS_Y);
    const bool xl = (gridDim.x % 8 == 0);
    const int xq = blockIdx.x % 8, lq = blockIdx.x / 8, nl = gridDim.x / 8;
    v4u pf[8];
    constexpr int NCI = M / 32, NCIX = NCI / 8;
    const int first = xl ? xq * NCIX + lq : (int)blockIdx.x, step = xl ? nl : (int)gridDim.x, last = xl ? (xq + 1) * NCIX : NCI;
    if (first < last) conv_tile_load(pf, first, Ab, tid);
    for (int j = xl ? lq : (int)blockIdx.x; j < (xl ? M / CHUNK * 2 / 8 : M / CHUNK * 2); j += xl ? nl : (int)gridDim.x) { const int it = xl ? xq * (M / CHUNK * 2 / 8) + j : j;
        sgu_item(lds, it, GV, UG, (const bf16*)(ws + WS_WSB), a.in[12], a.in[9], a.in[10], Y, tid, wave, lane); }
    {
        const int cp = tid & 255;
        f32x2 w[CW];
#pragma unroll
        for (int k = 0; k < CW; ++k) w[k] = *(const f32x2*)(a.in[5] + k * DC + 2 * cp);
        const f32x2 cb = *(const f32x2*)(a.in[6] + 2 * cp);
        for (int rep = 0; rep < REP_CONV; ++rep)
        for (int it = first; it < last; it += step) { const int nx = it + step < last ? it + step : ((REP_CONV > 1 && rep + 1 < REP_CONV) ? first : -1);
            conv_item(lds, it, nx, pf, Ab, SZ, Y, w, cb, a.in[7], a.in[8], tid, wave, lane); }
    }
}

__global__ void __launch_bounds__(NTHR, 2) fwd_megakernel(Args a) {
    extern __shared__ __attribute__((aligned(16))) unsigned char lds_raw[];
    LAS unsigned char* lds = (LAS unsigned char*)lds_raw;
    cg::grid_group grid = cg::this_grid();
#define FRESH_IDS int tid = threadIdx.x; asm volatile("" : "+v"(tid)); const int lane = tid & 63, wave = __builtin_amdgcn_readfirstlane(tid >> 6); (void)lane; (void)wave;
    unsigned char* ws = a.ws;
    const int G = gridDim.x;
    if (threadIdx.x < 32) ((LAS unsigned*)(lds + MISC_OFF))[threadIdx.x] = 0u;
    __syncthreads();
    const XcdBarrier bar = xcd_barrier_post((unsigned*)(ws + WS_BAR), (volatile LAS unsigned*)(lds + MISC_OFF));
    if (ws == nullptr) grid.sync();
#define GRID_BAR() xcd_barrier(bar)

#ifndef NO_P0
    for (int rep = 0; rep < REP_P0; ++rep) { FRESH_IDS p0_prologue(a, lds, wave, lane); }
#endif
    GRID_BAR();

#ifndef NO_P1
    for (int rep = 0; rep < REP_P1; ++rep) {
#ifndef NO_PE
    {
        pg8::Gemm g{(const bf16*)(ws + WS_PB), (const bf16*)(ws + WS_WPLE), M, D, DPLE}; pg8::StaticOrder S; S.init(M, D, G, (int)blockIdx.x);
        pg8::EpiBf16<0> E{(bf16*)(ws + WS_PE), D, nullptr, 0, 0, 1.f};
        pg8::gemm_phase<pg8::EpiBf16<0>, pg8::StaticOrder, PG8_ALIGN, PG8_SP2>(lds, g, S, E);
    }
#endif
#ifndef NO_IN
    {
        pg8::Gemm g{(const bf16*)(ws + WS_H), (const bf16*)(ws + WS_WIN), M, DIN, D}; pg8::StaticOrder S; S.init(M, DIN, G, (int)blockIdx.x);
        pg8::EpiP1 E{(bf16*)(ws + WS_AB), (bf16*)(ws + WS_SZ), (bf16*)(ws + WS_UG), (bf16*)(ws + WS_GV)};
        pg8::gemm_phase<pg8::EpiP1, pg8::StaticOrder, PG8_ALIGN, PG8_SP2>(lds, g, S, E);
    }
#endif
    }
#endif
    GRID_BAR();

#ifndef NO_P2
    for (int rep = 0; rep < REP_P2; ++rep) { FRESH_IDS p2_mixer(a, lds, tid, wave, lane); }
#endif
    GRID_BAR();

#ifndef NO_P3
    for (int rep = 0; rep < REP_P3; ++rep)
    {
        pg8::Gemm g{(const bf16*)(ws + WS_Y), (const bf16*)(ws + WS_WOUT), M, D, D}; pg8::StaticOrder S; S.init(M, D, G, (int)blockIdx.x);
#ifdef PROBE_K3
        { pg8::EpiNone E0; pg8::gemm_phase<pg8::EpiNone, pg8::StaticOrder, false, PG8_SP2>(lds, g, S, E0); }
#endif
        pg8::EpiP3 E{(const bf16*)(ws + WS_H), (bf16*)(ws + WS_RB), (float*)(ws + WS_STATSP), ALPHA};
        pg8::gemm_phase<pg8::EpiP3, pg8::StaticOrder, false, PG8_SP2>(lds, g, S, E);
    }
#endif
    GRID_BAR();

#ifndef NO_P4
    for (int rep = 0; rep < REP_P4; ++rep)
    {
        pg8::Gemm g{(const bf16*)(ws + WS_RB), (const bf16*)(ws + WS_WG), M, D, D}; pg8::StaticOrder S; S.init(M, D, G, (int)blockIdx.x);
        pg8::EpiP4 E{(const bf16*)(ws + WS_RB), (const bf16*)(ws + WS_PE), (const float*)(ws + WS_STATSP), (const float*)(ws + WS_CP1), (const float*)(ws + WS_CP2), a.in[18], a.in[14], a.in[15], a.out, LN_EPS};
        pg8::gemm_phase<pg8::EpiP4, pg8::StaticOrder, false, PG8_SP2>(lds, g, S, E);
    }
#endif
}

extern "C" void kernel_launch(void* const* d_in, const int* in_sizes, int n_in, void* d_out, int out_size, void* d_ws, size_t ws_size, hipStream_t stream) {
    static int grid = 0;
    if (grid == 0) {
        if (n_in != 19 || in_sizes[0] != M * D || out_size != M * D || ws_size < WS_END) { fprintf(stderr, "kernel_launch: unexpected shapes (n_in %d, in0 %d, out %d, ws %zu)\n", n_in, n_in > 0 ? in_sizes[0] : -1, out_size, ws_size); grid = -1; return; }
        int dev = 0, cus = 0, per_cu = 0;
        if (hipGetDevice(&dev) != hipSuccess || hipDeviceGetAttribute(&cus, hipDeviceAttributeMultiprocessorCount, dev) != hipSuccess) { fprintf(stderr, "kernel_launch: device query failed\n"); grid = -1; return; }
        if (hipFuncSetAttribute((const void*)fwd_megakernel, hipFuncAttributeMaxDynamicSharedMemorySize, LDS_BYTES) != hipSuccess) { fprintf(stderr, "kernel_launch: hipFuncSetAttribute failed\n"); grid = -1; return; }
        if (hipOccupancyMaxActiveBlocksPerMultiprocessor(&per_cu, (const void*)fwd_megakernel, NTHR, LDS_BYTES) != hipSuccess || per_cu < 1) { fprintf(stderr, "kernel_launch: occupancy query says %d\n", per_cu); per_cu = 1; }
        (void)hipGetLastError();
        grid = cus * 1;
    }
    if (grid < 0) return;
    Args a{};
    for (int i = 0; i < 19; ++i) a.in[i] = (const float*)d_in[i];
    a.out = (float*)d_out; a.ws = (unsigned char*)d_ws;
    if (hipMemsetAsync((char*)d_ws + WS_BAR, 0, BAR_ZERO_BYTES, stream) != hipSuccess) { fprintf(stderr, "kernel_launch: memset failed\n"); return; }
    void* args[] = {&a};
    hipError_t e = hipLaunchCooperativeKernel((const void*)fwd_megakernel, dim3(grid), dim3(NTHR), args, LDS_BYTES, stream);
    if (e != hipSuccess) fprintf(stderr, "kernel_launch: cooperative launch failed: %s (grid %d)\n", hipGetErrorString(e), grid);
}
```

```cpp
#include <hip/hip_runtime.h>
#include <hip/hip_cooperative_groups.h>
#include <cstdio>
#include <cstdint>
namespace cg = cooperative_groups;
namespace pg8 {
#define PG8_LAS __attribute__((address_space(3)))
typedef unsigned short bf16_t;
typedef short bf16x8 __attribute__((ext_vector_type(8)));
typedef float f32x4 __attribute__((ext_vector_type(4)));
typedef unsigned u32x4 __attribute__((ext_vector_type(4)));
constexpr int BM = 256, BK = 64, HALF = 128, HTB = HALF * BK * 2  , STAGE_BYTES = 8 * HTB, NXCD = 8, WGM = 8;

__host__ __device__ __forceinline__ int lds_byte(int r, int c) { const int st = (r >> 4) * 2 + (c >> 5), rr = r & 15, cc = c & 31, ob = rr * 64 + cc * 2; return st * 1024 + (ob ^ (((ob >> 9) & 1) << 5)); }
__host__ __device__ __forceinline__ void stage_rc(int b, int& R, int& C) { const int st = b / 1024, sb = b % 1024, swz = sb ^ (((sb >> 9) & 1) << 5); R = (st >> 1) * 16 + swz / 64; C = (st & 1) * 32 + (swz % 64) / 2; }
__host__ __device__ __forceinline__ int perm32(int rho) { const int n = rho >> 4, i = rho & 15; return 8 * (i >> 2) + 4 * n + (i & 3); }

struct Unit { int pm, pn, alt; };
struct Gemm { const bf16_t* A; const bf16_t* Bt; int M, N, K; const bf16_t* A2; const bf16_t* Bt2; int nt2; };

struct StaticOrder {
    int nM, nN, nwg, G, c, nN2, nwg2;
    __host__ __device__ void init(int M, int N, int G_, int c_) { nM = M / BM; nN = N / BM; nwg = nM * nN; G = G_; c = c_; nN2 = 0; nwg2 = 0; }
    __host__ __device__ void init2(int N2) { nN2 = N2 / BM; nwg2 = nM * nN2; }
    __host__ __device__ static void tile(int wgid, int nwg_, int nM_, int nN_, Unit& u) {
        { const int q = nwg_ / NXCD, r = nwg_ % NXCD, xcd = wgid % NXCD, off = wgid / NXCD; wgid = (xcd < r ? xcd * (q + 1) : r * (q + 1) + (xcd - r) * q) + off; }
        const int nig = WGM * nN_, gid = wgid / nig, fm = gid * WGM, gsz = (nM_ - fm) < WGM ? (nM_ - fm) : WGM;
        u.pm = fm + ((wgid % nig) % gsz); u.pn = (wgid % nig) / gsz;
    }
    __host__ __device__ bool next(int i, Unit& u) const {
        const long L = (long)i * G + c;
        if (L < nwg) { tile((int)L, nwg, nM, nN, u); u.alt = 0; return true; }
        const long L2 = L - nwg; if (L2 >= nwg2) return false;
        tile((int)L2, nwg2, nM, nN2, u); u.alt = 1; return true;
    }
    __device__ __forceinline__ void a_ready(const Unit&) const {}
    __device__ __forceinline__ void done(const Unit&) const {}
};

__device__ __forceinline__ unsigned cvt_pk_bf16(float lo, float hi) { unsigned r; asm volatile("v_cvt_pk_bf16_f32 %0, %1, %2" : "=v"(r) : "v"(lo), "v"(hi)); return r; }
typedef float f32x2 __attribute__((ext_vector_type(2)));
__device__ __forceinline__ f32x2 gelu_pk(f32x2 v) {
    const f32x2 av = __builtin_elementwise_abs(v), d = av * 0.2316418882f + 1.0f;
    f32x2 t; t.x = __builtin_amdgcn_rcpf(d.x); t.y = __builtin_amdgcn_rcpf(d.y);
    f32x2 q = t * 0.5307027145f + (-0.7265760135f); q = q * t + 0.7107068705f; q = q * t + (-0.142248368f); q = q * t + 0.127414796f; q = q * t;
    const f32x2 s = (v * v) * (-0.72134752044f);
    f32x2 e; e.x = __builtin_amdgcn_exp2f(s.x); e.y = __builtin_amdgcn_exp2f(s.y);
    const f32x2 m = v * (q * e), r = v - m;
    f32x2 o; o.x = v.x < 0.f ? m.x : r.x; o.y = v.y < 0.f ? m.y : r.y; return o;
}

template <int ACT  > struct EpiBf16 {
    static constexpr bool PERM = true, AFTER_DRAIN = false; static constexpr int REP = 1; static_assert(ACT == 0 || ACT == 1, "EpiBf16: ACT is 0 (none) or 1 (gelu_pk)");
    bf16_t* O; int ldc; const float* bias; int split_cols; size_t split_stride; float scale0;
    __device__ __forceinline__ void operator()(const f32x4 (&acc)[2][2][4][2], const Unit& u, int wr, int wc, int fr, int fq) const {
        const int row0 = u.pm * BM + wr * 64 + fr; int colt = u.pn * BM; bf16_t* base = O;
        float sc = 1.f; if (split_cols) { const int t = colt / split_cols; base += (size_t)t * split_stride; colt -= t * split_cols; if (t == 0) sc = scale0; }
        const int col0 = colt + wc * 32 + 8 * fq, bcol0 = u.pn * BM + wc * 32 + 8 * fq;
        f32x4 bv[2][2];
#pragma unroll
        for (int bj = 0; bj < 2; ++bj)
#pragma unroll
            for (int n = 0; n < 2; ++n) bv[bj][n] = bias ? *(const f32x4*)(bias + bcol0 + bj * HALF + 4 * n) : (f32x4){0.f, 0.f, 0.f, 0.f};
#pragma unroll
        for (int ai = 0; ai < 2; ++ai)
#pragma unroll
            for (int m = 0; m < 4; ++m) { bf16_t* rowp = base + (size_t)(row0 + ai * HALF + m * 16) * ldc + col0;
#pragma unroll
                for (int bj = 0; bj < 2; ++bj) { f32x4 v0 = acc[ai][bj][m][0] + bv[bj][0], v1 = acc[ai][bj][m][1] + bv[bj][1];
                    if (ACT == 1) { f32x2 a = gelu_pk((f32x2){v0[0], v0[1]}), b = gelu_pk((f32x2){v0[2], v0[3]}), c = gelu_pk((f32x2){v1[0], v1[1]}), d = gelu_pk((f32x2){v1[2], v1[3]});
                        v0 = (f32x4){a.x, a.y, b.x, b.y}; v1 = (f32x4){c.x, c.y, d.x, d.y}; }
                    v0 = v0 * sc; v1 = v1 * sc; u32x4 w; w.x = cvt_pk_bf16(v0[0], v0[1]); w.y = cvt_pk_bf16(v0[2], v0[3]); w.z = cvt_pk_bf16(v1[0], v1[1]); w.w = cvt_pk_bf16(v1[2], v1[3]);
                    *(u32x4*)(rowp + bj * HALF) = w; } }
    }
};
#ifndef REP_E1
#define REP_E1 1
#endif
#ifndef REP_E3
#define REP_E3 1
#endif
#ifndef REP_E4
#define REP_E4 1
#endif
__device__ __forceinline__ float sigm(float x) { return __builtin_amdgcn_rcpf(1.0f + __builtin_amdgcn_exp2f(-1.44269504089f * x)); }
__device__ __forceinline__ f32x4 sigm4(f32x4 v) { return (f32x4){sigm(v[0]), sigm(v[1]), sigm(v[2]), sigm(v[3])}; }
__device__ __forceinline__ f32x4 gelu4(f32x4 v) { const f32x2 a = gelu_pk((f32x2){v[0], v[1]}), b = gelu_pk((f32x2){v[2], v[3]}); return (f32x4){a.x, a.y, b.x, b.y}; }
__device__ __forceinline__ u32x4 pack8(f32x4 v0, f32x4 v1) { u32x4 w; w.x = cvt_pk_bf16(v0[0], v0[1]); w.y = cvt_pk_bf16(v0[2], v0[3]); w.z = cvt_pk_bf16(v1[0], v1[1]); w.w = cvt_pk_bf16(v1[2], v1[3]); return w; }
__device__ __forceinline__ f32x4 unpk_lo(u32x4 w) { return (f32x4){__uint_as_float(w.x << 16), __uint_as_float(w.x & 0xffff0000u), __uint_as_float(w.y << 16), __uint_as_float(w.y & 0xffff0000u)}; }
__device__ __forceinline__ f32x4 unpk_hi(u32x4 w) { return (f32x4){__uint_as_float(w.z << 16), __uint_as_float(w.z & 0xffff0000u), __uint_as_float(w.w << 16), __uint_as_float(w.w & 0xffff0000u)}; }

__device__ __forceinline__ void store16_sc1(void* p, u32x4 v) { asm volatile("global_store_dwordx4 %0, %1, off sc1\n\ts_nop 1" :: "v"(p), "v"(v) : "memory"); }

struct EpiP1 {
    static constexpr bool PERM = true, AFTER_DRAIN = false; static constexpr int REP = REP_E1;
    bf16_t *Ab, *SZ, *UG, *GV;
    bf16_t *PE;
    __device__ __forceinline__ void operator()(const f32x4 (&acc)[2][2][4][2], const Unit& u, int wr, int wc, int fr, int fq) const {
        const int row0 = u.pm * BM + wr * 64 + fr, pn = u.pn, cl = wc * 32 + 8 * fq;
        if (u.alt) {
#pragma unroll
            for (int ai = 0; ai < 2; ++ai)
#pragma unroll
                for (int m = 0; m < 4; ++m) { bf16_t* rowp = PE + (size_t)(row0 + ai * HALF + m * 16) * 1024 + pn * BM + cl;
#pragma unroll
                    for (int bj = 0; bj < 2; ++bj) *(u32x4*)(rowp + bj * HALF) = pack8(acc[ai][bj][m][0], acc[ai][bj][m][1]); }
        } else if (pn < 6 || pn == 8 || pn == 9) {
            const bool glu = pn < 4; bf16_t* base = glu ? Ab : UG; const int colt = 128 * (glu ? pn : (pn < 6 ? pn - 4 : pn - 6)) + cl;
#pragma unroll
            for (int ai = 0; ai < 2; ++ai)
#pragma unroll
                for (int m = 0; m < 4; ++m) { bf16_t* rowp = base + (size_t)(row0 + ai * HALF + m * 16) * 512 + colt;
                    const f32x4 v0 = acc[ai][0][m][0], v1 = acc[ai][0][m][1], g0 = acc[ai][1][m][0], g1 = acc[ai][1][m][1];
                    f32x4 o0, o1;
                    if (glu) { o0 = v0 * sigm4(g0); o1 = v1 * sigm4(g1); }
                    else { o0 = gelu4(v0) * (g0 * sigm4(g0)); o1 = gelu4(v1) * (g1 * sigm4(g1)); }
                    *(u32x4*)rowp = pack8(o0, o1); }
        } else {
            const bool sil = pn < 8; bf16_t* base = sil ? SZ : GV; const int colt = 256 * (sil ? pn - 6 : pn - 10) + cl;
#pragma unroll
            for (int ai = 0; ai < 2; ++ai)
#pragma unroll
                for (int m = 0; m < 4; ++m) { bf16_t* rowp = base + (size_t)(row0 + ai * HALF + m * 16) * 512 + colt;
#pragma unroll
                    for (int bj = 0; bj < 2; ++bj) { const f32x4 v0 = acc[ai][bj][m][0], v1 = acc[ai][bj][m][1]; f32x4 o0, o1;
                        if (sil) { o0 = v0 * sigm4(v0); o1 = v1 * sigm4(v1); } else { o0 = gelu4(v0); o1 = gelu4(v1); }
                        *(u32x4*)(rowp + bj * HALF) = pack8(o0, o1); } }
        }
    }
};

struct EpiP3 {
    static constexpr int STAMP_SLOT = 9; static constexpr bool PERM = true, AFTER_DRAIN = true; static constexpr int REP = REP_E3;
    const bf16_t* H; bf16_t* RB; float* statsP; float alpha; unsigned* pcnt;
    __device__ __forceinline__ void fused(f32x4 (&acc)[2][2][4][2], const Unit& u, int wr, int wc, int fr, int fq, PG8_LAS unsigned char* lds, int wid, int lane) const {
        PG8_LAS f32x2* P = (PG8_LAS f32x2*)lds;
        const int col0 = u.pn * BM + wc * 32 + 8 * fq;
        const size_t off0 = (size_t)(u.pm * BM + wr * 64 + fr) * 1024 + col0;
        u32x4 hv[2][4][2];
#pragma unroll
        for (int ai = 0; ai < 2; ++ai)
#pragma unroll
            for (int m = 0; m < 4; ++m)
#pragma unroll
                for (int bj = 0; bj < 2; ++bj) hv[ai][m][bj] = __builtin_nontemporal_load((const u32x4*)(H + off0 + (size_t)(ai * HALF + m * 16) * 1024 + bj * HALF));
        asm volatile("" ::: "memory");
#pragma unroll
        for (int ai = 0; ai < 2; ++ai)
#pragma unroll
            for (int m = 0; m < 4; ++m) { const int r = ai * HALF + wr * 64 + m * 16 + fr; const size_t off = off0 + (size_t)(ai * HALF + m * 16) * 1024; float s1 = 0.f, s2 = 0.f;
#pragma unroll
                for (int bj = 0; bj < 2; ++bj) { const u32x4 hh = hv[ai][m][bj];
                    const f32x4 v0 = acc[ai][bj][m][0] + alpha * unpk_lo(hh), v1 = acc[ai][bj][m][1] + alpha * unpk_hi(hh);
                    store16_sc1(RB + off + bj * HALF, pack8(v0, v1));
                    s1 += (v0[0] + v0[1]) + (v0[2] + v0[3]) + (v1[0] + v1[1]) + (v1[2] + v1[3]);
                    s2 += (v0[0] * v0[0] + v0[1] * v0[1]) + (v0[2] * v0[2] + v0[3] * v0[3]) + (v1[0] * v1[0] + v1[1] * v1[1]) + (v1[2] * v1[2] + v1[3] * v1[3]); }
                s1 += __shfl_xor(s1, 16); s1 += __shfl_xor(s1, 32); s2 += __shfl_xor(s2, 16); s2 += __shfl_xor(s2, 32);
                if (fq == 0) P[r * 4 + wc] = (f32x2){s1, s2}; }
        __syncthreads();
        const int tid = wid * 64 + lane;
        if (tid < 256) { const f32x2 a = P[tid * 4 + 0], b = P[tid * 4 + 1], c = P[tid * 4 + 2], d = P[tid * 4 + 3];
            const float t1 = (a.x + b.x) + (c.x + d.x), t2 = (a.y + b.y) + (c.y + d.y);
            __hip_atomic_store((unsigned long long*)(statsP + (size_t)(u.pm * BM + tid) * 8 + u.pn * 2), ((unsigned long long)__float_as_uint(t2) << 32) | __float_as_uint(t1), __ATOMIC_RELAXED, __HIP_MEMORY_SCOPE_AGENT); }
        asm volatile("s_waitcnt vmcnt(0)" ::: "memory");
        __syncthreads();
        if (pcnt && tid == 0) (void)__hip_atomic_fetch_add(pcnt + 64 * u.pm, 1u, __ATOMIC_RELAXED, __HIP_MEMORY_SCOPE_AGENT);
    }
};

struct EpiP4 {
    static constexpr int STAMP_SLOT = 12; static constexpr bool PERM = true, AFTER_DRAIN = true; static constexpr int REP = REP_E4;
    const bf16_t* RB; const bf16_t* PE; const float* statsP; const float* cp1; const float* cp2; const float* bgate; const float* g; const float* b; float* out; float eps;
    __device__ __forceinline__ void fused(f32x4 (&acc)[2][2][4][2], const Unit& u, int wr, int wc, int fr, int fq, PG8_LAS unsigned char* lds, int wid, int lane) const {
        PG8_LAS float* C = (PG8_LAS float*)lds;
        PG8_LAS f32x2* T = (PG8_LAS f32x2*)(lds + 2048);
        const int tid = wid * 64 + lane;
        const size_t off0 = (size_t)(u.pm * BM + wr * 64 + fr) * 1024 + u.pn * BM + wc * 32 + 8 * fq;
        u32x4 rw[2][2], pw[2][2];
#define P4_LOAD(s) do { _Pragma("unroll") for (int mm = 0; mm < 2; ++mm) { const size_t o_ = off0 + (size_t)((((s) >> 1) & 1) * HALF + (((s) & 1) * 2 + mm) * 16) * 1024 + ((s) >> 2) * HALF; \
            rw[(s) & 1][mm] = __builtin_nontemporal_load((const u32x4*)(RB + o_)); pw[(s) & 1][mm] = __builtin_nontemporal_load((const u32x4*)(PE + o_)); } } while (0)
        P4_LOAD(0);
        { const int col = tid & 255, which = tid >> 8; const float* cp = cp1 + which * (16 * 1024); float s = 0.f;
#pragma unroll
          for (int kb = 0; kb < 16; ++kb) s += cp[kb * 1024 + u.pn * BM + col];
          if (which) s += bgate[u.pn * BM + col];
          C[which * 256 + col] = s; }
        if (tid < 256) { const float* sp = statsP + (size_t)(u.pm * BM + tid) * 8; const f32x4 a = *(const f32x4*)sp, bq = *(const f32x4*)(sp + 4);
            const float s1 = (a[0] + a[2]) + (bq[0] + bq[2]), s2 = (a[1] + a[3]) + (bq[1] + bq[3]);
            const float mu = s1 * (1.0f / 1024.0f); float var = s2 * (1.0f / 1024.0f) - mu * mu; var = var < 0.f ? 0.f : var;
            T[tid] = (f32x2){mu, __builtin_amdgcn_rsqf(var + eps)}; }
        __syncthreads();
#pragma unroll
        for (int bj = 0; bj < 2; ++bj) {
            const int cl = wc * 32 + 8 * fq + bj * HALF, gc = u.pn * BM + cl;
            const f32x4 c1a = *(const PG8_LAS f32x4*)(C + cl), c1b = *(const PG8_LAS f32x4*)(C + cl + 4), c2a = *(const PG8_LAS f32x4*)(C + 256 + cl), c2b = *(const PG8_LAS f32x4*)(C + 256 + cl + 4);
            const f32x4 ga = *(const f32x4*)(g + gc), gb = *(const f32x4*)(g + gc + 4), ba = *(const f32x4*)(b + gc), bb = *(const f32x4*)(b + gc + 4);
#pragma unroll
            for (int s4 = 0; s4 < 4; ++s4) {
                const int s = bj * 4 + s4, ai = s4 >> 1, mh = s4 & 1;
                if (s + 1 < 8) P4_LOAD(s + 1);
                asm volatile("" ::: "memory");
#pragma unroll
                for (int mm = 0; mm < 2; ++mm) { const int m = 2 * mh + mm, r = ai * HALF + wr * 64 + m * 16 + fr; const f32x2 sr = T[r]; const size_t off = off0 + (size_t)(ai * HALF + m * 16) * 1024 + bj * HALF;
                    const f32x4 r0 = unpk_lo(rw[s & 1][mm]), r1 = unpk_hi(rw[s & 1][mm]), p0 = unpk_lo(pw[s & 1][mm]), p1 = unpk_hi(pw[s & 1][mm]);
                    const f32x4 gp0 = (acc[ai][bj][m][0] - sr.x * c1a) * sr.y + c2a, gp1 = (acc[ai][bj][m][1] - sr.x * c1b) * sr.y + c2b;
                    const f32x4 h0 = (r0 - sr.x) * sr.y * ga + ba, h1 = (r1 - sr.x) * sr.y * gb + bb;
                    *(f32x4*)(out + off) = h0 + sigm4(gp0) * p0; *(f32x4*)(out + off + 4) = h1 + sigm4(gp1) * p1; }
            }
        }
#undef P4_LOAD
    }
};


struct EpiNone {
    static constexpr bool PERM = true, AFTER_DRAIN = false; static constexpr int REP = 1;
    __device__ __forceinline__ void operator()(const f32x4 (&acc)[2][2][4][2], const Unit& u, int wr, int wc, int fr, int fq) const { asm volatile("" :: "v"(acc[0][0][0][0]), "v"(acc[1][1][3][1])); }
};
template <class Epi, class Sched, bool ALIGN_EPI = false, bool SP2 = false>
__device__ __forceinline__ void gemm_phase(PG8_LAS unsigned char* lds, const Gemm g, const Sched& S, const Epi& E) {
    int tid_ = threadIdx.x; asm volatile("" : "+v"(tid_));
    const int tid = tid_, wid = __builtin_amdgcn_readfirstlane(tid >> 6), lane = tid & 63, wr = wid >> 2, wc = wid & 3, fr = lane & 15, fq = lane >> 4;
    const int K = g.K, nt = K / BK;
    unsigned voffA[2], voffB[2];
#pragma unroll
    for (int i = 0; i < 2; ++i) { int R, C; stage_rc(tid * 16 + i * 8192, R, C); const int Rb = Epi::PERM ? ((R & ~31) + perm32(R & 31)) : R;
        voffA[i] = (unsigned)(R * K + C) * 2u; voffB[i] = (unsigned)(Rb * K + C) * 2u; }
    const size_t kstep = (size_t)(BK * 2);
    const size_t hstep = (size_t)HALF * K * 2;
    const size_t tstep = 2 * hstep;
    const unsigned ldsw = (unsigned)wid * 1024u;
    const int aoff = lds_byte(wr * 64 + fr, fq * 8), boff = lds_byte(wc * 32 + fr, fq * 8);
#define PG8_SA(b, h) (((b) * 2 + (h)) * HTB)
#define PG8_SB(b, h) ((4 + (b) * 2 + (h)) * HTB)
#define PG8_STAGE(bufoff, gbase, voff) do { _Pragma("unroll") for (int _i = 0; _i < 2; ++_i) \
        __builtin_amdgcn_global_load_lds((const unsigned*)((const char*)(gbase) + (voff)[_i]), (PG8_LAS unsigned*)(lds + (bufoff) + ldsw + _i * 8192), 16, 0, 0); } while (0)
#define PG8_LDA(dst, b, h) do { _Pragma("unroll") for (int m = 0; m < 4; ++m) _Pragma("unroll") for (int k = 0; k < 2; ++k) dst[m][k] = *(const PG8_LAS bf16x8*)(lds + PG8_SA(b, h) + aoff + m * 2048 + k * 1024); } while (0)
#define PG8_LDB(dst, b, h) do { _Pragma("unroll") for (int n = 0; n < 2; ++n) _Pragma("unroll") for (int k = 0; k < 2; ++k) dst[n][k] = *(const PG8_LAS bf16x8*)(lds + PG8_SB(b, h) + boff + n * 2048 + k * 1024); } while (0)
#define PG8_MMA(ai, bj, At, Bt) do { __builtin_amdgcn_s_setprio(1); _Pragma("unroll") for (int m = 0; m < 4; ++m) _Pragma("unroll") for (int n = 0; n < 2; ++n) _Pragma("unroll") for (int k = 0; k < 2; ++k) \
        acc[ai][bj][m][n] = __builtin_amdgcn_mfma_f32_16x16x32_bf16(Bt[n][k], At[m][k], acc[ai][bj][m][n], 0, 0, 0); __builtin_amdgcn_s_setprio(0); } while (0)
#define PG8_WAIT_V(n) asm volatile("s_waitcnt vmcnt(" #n ")" ::: "memory")
#define PG8_WAIT_L(n) asm volatile("s_waitcnt lgkmcnt(" #n ")" ::: "memory")
#define PG8_BAR __builtin_amdgcn_s_barrier()
#define PG8_SCHED __builtin_amdgcn_sched_barrier(0)
    Unit cur, nxt; int ui = 0;
    if (!S.next(0, cur)) return;
    f32x4 acc[2][2][4][2];
#pragma unroll
    for (int a = 0; a < 2; ++a)
#pragma unroll
        for (int b = 0; b < 2; ++b)
#pragma unroll
            for (int m = 0; m < 4; ++m)
#pragma unroll
                for (int n = 0; n < 2; ++n) acc[a][b][m][n] = (f32x4){0.f, 0.f, 0.f, 0.f};
    bf16x8 At[4][2], B0[2][2], B1[2][2];
    const char* cA = (const char*)(cur.alt ? g.A2 : g.A) + (size_t)cur.pm * tstep; const char* cB = (const char*)(cur.alt ? g.Bt2 : g.Bt) + (size_t)cur.pn * tstep;
    int ntc = cur.alt ? g.nt2 : nt;
    S.a_ready(cur);
    if constexpr (SP2) {
        PG8_STAGE(PG8_SB(0, 0), cB, voffB); PG8_STAGE(PG8_SB(0, 1), cB + hstep, voffB); PG8_STAGE(PG8_SA(0, 0), cA, voffA); PG8_STAGE(PG8_SA(0, 1), cA + hstep, voffA);
        if (wr == 1) PG8_BAR;
        PG8_WAIT_V(2); PG8_BAR;
        PG8_STAGE(PG8_SB(1, 0), cB + kstep, voffB); PG8_STAGE(PG8_SA(1, 0), cA + kstep, voffA); PG8_STAGE(PG8_SB(1, 1), cB + hstep + kstep, voffB);
        PG8_WAIT_V(6); PG8_BAR;
    } else {
        PG8_STAGE(PG8_SB(0, 0), cB, voffB); PG8_STAGE(PG8_SA(0, 0), cA, voffA); PG8_STAGE(PG8_SB(0, 1), cB + hstep, voffB); PG8_STAGE(PG8_SA(0, 1), cA + hstep, voffA);
        if (wr == 1) PG8_BAR;
        PG8_WAIT_V(4); PG8_BAR;
        PG8_STAGE(PG8_SB(1, 0), cB + kstep, voffB); PG8_STAGE(PG8_SA(1, 0), cA + kstep, voffA); PG8_STAGE(PG8_SB(1, 1), cB + hstep + kstep, voffB);
        PG8_WAIT_V(6); PG8_BAR;
    }
    for (;;) {
        const bool has_next = S.next(ui + 1, nxt);
        const char* nA = has_next ? (const char*)(nxt.alt ? g.A2 : g.A) + (size_t)nxt.pm * tstep : cA; const char* nB = has_next ? (const char*)(nxt.alt ? g.Bt2 : g.Bt) + (size_t)nxt.pn * tstep : cB;
        for (int t = 0; t < ntc; t += 2) {
            const bool last = (t == ntc - 2);
            const char* a1 = cA + (size_t)(t + 1) * kstep;
            const char* a2 = last ? nA : cA + (size_t)(t + 2) * kstep; const char* b2 = last ? nB : cB + (size_t)(t + 2) * kstep;
            const char* a3 = a2 + kstep; const char* b3 = b2 + kstep;
            if (last && has_next) S.a_ready(nxt);
            if constexpr (SP2) {
            PG8_LDB(B0, 0, 0); PG8_LDB(B1, 0, 1); PG8_SCHED; PG8_LDA(At, 0, 0); PG8_STAGE(PG8_SA(1, 1), a1 + hstep, voffA);
            PG8_WAIT_V(8); PG8_WAIT_L(0); PG8_BAR; PG8_MMA(0, 0, At, B0); PG8_MMA(0, 1, At, B1); PG8_BAR; PG8_SCHED;
            PG8_LDA(At, 0, 1); PG8_STAGE(PG8_SB(0, 0), b2, voffB); PG8_STAGE(PG8_SB(0, 1), b2 + hstep, voffB); PG8_STAGE(PG8_SA(0, 0), a2, voffA);
            PG8_WAIT_V(8); PG8_WAIT_L(0); PG8_BAR; PG8_MMA(1, 0, At, B0); PG8_MMA(1, 1, At, B1); PG8_BAR; PG8_SCHED;
            PG8_LDB(B0, 1, 0); PG8_LDB(B1, 1, 1); PG8_SCHED; PG8_LDA(At, 1, 0); PG8_STAGE(PG8_SA(0, 1), a2 + hstep, voffA);
            PG8_WAIT_V(8); PG8_WAIT_L(0); PG8_BAR; PG8_MMA(0, 0, At, B0); PG8_MMA(0, 1, At, B1); PG8_BAR; PG8_SCHED;
            PG8_LDA(At, 1, 1); PG8_STAGE(PG8_SB(1, 0), b3, voffB); PG8_STAGE(PG8_SB(1, 1), b3 + hstep, voffB); PG8_STAGE(PG8_SA(1, 0), a3, voffA);
            PG8_WAIT_V(8); PG8_WAIT_L(0); PG8_BAR; PG8_MMA(1, 0, At, B0); PG8_MMA(1, 1, At, B1); PG8_BAR; PG8_SCHED;
            } else {
            PG8_LDB(B0, 0, 0); PG8_SCHED; PG8_LDA(At, 0, 0); PG8_STAGE(PG8_SA(1, 1), a1 + hstep, voffA);
            PG8_WAIT_L(8); PG8_BAR; PG8_WAIT_L(0); PG8_MMA(0, 0, At, B0); PG8_BAR; PG8_SCHED;
            PG8_LDB(B1, 0, 1); PG8_STAGE(PG8_SB(0, 0), b2, voffB);
            PG8_BAR; PG8_WAIT_L(0); PG8_MMA(0, 1, At, B1); PG8_BAR;
            PG8_LDA(At, 0, 1); PG8_STAGE(PG8_SA(0, 0), a2, voffA);
            PG8_BAR; PG8_WAIT_L(0); PG8_MMA(1, 0, At, B0); PG8_BAR; PG8_SCHED;
            PG8_STAGE(PG8_SB(0, 1), b2 + hstep, voffB);
            PG8_WAIT_V(6); PG8_BAR; PG8_MMA(1, 1, At, B1); PG8_BAR;
            PG8_LDB(B0, 1, 0); PG8_SCHED; PG8_LDA(At, 1, 0); PG8_STAGE(PG8_SA(0, 1), a2 + hstep, voffA);
            PG8_WAIT_L(8); PG8_BAR; PG8_WAIT_L(0); PG8_MMA(0, 0, At, B0); PG8_BAR; PG8_SCHED;
            PG8_LDB(B1, 1, 1); PG8_STAGE(PG8_SB(1, 0), b3, voffB);
            PG8_BAR; PG8_WAIT_L(0); PG8_MMA(0, 1, At, B1); PG8_BAR;
            PG8_LDA(At, 1, 1); PG8_STAGE(PG8_SA(1, 0), a3, voffA);
            PG8_BAR; PG8_WAIT_L(0); PG8_MMA(1, 0, At, B0); PG8_BAR; PG8_SCHED;
            PG8_STAGE(PG8_SB(1, 1), b3 + hstep, voffB);
            PG8_WAIT_V(6); PG8_BAR; PG8_MMA(1, 1, At, B1); PG8_BAR;
            }
        }
        if constexpr (ALIGN_EPI) { if (wr == 0) PG8_BAR; }
        if constexpr (!Epi::AFTER_DRAIN) { E(acc, cur, wr, wc, fr, fq); if constexpr (Epi::REP > 1) { asm volatile("" ::: "memory"); E(acc, cur, wr, wc, fr, fq); } S.done(cur); }
        if (!has_next) break;
#pragma unroll
        for (int a = 0; a < 2; ++a)
#pragma unroll
            for (int b = 0; b < 2; ++b)
#pragma unroll
                for (int m = 0; m < 4; ++m)
#pragma unroll
                    for (int n = 0; n < 2; ++n) acc[a][b][m][n] = (f32x4){0.f, 0.f, 0.f, 0.f};
        cur = nxt; cA = nA; cB = nB; ++ui; ntc = cur.alt ? g.nt2 : nt;
        if constexpr (ALIGN_EPI) { if (wr == 1) PG8_BAR; }
    }
    PG8_WAIT_V(0);
    if constexpr (!ALIGN_EPI) { if (wr == 0) PG8_BAR; }
    PG8_BAR;
#ifdef TPROBE
    if constexpr (Epi::AFTER_DRAIN) { if (tid == 0) ((volatile PG8_LAS unsigned long long*)(lds + TPROBE_MISC + 64))[Epi::STAMP_SLOT] = __builtin_amdgcn_s_memrealtime(); }
#endif
    if constexpr (Epi::AFTER_DRAIN) { E.fused(acc, cur, wr, wc, fr, fq, lds, wid, lane); if constexpr (Epi::REP > 1) { __syncthreads(); E.fused(acc, cur, wr, wc, fr, fq, lds, wid, lane); } S.done(cur); }
#undef PG8_SA
#undef PG8_SB
#undef PG8_STAGE
#undef PG8_LDA
#undef PG8_LDB
#undef PG8_MMA
#undef PG8_WAIT_V
#undef PG8_WAIT_L
#undef PG8_BAR
#undef PG8_SCHED
}
}
#ifndef REP_TR
#define REP_TR 1
#endif
#ifndef REP_SGU
#define REP_SGU 1
#endif
#ifndef REP_CONV
#define REP_CONV 1
#endif
#ifndef REP_P0
#define REP_P0 1
#endif
#ifndef REP_P1
#define REP_P1 1
#endif
#ifndef REP_P2
#define REP_P2 1
#endif
#ifndef REP_P3
#define REP_P3 1
#endif
#ifndef REP_P4
#define REP_P4 1
#endif
#ifndef PG8_SP2
#define PG8_SP2 true
#endif
#ifndef PG8_ALIGN
#define PG8_ALIGN true
#endif
#define LAS __attribute__((address_space(3)))
typedef unsigned short bf16;
typedef unsigned v4u __attribute__((ext_vector_type(4)));
typedef unsigned v2u __attribute__((ext_vector_type(2)));
typedef float f32x4 __attribute__((ext_vector_type(4)));
typedef float f32x2 __attribute__((ext_vector_type(2)));
typedef short bf16x8 __attribute__((ext_vector_type(8)));
#define LDS_WAIT() asm volatile("s_waitcnt lgkmcnt(0)" ::: "memory")

constexpr int NWAVES = 8, NTHR = 512;
constexpr int M = 16384, D = 1024, DIN = 3072, DPLE = 256, DC = 512, SEQ = 8192, CHUNK = 128, NHEAD = 8, CW = 31;
constexpr float LN_EPS = 1e-5f, ALPHA = 1.189207115002721f;
constexpr size_t MiB = 1u << 20;
constexpr size_t WS_CP1 = 0, WS_CP2 = 64 * 1024, WS_STATSP = 128 * 1024;
constexpr size_t WS_WSB = 1 * MiB;
constexpr size_t WS_WIN = 2 * MiB, WS_WOUT = 8 * MiB, WS_WG = 10 * MiB, WS_WPLE = 12 * MiB;
constexpr size_t WS_H = 16 * MiB, WS_PB = 216 * MiB, WS_PE = 56 * MiB, WS_Y = 88 * MiB, WS_RB = 120 * MiB;
constexpr size_t WS_AB = 152 * MiB, WS_SZ = 168 * MiB, WS_UG = 184 * MiB, WS_GV = 200 * MiB;
constexpr size_t WS_R = 152 * MiB;
constexpr size_t WS_END = 248 * MiB;
constexpr int LDS_BYTES = 147456;

__device__ __forceinline__ unsigned f2bf(float f) { unsigned u = __builtin_bit_cast(unsigned, f); return (u + 0x7fffu + ((u >> 16) & 1u)) >> 16; }
__device__ __forceinline__ unsigned pk2(float lo, float hi) { unsigned r; asm volatile("v_cvt_pk_bf16_f32 %0, %1, %2" : "=v"(r) : "v"(lo), "v"(hi)); return r; }
__device__ __forceinline__ float bf_lo(unsigned u) { return __uint_as_float(u << 16); }
__device__ __forceinline__ float bf_hi(unsigned u) { return __uint_as_float(u & 0xffff0000u); }
template <int CTRL> __device__ __forceinline__ float dpp_addc(float v) {
    return v + __builtin_bit_cast(float, __builtin_amdgcn_update_dpp(0, __builtin_bit_cast(int, v), CTRL, 0xF, 0xF, true));
}
__device__ __forceinline__ float wave_sum(float v) {
    v = dpp_addc<0xB1>(v);
    v = dpp_addc<0x4E>(v);
    v = dpp_addc<0x141>(v);
    v = dpp_addc<0x140>(v);
    const int vi = __builtin_bit_cast(int, v);
    const float r0 = __builtin_bit_cast(float, __builtin_amdgcn_readlane(vi, 0)), r1 = __builtin_bit_cast(float, __builtin_amdgcn_readlane(vi, 16)),
                r2 = __builtin_bit_cast(float, __builtin_amdgcn_readlane(vi, 32)), r3 = __builtin_bit_cast(float, __builtin_amdgcn_readlane(vi, 48));
    return (r0 + r1) + (r2 + r3);
}
__device__ __forceinline__ float sigm_f(float x) { return __builtin_amdgcn_rcpf(1.0f + __builtin_amdgcn_exp2f(-1.44269504089f * x)); }

#define GAS __attribute__((address_space(1)))
constexpr size_t WS_BAR = 768 * 1024, BAR_ZERO_BYTES = 49152;
constexpr size_t WS_PCNT = WS_BAR + 16384, WS_PCNT2 = WS_BAR + 32768;
constexpr int MISC_OFF = LDS_BYTES - 256;
#define XB_TMO      128
#define XB_XCNT(j)  (256  + 64 * (j))
#define XB_XSUB(j)  (1280 + 64 * (j))
#define XB_XGEN(j)  (2304 + 64 * (j))
#define XB_TOP      3328
#define XB_TOPGEN   3392
#define XCD_BAR_WORDS 3456
#define XB_SPIN_CAP (1u << 18)

__device__ __forceinline__ unsigned xb_ld(unsigned* p)              { return __hip_atomic_load(p, __ATOMIC_RELAXED, __HIP_MEMORY_SCOPE_AGENT); }
__device__ __forceinline__ unsigned xb_add(unsigned* p, unsigned v) { return __hip_atomic_fetch_add(p, v, __ATOMIC_RELAXED, __HIP_MEMORY_SCOPE_AGENT); }
__device__ __forceinline__ unsigned xb_xcc_id() { return (unsigned)__builtin_amdgcn_s_getreg((3 << 11) | 20) & 0xFu; }
#define XB_SPIN(cond, bar) do { unsigned _sp = 0; while (cond) { __builtin_amdgcn_s_sleep(1); \
    if ((++_sp & 255u) == 0u) { if (xb_ld(&(bar)[XB_TMO])) break; if (_sp > XB_SPIN_CAP) { atomicAdd(&(bar)[XB_TMO], 1u); break; } } } } while (0)

struct XcdBarrier {
    unsigned* bar; unsigned x;
    volatile LAS unsigned* st;
};

__device__ __forceinline__ XcdBarrier xcd_barrier_post(unsigned* bar, volatile LAS unsigned* st) {
    XcdBarrier b; b.bar = bar; b.x = xb_xcc_id(); b.st = st;
    if (threadIdx.x == 0) (void)xb_add(&bar[XB_XCNT(b.x)], 1u);
    return b;
}
__device__ __forceinline__ void xcd_barrier_complete(unsigned* bar, unsigned x, unsigned& nloc, unsigned& nx) {
    const unsigned G = gridDim.x * gridDim.y * gridDim.z;
    unsigned sum, cnt, mine, sp = 0u;
    for (;;) {
        sum = 0u; cnt = 0u; mine = 0u;
#pragma unroll
        for (unsigned j = 0; j < 16; ++j) { const unsigned c = xb_ld(&bar[XB_XCNT(j)]); sum += c; cnt += (c > 0u) ? 1u : 0u; mine = (j == x) ? c : mine; }
        if (sum == G) break;
        __builtin_amdgcn_s_sleep(1);
        if ((++sp & 255u) == 0u) { if (xb_ld(&bar[XB_TMO])) break; if (sp > XB_SPIN_CAP) { atomicAdd(&bar[XB_TMO], 1u); break; } }
    }
    nloc = mine > 0u ? mine : 1u; nx = cnt > 0u ? cnt : 1u;
}

__device__ __forceinline__ void xcd_barrier(const XcdBarrier& b) {
    asm volatile("s_waitcnt vmcnt(0)" ::: "memory");
    __syncthreads();
    if (threadIdx.x == 0) {
        unsigned* bar = b.bar;
        __builtin_amdgcn_s_waitcnt(0);
        unsigned nloc = b.st[0], nx = b.st[1];
        if (nloc == 0u) { xcd_barrier_complete(bar, b.x, nloc, nx); b.st[0] = nloc; b.st[1] = nx; }
        const unsigned old = xb_add(&bar[XB_XSUB(b.x)], 1u);
        const unsigned gen = old / nloc;
        if (old + 1u == (gen + 1u) * nloc) {
            __builtin_amdgcn_fence(__ATOMIC_RELEASE, "agent");
            asm volatile("s_waitcnt vmcnt(0)" ::: "memory");
            const unsigned og = xb_add(&bar[XB_TOP], 1u);
            const unsigned tg = og / nx;
            if (og + 1u == (tg + 1u) * nx) xb_add(&bar[XB_TOPGEN], 1u);
            else XB_SPIN(xb_ld(&bar[XB_TOPGEN]) == tg, bar);
            __builtin_amdgcn_fence(__ATOMIC_ACQUIRE, "agent");
            xb_add(&bar[XB_XGEN(b.x)], 1u);
            asm volatile("s_waitcnt vmcnt(0)" ::: "memory");
        } else {
            XB_SPIN(xb_ld(&bar[XB_XGEN(b.x)]) == gen, bar);
            __builtin_amdgcn_fence(__ATOMIC_ACQUIRE, "agent");
            asm volatile("s_waitcnt vmcnt(0)" ::: "memory");
        }
    }
    __syncthreads();
}

#ifdef TPROBE
#define STAMP(i) do { __syncthreads(); if (threadIdx.x == 0) ((volatile LAS unsigned long long*)(lds + MISC_OFF + 64))[i] = __builtin_amdgcn_s_memrealtime(); } while (0)
#else
#define STAMP(i) do { } while (0)
#endif
struct Args { const float* in[19]; float* out; unsigned char* ws; };

__device__ __forceinline__ int win_map(int n) {
    const int seg = n >> 9, o = n & 511, blk = o >> 7, w = o & 127;
    if (seg == 0) return 256 * blk + w;
    if (seg == 1) return 256 * blk + 128 + w;
    if (seg == 2) return 1536 + o;
    if (seg == 3) return (blk < 2 ? 1024 + 256 * blk : 2048 + 256 * (blk - 2)) + w;
    if (seg == 5) return (blk < 2 ? 1024 + 256 * blk : 2048 + 256 * (blk - 2)) + 128 + w;
    return 2560 + o;
}
template <bool GATE>
__device__ __forceinline__ void tr_item(const float* W, int K, int N, bf16* WT, int drow, LAS float* scr, int k0, int n0, int lane, const float* g, const float* b, float* cp1, float* cp2) {
#pragma unroll
    for (int i = 0; i < 32; ++i) { const int kk = 2 * i + (lane >> 5); scr[kk * 33 + (lane & 31)] = __builtin_nontemporal_load(W + (size_t)(k0 + kk) * N + n0 + (lane & 31)); }
    LDS_WAIT(); asm volatile("" ::: "memory");
    const int c = lane & 7;
    float gs[8];
#pragma unroll
    for (int e = 0; e < 8; ++e) gs[e] = GATE ? g[k0 + 8 * c + e] : 1.0f;
#pragma unroll
    for (int j = 0; j < 4; ++j) { const int n = (lane >> 3) + 8 * j; const LAS float* s = scr + (8 * c) * 33 + n;
        v4u o; o.x = pk2(s[0 * 33] * gs[0], s[1 * 33] * gs[1]); o.y = pk2(s[2 * 33] * gs[2], s[3 * 33] * gs[3]); o.z = pk2(s[4 * 33] * gs[4], s[5 * 33] * gs[5]); o.w = pk2(s[6 * 33] * gs[6], s[7 * 33] * gs[7]);
        *(v4u*)(WT + (size_t)(drow + n) * K + k0 + 8 * c) = o; }
    if (GATE) { const int n = lane & 31, half = lane >> 5; float s1 = 0.f, s2 = 0.f;
#pragma unroll 8
        for (int kk = 0; kk < 32; ++kk) { const int k = 32 * half + kk; const float w = scr[k * 33 + n]; s1 += g[k0 + k] * w; s2 += b[k0 + k] * w; }
        s1 += __shfl_xor(s1, 32); s2 += __shfl_xor(s2, 32);
        if (lane < 32) { cp1[(k0 >> 6) * N + n0 + n] = s1; cp2[(k0 >> 6) * N + n0 + n] = s2; } }
    LDS_WAIT(); asm volatile("" ::: "memory");
}

__device__ __forceinline__ void p0_prologue(const Args& a, LAS unsigned char* lds, int wave, int lane) {
    unsigned char* ws = a.ws;
    LAS float* scr = (LAS float*)(lds + wave * 16384);
    const int gw = blockIdx.x * NWAVES + wave, NGW = gridDim.x * NWAVES;
    constexpr int I_IN = (D / 64) * (DIN / 32), I_OUT = (D / 64) * (D / 32), I_G = I_OUT, I_PLE = (DPLE / 64) * (D / 32);
    constexpr int NITEMS = I_IN + I_OUT + I_G + I_PLE;
    const float* x = a.in[0]; bf16* H = (bf16*)(ws + WS_H);
    f32x4 xv[8][4];
    const bool xl = (gridDim.x % 8 == 0) && (M / 8) % (int)gridDim.x == 0;
    const int rbase = xl ? (int)(blockIdx.x % 8) * (M / 8) + ((int)(blockIdx.x / 8) * NWAVES + wave) * 8 : gw, rstep = xl ? 1 : NGW, rend = xl ? rbase + 8 : M;
#pragma unroll
    for (int r = 0; r < 8; ++r) { const int mr = rbase + r * rstep; const f32x4* xr = (const f32x4*)(x + (size_t)(mr < rend ? mr : rbase) * D) + lane;
#pragma unroll
        for (int j = 0; j < 4; ++j) xv[r][j] = __builtin_nontemporal_load(xr + 64 * j); }
    for (int rep = 0; rep < REP_TR; ++rep)
    for (int it = gw; it < NITEMS; it += NGW) {
        int r = it;
        if (r < I_IN) { const int nblk = DIN / 32, kb = r / nblk, nb = r % nblk; tr_item<false>(a.in[4], D, DIN, (bf16*)(ws + WS_WIN), win_map(32 * nb), scr, 64 * kb, 32 * nb, lane, nullptr, nullptr, nullptr, nullptr); continue; } r -= I_IN;
        if (r < I_OUT) { const int nblk = D / 32, kb = r / nblk, nb = r % nblk; tr_item<false>(a.in[13], D, D, (bf16*)(ws + WS_WOUT), 32 * nb, scr, 64 * kb, 32 * nb, lane, nullptr, nullptr, nullptr, nullptr); continue; } r -= I_OUT;
        if (r < I_G) { const int nblk = D / 32, kb = r / nblk, nb = r % nblk; tr_item<true>(a.in[17], D, D, (bf16*)(ws + WS_WG), 32 * nb, scr, 64 * kb, 32 * nb, lane, a.in[14], a.in[15], (float*)(ws + WS_CP1), (float*)(ws + WS_CP2)); continue; } r -= I_G;
        { const int nblk = D / 32, kb = r / nblk, nb = r % nblk; tr_item<false>(a.in[16], D  , D, (bf16*)(ws + WS_WPLE), 32 * nb, scr, 64 * kb, 32 * nb, lane, nullptr, nullptr, nullptr, nullptr); }
    }
    STAMP(14);
    {
        f32x4 gg[4], bb[4];
#pragma unroll
        for (int j = 0; j < 4; ++j) { gg[j] = *(const f32x4*)(a.in[2] + 4 * lane + 256 * j); bb[j] = *(const f32x4*)(a.in[3] + 4 * lane + 256 * j); }
        for (int m = rbase; m < rend; m += xl ? (1 << 30) : 8 * rstep) {
            if (m != rbase) {
#pragma unroll
                for (int r = 0; r < 8; ++r) { const int mr = m + r * rstep; const f32x4* xr = (const f32x4*)(x + (size_t)(mr < rend ? mr : m) * D) + lane;
#pragma unroll
                    for (int j = 0; j < 4; ++j) xv[r][j] = __builtin_nontemporal_load(xr + 64 * j); }
            }
#pragma unroll
            for (int r = 0; r < 8; ++r) { float s = 0.f;
#pragma unroll
                for (int j = 0; j < 4; ++j) s += (xv[r][j][0] + xv[r][j][1]) + (xv[r][j][2] + xv[r][j][3]);
                const float mean = wave_sum(s) * (1.f / D); float s2 = 0.f;
#pragma unroll
                for (int j = 0; j < 4; ++j) { xv[r][j] = xv[r][j] - mean; s2 += (xv[r][j][0] * xv[r][j][0] + xv[r][j][1] * xv[r][j][1]) + (xv[r][j][2] * xv[r][j][2] + xv[r][j][3] * xv[r][j][3]); }
                const float rstd = __builtin_amdgcn_rsqf(wave_sum(s2) * (1.f / D) + LN_EPS);
                if (m + r * rstep < rend) { v2u* o8 = (v2u*)(H + (size_t)(m + r * rstep) * D) + lane;
#pragma unroll
                    for (int j = 0; j < 4; ++j) { const f32x4 y = xv[r][j] * rstd * gg[j] + bb[j]; o8[64 * j] = (v2u){pk2(y[0], y[1]), pk2(y[2], y[3])}; } } }
        }
    }
    STAMP(15);
    {
        const float* p = a.in[1]; bf16* Pb = (bf16*)(ws + WS_PB);
        const int gt = blockIdx.x * NTHR + threadIdx.x, NGT = gridDim.x * NTHR;
        for (int i0 = gt; i0 < M * DPLE / 8; i0 += 4 * NGT) {
            f32x4 a0[4], a1[4];
#pragma unroll
            for (int r = 0; r < 4; ++r) { const int i = i0 + r * NGT; const bool ok = i < M * DPLE / 8; const size_t o = (size_t)(ok ? i : i0) * 8; a0[r] = __builtin_nontemporal_load((const f32x4*)(p + o)); a1[r] = __builtin_nontemporal_load((const f32x4*)(p + o + 4)); }
#pragma unroll
            for (int r = 0; r < 4; ++r) { const int i = i0 + r * NGT; if (i < M * DPLE / 8)
                *(v4u*)(Pb + (size_t)(i >> 5) * D + (i & 31) * 8) = (v4u){pk2(a0[r][0], a0[r][1]), pk2(a0[r][2], a0[r][3]), pk2(a1[r][0], a1[r][1]), pk2(a1[r][2], a1[r][3])}; }
        }
        const float* wsrc = a.in[11]; bf16* Wsb = (bf16*)(ws + WS_WSB);
        for (int i = gt; i < NHEAD * CHUNK * CHUNK / 8; i += NGT) { const int t = (i >> 4) & 127, s0 = (i & 15) * 8;
            const f32x4 a0 = __builtin_nontemporal_load((const f32x4*)(wsrc + (size_t)i * 8)), a1 = __builtin_nontemporal_load((const f32x4*)(wsrc + (size_t)i * 8 + 4));
            float e[8] = {a0[0], a0[1], a0[2], a0[3], a1[0], a1[1], a1[2], a1[3]};
#pragma unroll
            for (int k = 0; k < 8; ++k) e[k] = (s0 + k <= t) ? e[k] : 0.f;
            *(v4u*)(Wsb + (size_t)i * 8) = (v4u){pk2(e[0], e[1]), pk2(e[2], e[3]), pk2(e[4], e[5]), pk2(e[6], e[7])}; }
    }
}

__device__ __forceinline__ void store8_wt(void* p, v2u v) { __hip_atomic_store((unsigned long long*)p, ((unsigned long long)v.y << 32) | v.x, __ATOMIC_RELAXED, __HIP_MEMORY_SCOPE_AGENT); }
template <int J> struct ConvStep {
    static __device__ __forceinline__ void run(f32x2 (&acc)[16], const f32x2 (&w)[CW], const LAS unsigned char* p) {
        const unsigned d = *(const LAS unsigned*)(p + J * 1024); const f32x2 v = (f32x2){bf_lo(d), bf_hi(d)};
#pragma unroll
        for (int k = 0; k < CW; ++k) { const int t = J - k; if (t >= 0 && t < 16) acc[t] += w[k] * v; }
        ConvStep<J + 1>::run(acc, w, p);
    }
};
template <> struct ConvStep<46> { static __device__ __forceinline__ void run(f32x2 (&)[16], const f32x2 (&)[CW], const LAS unsigned char*) {} };
__device__ __forceinline__ void conv_tile_load(v4u (&pf)[8], int it, const bf16* Ab, int tid) {
    const int m0 = it * 32, t0 = m0 & (SEQ - 1);
#pragma unroll
    for (int i = 0; i < 8; ++i) { const int q = tid + i * NTHR, row = q >> 6, c16 = q & 63; pf[i] = (v4u){0u, 0u, 0u, 0u};
        if (q < 62 * 64 && t0 - 30 + row >= 0) pf[i] = __builtin_nontemporal_load((const v4u*)(Ab + (size_t)(m0 - 30 + row) * DC + c16 * 8)); }
}
__device__ __forceinline__ void conv_item(LAS unsigned char* lds, int it, int it_next, v4u (&pf)[8], const bf16* Ab, const bf16* SZ, bf16* Y, const f32x2 (&w)[CW], f32x2 cb,
                                          const float* lng, const float* lnb, int tid, int wave, int lane) {
    const int m0 = it * 32;
    LAS unsigned char* in = lds; LAS float* outt = (LAS float*)(lds + 65536);
#pragma unroll
    for (int i = 0; i < 8; ++i) { const int q = tid + i * NTHR, row = q >> 6, c16 = q & 63; if (q < 62 * 64) *(LAS v4u*)(in + row * 1024 + c16 * 16) = pf[i]; }
    __syncthreads();
    if (it_next >= 0) conv_tile_load(pf, it_next, Ab, tid);
    f32x4 gg[2], bb[2]; v2u zz[4][2];
#pragma unroll
    for (int j = 0; j < 2; ++j) { const int c = 4 * lane + 256 * j; gg[j] = *(const f32x4*)(lng + c); bb[j] = *(const f32x4*)(lnb + c);
#pragma unroll
        for (int rr = 0; rr < 4; ++rr) zz[rr][j] = __builtin_nontemporal_load((const v2u*)(SZ + (size_t)(m0 + 4 * wave + rr) * DC + c)); }
    const int cp = tid & 255, rh = tid >> 8;
    f32x2 acc[16];
#pragma unroll
    for (int t = 0; t < 16; ++t) acc[t] = (f32x2){0.f, 0.f};
    ConvStep<0>::run(acc, w, in + (16 * rh) * 1024 + cp * 4);
#pragma unroll
    for (int t = 0; t < 16; ++t) *(LAS f32x2*)(outt + (16 * rh + t) * DC + 2 * cp) = acc[t] + cb;
    __syncthreads();
    {
#pragma unroll
        for (int rr = 0; rr < 4; ++rr) { const int row = 4 * wave + rr; const size_t m = (size_t)(m0 + row);
            f32x4 v[2]; float s = 0.f;
#pragma unroll
            for (int j = 0; j < 2; ++j) { v[j] = *(const LAS f32x4*)(outt + row * DC + 4 * lane + 256 * j); s += (v[j][0] + v[j][1]) + (v[j][2] + v[j][3]); }
            const float mean = wave_sum(s) * (1.f / DC); float s2 = 0.f;
#pragma unroll
            for (int j = 0; j < 2; ++j) { v[j] = v[j] - mean; s2 += (v[j][0] * v[j][0] + v[j][1] * v[j][1]) + (v[j][2] * v[j][2] + v[j][3] * v[j][3]); }
            const float rstd = __builtin_amdgcn_rsqf(wave_sum(s2) * (1.f / DC) + LN_EPS);
#pragma unroll
            for (int j = 0; j < 2; ++j) { const int c = 4 * lane + 256 * j;
                f32x4 y = v[j] * rstd * gg[j] + bb[j];
                y = (f32x4){y[0] * sigm_f(y[0]), y[1] * sigm_f(y[1]), y[2] * sigm_f(y[2]), y[3] * sigm_f(y[3])};
                y = y * (f32x4){bf_lo(zz[rr][j].x), bf_hi(zz[rr][j].x), bf_lo(zz[rr][j].y), bf_hi(zz[rr][j].y)};
                store8_wt(Y + m * D + c, (v2u){pk2(y[0], y[1]), pk2(y[2], y[3])}); } }
    }
    __syncthreads();
}

__device__ __forceinline__ void sgu_item(LAS unsigned char* lds, int c, const bf16* GV, const bf16* UG, const bf16* Wsb, const float* bs, const float* lng, const float* lnb, bf16* Y,
                                         int tid, int wave, int lane) {
    constexpr int RS = 1056;
    const int m0 = c * CHUNK;
    {
        const f32x4 g0 = *(const f32x4*)(lng + 8 * lane), g1 = *(const f32x4*)(lng + 8 * lane + 4), b0 = *(const f32x4*)(lnb + 8 * lane), b1 = *(const f32x4*)(lnb + 8 * lane + 4);
        v4u raw[16];
#pragma unroll
        for (int i = 0; i < 16; ++i) raw[i] = __builtin_nontemporal_load((const v4u*)(GV + (size_t)(m0 + 16 * wave + i) * DC + 8 * lane));
#pragma unroll
        for (int i = 0; i < 16; ++i) {
            f32x4 x0 = (f32x4){bf_lo(raw[i].x), bf_hi(raw[i].x), bf_lo(raw[i].y), bf_hi(raw[i].y)}, x1 = (f32x4){bf_lo(raw[i].z), bf_hi(raw[i].z), bf_lo(raw[i].w), bf_hi(raw[i].w)};
            const float s = (x0[0] + x0[1]) + (x0[2] + x0[3]) + (x1[0] + x1[1]) + (x1[2] + x1[3]);
            const float mean = wave_sum(s) * (1.f / DC);
            x0 = x0 - mean; x1 = x1 - mean;
            const float q = (x0[0] * x0[0] + x0[1] * x0[1]) + (x0[2] * x0[2] + x0[3] * x0[3]) + (x1[0] * x1[0] + x1[1] * x1[1]) + (x1[2] * x1[2] + x1[3] * x1[3]);
            const float rstd = __builtin_amdgcn_rsqf(wave_sum(q) * (1.f / DC) + LN_EPS);
            x0 = x0 * rstd * g0 + b0; x1 = x1 * rstd * g1 + b1;
            *(LAS v4u*)(lds + (16 * wave + i) * RS + lane * 16) = (v4u){pk2(x0[0], x0[1]), pk2(x0[2], x0[3]), pk2(x1[0], x1[1]), pk2(x1[2], x1[3])};
        }
    }
    asm volatile("" ::: "memory");
    bf16x8 wf[20]; float biasv[8];
    int lane_ = lane; asm volatile("" : "+v"(lane_));
    const int h = wave, fr = lane_ & 15, q = lane_ >> 4;
    const bf16* wsb0 = Wsb + (size_t)h * CHUNK * CHUNK; const unsigned woff = (unsigned)(fr * CHUNK + 8 * q);
    {
        int n = 0;
#pragma unroll
        for (int tb = 0; tb < 8; ++tb)
#pragma unroll
            for (int ks = 0; ks < 4; ++ks) if (ks <= (tb >> 1)) { wf[n] = *(const bf16x8*)(wsb0 + (woff + (unsigned)(16 * tb * CHUNK + 32 * ks))); ++n; }
#pragma unroll
        for (int tb = 0; tb < 8; ++tb) biasv[tb] = bs[h * CHUNK + 16 * tb + fr];
    }
    const bf16* ug0 = UG + (size_t)m0 * DC + h * 64; bf16* y0 = Y + (size_t)m0 * D + DC + h * 64;
    const unsigned uoff = (unsigned)(fr * DC + 4 * q), yoff = (unsigned)(fr * D + 4 * q);
    v2u ugv[2][8][2];
#define SGU_UG_LOAD(dh_) do { _Pragma("unroll") for (int tb = 0; tb < 8; ++tb) _Pragma("unroll") for (int nb = 0; nb < 2; ++nb) \
        ugv[dh_][tb][nb] = __builtin_nontemporal_load((const v2u*)(ug0 + (uoff + (unsigned)(16 * tb * DC + (dh_) * 32 + 16 * nb)))); } while (0)
    SGU_UG_LOAD(0);
    __syncthreads();
#pragma unroll
    for (int dh = 0; dh < 2; ++dh) {
        asm volatile("" ::: "memory");
        const int dbase = h * 64 + dh * 32;
        if (dh == 0) SGU_UG_LOAD(1);
        typedef short s16x4 __attribute__((ext_vector_type(4)));
        const LAS unsigned char* vb0 = lds + (8 * q + ((lane_ & 15) >> 2)) * RS + 2 * (dbase + 4 * (lane_ & 3)); const LAS unsigned char* vb1 = vb0 + 64 * RS;
        asm volatile("" : "+v"(vb1));
        bf16x8 vf[2][4];
#pragma unroll
        for (int nb = 0; nb < 2; ++nb)
#pragma unroll
            for (int ks = 0; ks < 4; ++ks) {
                const LAS unsigned char* pb = (ks < 2 ? vb0 : vb1) + (32 * (ks & 1)) * RS + 32 * nb;
                const s16x4 lo = __builtin_amdgcn_ds_read_tr16_b64_v4i16((LAS s16x4*)(pb)), hi = __builtin_amdgcn_ds_read_tr16_b64_v4i16((LAS s16x4*)(pb + 4 * RS));
                vf[nb][ks] = __builtin_shufflevector(lo, hi, 0, 1, 2, 3, 4, 5, 6, 7); }
        int n = 0;
#pragma unroll
        for (int tbh = 0; tbh < 2; ++tbh) {
            f32x4 acc[4][2];
#pragma unroll
            for (int tl = 0; tl < 4; ++tl) { acc[tl][0] = (f32x4){0.f, 0.f, 0.f, 0.f}; acc[tl][1] = (f32x4){0.f, 0.f, 0.f, 0.f}; }
#pragma unroll
            for (int tl = 0; tl < 4; ++tl)
#pragma unroll
                for (int ks = 0; ks < 4; ++ks) if (ks <= ((4 * tbh + tl) >> 1)) {
                    acc[tl][0] = __builtin_amdgcn_mfma_f32_16x16x32_bf16(vf[0][ks], wf[n], acc[tl][0], 0, 0, 0);
                    acc[tl][1] = __builtin_amdgcn_mfma_f32_16x16x32_bf16(vf[1][ks], wf[n], acc[tl][1], 0, 0, 0); ++n; }
#pragma unroll
            for (int tl = 0; tl < 4; ++tl) { const int tb = 4 * tbh + tl;
#pragma unroll
                for (int nb = 0; nb < 2; ++nb) { const v2u ug = ugv[dh][tb][nb];
                    const f32x4 o = (acc[tl][nb] + biasv[tb]) * (f32x4){bf_lo(ug.x), bf_hi(ug.x), bf_lo(ug.y), bf_hi(ug.y)};
                    store8_wt(y0 + (yoff + (unsigned)(16 * tb * D + dh * 32 + 16 * nb)), (v2u){pk2(o[0], o[1]), pk2(o[2], o[3])}); } }
        }
    }
    __syncthreads();
#undef SGU_UG_LOAD
}

__device__ __forceinline__ void p2_mixer(const Args& a, LAS unsigned char* lds, int tid, int wave, int lane) {
    unsigned char* ws = a.ws;
    const bf16* Ab = (const bf16*)(ws + WS_AB); const bf16* SZ = (const bf16*)(ws + WS_SZ); const bf16* UG = (const bf16*)(ws + WS_UG); const bf16* GV = (const bf16*)(ws + WS_GV);
    bf16* Y = (bf16*)(ws + WS_Y);
    constexpr int NCH = M / CHUNK, NCI = M / 32;
    const bool xl = (gridDim.x == 256);
    const int xq = blockIdx.x % 8, lq = blockIdx.x / 8;
    int c_first, c_step, c_last, k_first, k_step, k_last;
    if (xl) { c_first = lq < 16 ? xq * (NCH / 8) + lq : 0; c_last = lq < 16 ? c_first + 1 : 0; c_step = 1;
              k_first = lq < 16 ? 0 : xq * (NCI / 8) + 4 * (lq - 16); k_last = lq < 16 ? 0 : k_first + 4; k_step = 1; }
    else { c_first = blockIdx.x; c_last = NCH; c_step = gridDim.x; k_first = blockIdx.x; k_last = NCI; k_step = gridDim.x; }
    v4u pf[8];
    for (int c = c_first; c < c_last; c += c_step)
        sgu_item(lds, c, GV, UG, (const bf16*)(ws + WS_WSB), a.in[12], a.in[9], a.in[10], Y, tid, wave, lane);
    STAMP(6);
    {
        int tid_c = threadIdx.x; asm volatile("" : "+v"(tid_c));
        const int tid = tid_c, lane = tid & 63; (void)lane;
        const int cp = tid & 255;
        f32x2 w[CW];
#pragma unroll
        for (int k = 0; k < CW; ++k) w[k] = *(const f32x2*)(a.in[5] + k * DC + 2 * cp);
        const f32x2 cb = *(const f32x2*)(a.in[6] + 2 * cp);
        if (k_first < k_last) conv_tile_load(pf, k_first, Ab, tid);
        for (int it = k_first; it < k_last; it += k_step) { const int nx = it + k_step < k_last ? it + k_step : -1;
            conv_item(lds, it, nx, pf, Ab, SZ, Y, w, cb, a.in[7], a.in[8], tid, wave, lane); }
    }
    if (xl) {
        const int pm = lq < 16 ? (c_first >> 1) : (k_first >> 3);
        asm volatile("s_waitcnt vmcnt(0)" ::: "memory");
        __syncthreads();
        if (threadIdx.x == 0) (void)__hip_atomic_fetch_add((unsigned*)(ws + WS_PCNT2) + 64 * pm, 1u, __ATOMIC_RELAXED, __HIP_MEMORY_SCOPE_AGENT);
    }
}

__global__ void __launch_bounds__(NTHR, 2) fwd_megakernel(Args a) {
    extern __shared__ __attribute__((aligned(16))) unsigned char lds_raw[];
    LAS unsigned char* lds = (LAS unsigned char*)lds_raw;
    cg::grid_group grid = cg::this_grid();
#define FRESH_IDS int tid = threadIdx.x; asm volatile("" : "+v"(tid)); const int lane = tid & 63, wave = __builtin_amdgcn_readfirstlane(tid >> 6); (void)lane; (void)wave;
    unsigned char* ws = a.ws;
    const int G = gridDim.x;
    if (threadIdx.x < 64) ((LAS unsigned*)(lds + MISC_OFF))[threadIdx.x] = 0u;
    __syncthreads();
    const XcdBarrier bar = xcd_barrier_post((unsigned*)(ws + WS_BAR), (volatile LAS unsigned*)(lds + MISC_OFF));
    if (ws == nullptr) grid.sync();
#define GRID_BAR() xcd_barrier(bar)
    STAMP(0);

#ifndef NO_P0
    for (int rep = 0; rep < REP_P0; ++rep) { FRESH_IDS p0_prologue(a, lds, wave, lane); }
#endif
    STAMP(1);
    GRID_BAR();
    STAMP(2);

#ifndef NO_P1
    for (int rep = 0; rep < REP_P1; ++rep) {
#ifndef NO_IN
    {
        pg8::Gemm g{(const bf16*)(ws + WS_H), (const bf16*)(ws + WS_WIN), M, DIN, D, (const bf16*)(ws + WS_PB), (const bf16*)(ws + WS_WPLE), DPLE / 64}; pg8::StaticOrder S; S.init(M, DIN, G, (int)blockIdx.x); S.init2(D);
        pg8::EpiP1 E{(bf16*)(ws + WS_AB), (bf16*)(ws + WS_SZ), (bf16*)(ws + WS_UG), (bf16*)(ws + WS_GV), (bf16*)(ws + WS_PE)};
        pg8::gemm_phase<pg8::EpiP1, pg8::StaticOrder, PG8_ALIGN, PG8_SP2>(lds, g, S, E);
    }
#endif
    }
#endif
    STAMP(4);
    GRID_BAR();
    STAMP(5);

#ifndef NO_P2
    for (int rep = 0; rep < REP_P2; ++rep) { FRESH_IDS p2_mixer(a, lds, tid, wave, lane); }
#endif
    STAMP(7);
    if (G == 256) {
        pg8::StaticOrder S3; S3.init(M, D, G, (int)blockIdx.x); pg8::Unit u3; (void)S3.next(0, u3);
        if (threadIdx.x == 0) { unsigned* pc = (unsigned*)(ws + WS_PCNT2) + 64 * u3.pm; unsigned* bw = (unsigned*)(ws + WS_BAR);
            XB_SPIN(xb_ld(pc) < 4u, bw);
            __builtin_amdgcn_fence(__ATOMIC_ACQUIRE, "agent"); }
        asm volatile("s_waitcnt vmcnt(0)" ::: "memory");
        __syncthreads();
    } else { GRID_BAR(); }
    STAMP(8);

#ifndef NO_P3
    for (int rep = 0; rep < REP_P3; ++rep)
    {
        pg8::Gemm g{(const bf16*)(ws + WS_Y), (const bf16*)(ws + WS_WOUT), M, D, D}; pg8::StaticOrder S; S.init(M, D, G, (int)blockIdx.x);
#ifdef PROBE_K3
        { pg8::EpiNone E0; pg8::gemm_phase<pg8::EpiNone, pg8::StaticOrder, false, PG8_SP2>(lds, g, S, E0); }
#endif
        pg8::EpiP3 E{(const bf16*)(ws + WS_H), (bf16*)(ws + WS_RB), (float*)(ws + WS_STATSP), ALPHA, G == 256 ? (unsigned*)(ws + WS_PCNT) : nullptr};
        pg8::gemm_phase<pg8::EpiP3, pg8::StaticOrder, false, PG8_SP2>(lds, g, S, E);
    }
#endif
    STAMP(10);
    if (G == 256) {
        pg8::StaticOrder S4; S4.init(M, D, G, (int)blockIdx.x); pg8::Unit u4; (void)S4.next(0, u4);
        if (threadIdx.x == 0) { unsigned* pc = (unsigned*)(ws + WS_PCNT) + 64 * u4.pm; unsigned* bw = (unsigned*)(ws + WS_BAR);
            XB_SPIN(xb_ld(pc) < 4u, bw);
            __builtin_amdgcn_fence(__ATOMIC_ACQUIRE, "agent"); }
        asm volatile("s_waitcnt vmcnt(0)" ::: "memory");
        __syncthreads();
    } else { GRID_BAR(); }
    STAMP(11);

#ifndef NO_P4
    for (int rep = 0; rep < REP_P4; ++rep)
    {
        pg8::Gemm g{(const bf16*)(ws + WS_RB), (const bf16*)(ws + WS_WG), M, D, D}; pg8::StaticOrder S; S.init(M, D, G, (int)blockIdx.x);
        pg8::EpiP4 E{(const bf16*)(ws + WS_RB), (const bf16*)(ws + WS_PE), (const float*)(ws + WS_STATSP), (const float*)(ws + WS_CP1), (const float*)(ws + WS_CP2), a.in[18], a.in[14], a.in[15], a.out, LN_EPS};
        pg8::gemm_phase<pg8::EpiP4, pg8::StaticOrder, false, PG8_SP2>(lds, g, S, E);
    }
#endif
#ifdef TPROBE
    STAMP(13);
    if (blockIdx.x == 0) {
        volatile LAS unsigned long long* T = (volatile LAS unsigned long long*)(lds + MISC_OFF + 64);
        __syncthreads();
        unsigned long long d = 0;
        if (TPROBE == 1) d = (T[2] - T[1]) + (T[5] - T[4]) + (T[8] - T[7]) + (T[11] - T[10]);
        if (TPROBE == 2) d = T[9] - T[8];
        if (TPROBE == 3) d = T[10] - T[9];
        if (TPROBE == 4) d = T[12] - T[11];
        if (TPROBE == 5) d = T[13] - T[12];
        if (TPROBE == 6) d = T[6] - T[5];
        if (TPROBE == 7) d = T[7] - T[6];
        if (TPROBE == 8) d = T[1] - T[0];
        if (TPROBE == 9) d = T[3] - T[2];
        if (TPROBE == 10) d = T[4] - T[3];
        if (TPROBE == 12) d = T[14] - T[0];
        if (TPROBE == 13) d = T[15] - T[14];
        if (TPROBE == 14) d = T[1] - T[15];
        if (TPROBE == 15) d = T[4] - T[2];
        if (TPROBE == 16) d = T[13] - T[0];
        if (TPROBE == 11) d = 2000;
        const unsigned long long t0 = __builtin_amdgcn_s_memrealtime();
        while (__builtin_amdgcn_s_memrealtime() - t0 < d) __builtin_amdgcn_s_sleep(4);
    }
#endif
}

extern "C" void kernel_launch(void* const* d_in, const int* in_sizes, int n_in, void* d_out, int out_size, void* d_ws, size_t ws_size, hipStream_t stream) {
    static int grid = 0;
    if (grid == 0) {
        if (n_in != 19 || in_sizes[0] != M * D || out_size != M * D || ws_size < WS_END) { fprintf(stderr, "kernel_launch: unexpected shapes (n_in %d, in0 %d, out %d, ws %zu)\n", n_in, n_in > 0 ? in_sizes[0] : -1, out_size, ws_size); grid = -1; return; }
        int dev = 0, cus = 0, per_cu = 0;
        if (hipGetDevice(&dev) != hipSuccess || hipDeviceGetAttribute(&cus, hipDeviceAttributeMultiprocessorCount, dev) != hipSuccess) { fprintf(stderr, "kernel_launch: device query failed\n"); grid = -1; return; }
        if (hipFuncSetAttribute((const void*)fwd_megakernel, hipFuncAttributeMaxDynamicSharedMemorySize, LDS_BYTES) != hipSuccess) { fprintf(stderr, "kernel_launch: hipFuncSetAttribute failed\n"); grid = -1; return; }
        if (hipOccupancyMaxActiveBlocksPerMultiprocessor(&per_cu, (const void*)fwd_megakernel, NTHR, LDS_BYTES) != hipSuccess || per_cu < 1) { fprintf(stderr, "kernel_launch: occupancy query says %d\n", per_cu); per_cu = 1; }
        (void)hipGetLastError();
        grid = cus * 1;
    }
    if (grid < 0) return;
    Args a{};
    for (int i = 0; i < 19; ++i) a.in[i] = (const float*)d_in[i];
    a.out = (float*)d_out; a.ws = (unsigned char*)d_ws;
    if (hipMemsetAsync((char*)d_ws + WS_BAR, 0, BAR_ZERO_BYTES, stream) != hipSuccess) { fprintf(stderr, "kernel_launch: memset failed\n"); return; }
#ifdef PROBE_MEMSET2
    (void)hipMemsetAsync((char*)d_ws + 900 * 1024, 0, BAR_ZERO_BYTES, stream);
#endif
    void* args[] = {&a};
    hipError_t e = hipLaunchCooperativeKernel((const void*)fwd_megakernel, dim3(grid), dim3(NTHR), args, LDS_BYTES, stream);
    if (e != hipSuccess) fprintf(stderr, "kernel_launch: cooperative launch failed: %s (grid %d)\n", hipGetErrorString(e), grid);
}
```

```cpp
#include <hip/hip_runtime.h>
#include <hip/hip_cooperative_groups.h>
#include <cstdio>
#include <cstdint>
namespace cg = cooperative_groups;
namespace pg8 {
#define PG8_LAS __attribute__((address_space(3)))
typedef unsigned short bf16_t;
typedef short bf16x8 __attribute__((ext_vector_type(8)));
typedef float f32x4 __attribute__((ext_vector_type(4)));
typedef unsigned u32x4 __attribute__((ext_vector_type(4)));
constexpr int BM = 256, BK = 64, HALF = 128, HTB = HALF * BK * 2  , STAGE_BYTES = 8 * HTB, NXCD = 8, WGM = 8;

__host__ __device__ __forceinline__ int lds_byte(int r, int c) { const int st = (r >> 4) * 2 + (c >> 5), rr = r & 15, cc = c & 31, ob = rr * 64 + cc * 2; return st * 1024 + (ob ^ (((ob >> 9) & 1) << 5)); }
__host__ __device__ __forceinline__ void stage_rc(int b, int& R, int& C) { const int st = b / 1024, sb = b % 1024, swz = sb ^ (((sb >> 9) & 1) << 5); R = (st >> 1) * 16 + swz / 64; C = (st & 1) * 32 + (swz % 64) / 2; }
__host__ __device__ __forceinline__ int perm32(int rho) { const int n = rho >> 4, i = rho & 15; return 8 * (i >> 2) + 4 * n + (i & 3); }

struct Unit { int pm, pn, alt; };
struct Gemm { const bf16_t* A; const bf16_t* Bt; int M, N, K; const bf16_t* A2; const bf16_t* Bt2; int nt2; };

struct StaticOrder {
    int nM, nN, nwg, G, c, nN2, nwg2;
    __host__ __device__ void init(int M, int N, int G_, int c_) { nM = M / BM; nN = N / BM; nwg = nM * nN; G = G_; c = c_; nN2 = 0; nwg2 = 0; }
    __host__ __device__ void init2(int N2) { nN2 = N2 / BM; nwg2 = nM * nN2; }
    __host__ __device__ static void tile(int wgid, int nwg_, int nM_, int nN_, Unit& u) {
        { const int q = nwg_ / NXCD, r = nwg_ % NXCD, xcd = wgid % NXCD, off = wgid / NXCD; wgid = (xcd < r ? xcd * (q + 1) : r * (q + 1) + (xcd - r) * q) + off; }
        const int nig = WGM * nN_, gid = wgid / nig, fm = gid * WGM, gsz = (nM_ - fm) < WGM ? (nM_ - fm) : WGM;
        u.pm = fm + ((wgid % nig) % gsz); u.pn = (wgid % nig) / gsz;
    }
    __host__ __device__ bool next(int i, Unit& u) const {
        const long L = (long)i * G + c;
        if (L < nwg) { tile((int)L, nwg, nM, nN, u); u.alt = 0; return true; }
        const long L2 = L - nwg; if (L2 >= nwg2) return false;
        tile((int)L2, nwg2, nM, nN2, u); u.alt = 1; return true;
    }
    __device__ __forceinline__ void a_ready(const Unit&) const {}
    __device__ __forceinline__ void done(const Unit&) const {}
};

__device__ __forceinline__ unsigned cvt_pk_bf16(float lo, float hi) { unsigned r; asm volatile("v_cvt_pk_bf16_f32 %0, %1, %2" : "=v"(r) : "v"(lo), "v"(hi)); return r; }
typedef float f32x2 __attribute__((ext_vector_type(2)));
__device__ __forceinline__ f32x2 gelu_pk(f32x2 v) {
    const f32x2 x = __builtin_elementwise_abs(v) * 0.70710678118f;
    f32x2 D = x * 0.0000430638f + 0.0002765672f; D = D * x + 0.0001520143f; D = D * x + 0.0092705272f; D = D * x + 0.0422820123f; D = D * x + 0.0705230784f; D = D * x + 1.0f;
    f32x2 r; r.x = __builtin_amdgcn_rcpf(D.x); r.y = __builtin_amdgcn_rcpf(D.y);
    r = r * r; r = r * r; r = r * r; r = r * r;
    const f32x2 m = (v * 0.5f) * r, p = v - m;
    f32x2 o; o.x = v.x < 0.f ? m.x : p.x; o.y = v.y < 0.f ? m.y : p.y; return o;
}

template <int ACT  > struct EpiBf16 {
    static constexpr bool PERM = true, AFTER_DRAIN = false; static constexpr int REP = 1; static_assert(ACT == 0 || ACT == 1, "EpiBf16: ACT is 0 (none) or 1 (gelu_pk)");
    bf16_t* O; int ldc; const float* bias; int split_cols; size_t split_stride; float scale0;
    __device__ __forceinline__ void operator()(const f32x4 (&acc)[2][2][4][2], const Unit& u, int wr, int wc, int fr, int fq) const {
        const int row0 = u.pm * BM + wr * 64 + fr; int colt = u.pn * BM; bf16_t* base = O;
        float sc = 1.f; if (split_cols) { const int t = colt / split_cols; base += (size_t)t * split_stride; colt -= t * split_cols; if (t == 0) sc = scale0; }
        const int col0 = colt + wc * 32 + 8 * fq, bcol0 = u.pn * BM + wc * 32 + 8 * fq;
        f32x4 bv[2][2];
#pragma unroll
        for (int bj = 0; bj < 2; ++bj)
#pragma unroll
            for (int n = 0; n < 2; ++n) bv[bj][n] = bias ? *(const f32x4*)(bias + bcol0 + bj * HALF + 4 * n) : (f32x4){0.f, 0.f, 0.f, 0.f};
#pragma unroll
        for (int ai = 0; ai < 2; ++ai)
#pragma unroll
            for (int m = 0; m < 4; ++m) { bf16_t* rowp = base + (size_t)(row0 + ai * HALF + m * 16) * ldc + col0;
#pragma unroll
                for (int bj = 0; bj < 2; ++bj) { f32x4 v0 = acc[ai][bj][m][0] + bv[bj][0], v1 = acc[ai][bj][m][1] + bv[bj][1];
                    if (ACT == 1) { f32x2 a = gelu_pk((f32x2){v0[0], v0[1]}), b = gelu_pk((f32x2){v0[2], v0[3]}), c = gelu_pk((f32x2){v1[0], v1[1]}), d = gelu_pk((f32x2){v1[2], v1[3]});
                        v0 = (f32x4){a.x, a.y, b.x, b.y}; v1 = (f32x4){c.x, c.y, d.x, d.y}; }
                    v0 = v0 * sc; v1 = v1 * sc; u32x4 w; w.x = cvt_pk_bf16(v0[0], v0[1]); w.y = cvt_pk_bf16(v0[2], v0[3]); w.z = cvt_pk_bf16(v1[0], v1[1]); w.w = cvt_pk_bf16(v1[2], v1[3]);
                    *(u32x4*)(rowp + bj * HALF) = w; } }
    }
};
#ifndef REP_E1
#define REP_E1 1
#endif
#ifndef REP_E3
#define REP_E3 1
#endif
#ifndef REP_E4
#define REP_E4 1
#endif
__device__ __forceinline__ float sigm(float x) { return __builtin_amdgcn_rcpf(1.0f + __builtin_amdgcn_exp2f(-1.44269504089f * x)); }
__device__ __forceinline__ f32x4 sigm4(f32x4 v) { return (f32x4){sigm(v[0]), sigm(v[1]), sigm(v[2]), sigm(v[3])}; }
__device__ __forceinline__ f32x4 gelu4(f32x4 v) { const f32x2 a = gelu_pk((f32x2){v[0], v[1]}), b = gelu_pk((f32x2){v[2], v[3]}); return (f32x4){a.x, a.y, b.x, b.y}; }
__device__ __forceinline__ u32x4 pack8(f32x4 v0, f32x4 v1) { u32x4 w; w.x = cvt_pk_bf16(v0[0], v0[1]); w.y = cvt_pk_bf16(v0[2], v0[3]); w.z = cvt_pk_bf16(v1[0], v1[1]); w.w = cvt_pk_bf16(v1[2], v1[3]); return w; }
__device__ __forceinline__ f32x4 unpk_lo(u32x4 w) { return (f32x4){__uint_as_float(w.x << 16), __uint_as_float(w.x & 0xffff0000u), __uint_as_float(w.y << 16), __uint_as_float(w.y & 0xffff0000u)}; }
__device__ __forceinline__ f32x4 unpk_hi(u32x4 w) { return (f32x4){__uint_as_float(w.z << 16), __uint_as_float(w.z & 0xffff0000u), __uint_as_float(w.w << 16), __uint_as_float(w.w & 0xffff0000u)}; }

__device__ __forceinline__ void store16_sc1(void* p, u32x4 v) { asm volatile("global_store_dwordx4 %0, %1, off sc1\n\ts_nop 1" :: "v"(p), "v"(v) : "memory"); }

struct EpiP1 {
    static constexpr bool PERM = true, AFTER_DRAIN = false; static constexpr int REP = REP_E1;
    bf16_t *Ab, *SZ, *UG, *GV;
    bf16_t *PE;
    __device__ __forceinline__ void operator()(const f32x4 (&acc)[2][2][4][2], const Unit& u, int wr, int wc, int fr, int fq) const {
        const int row0 = u.pm * BM + wr * 64 + fr, pn = u.pn, cl = wc * 32 + 8 * fq;
        if (u.alt) {
#pragma unroll
            for (int ai = 0; ai < 2; ++ai)
#pragma unroll
                for (int m = 0; m < 4; ++m) { bf16_t* rowp = PE + (size_t)(row0 + ai * HALF + m * 16) * 1024 + pn * BM + cl;
#pragma unroll
                    for (int bj = 0; bj < 2; ++bj) *(u32x4*)(rowp + bj * HALF) = pack8(acc[ai][bj][m][0], acc[ai][bj][m][1]); }
        } else if (pn < 6 || pn == 8 || pn == 9) {
            const bool glu = pn < 4; bf16_t* base = glu ? Ab : UG; const int colt = 128 * (glu ? pn : (pn < 6 ? pn - 4 : pn - 6)) + cl;
#pragma unroll
            for (int ai = 0; ai < 2; ++ai)
#pragma unroll
                for (int m = 0; m < 4; ++m) { bf16_t* rowp = base + (size_t)(row0 + ai * HALF + m * 16) * 512 + colt;
                    const f32x4 v0 = acc[ai][0][m][0], v1 = acc[ai][0][m][1], g0 = acc[ai][1][m][0], g1 = acc[ai][1][m][1];
                    f32x4 o0, o1;
                    if (glu) { o0 = v0 * sigm4(g0); o1 = v1 * sigm4(g1); }
                    else { o0 = gelu4(v0) * (g0 * sigm4(g0)); o1 = gelu4(v1) * (g1 * sigm4(g1)); }
                    *(u32x4*)rowp = pack8(o0, o1); }
        } else {
            const bool sil = pn < 8; bf16_t* base = sil ? SZ : GV; const int colt = 256 * (sil ? pn - 6 : pn - 10) + cl;
#pragma unroll
            for (int ai = 0; ai < 2; ++ai)
#pragma unroll
                for (int m = 0; m < 4; ++m) { bf16_t* rowp = base + (size_t)(row0 + ai * HALF + m * 16) * 512 + colt;
#pragma unroll
                    for (int bj = 0; bj < 2; ++bj) { const f32x4 v0 = acc[ai][bj][m][0], v1 = acc[ai][bj][m][1]; f32x4 o0, o1;
                        if (sil) { o0 = v0 * sigm4(v0); o1 = v1 * sigm4(v1); } else { o0 = gelu4(v0); o1 = gelu4(v1); }
                        *(u32x4*)(rowp + bj * HALF) = pack8(o0, o1); } }
        }
    }
};

struct EpiP3 {
    static constexpr int STAMP_SLOT = 9; static constexpr bool PERM = true, AFTER_DRAIN = true; static constexpr int REP = REP_E3;
    const bf16_t* H; bf16_t* RB; float* statsP; float alpha; unsigned* pcnt;
    __device__ __forceinline__ void fused(f32x4 (&acc)[2][2][4][2], const Unit& u, int wr, int wc, int fr, int fq, PG8_LAS unsigned char* lds, int wid, int lane) const {
        PG8_LAS f32x2* P = (PG8_LAS f32x2*)lds;
        const int col0 = u.pn * BM + wc * 32 + 8 * fq;
        const size_t off0 = (size_t)(u.pm * BM + wr * 64 + fr) * 1024 + col0;
        u32x4 hv[2][4][2];
#pragma unroll
        for (int ai = 0; ai < 2; ++ai)
#pragma unroll
            for (int m = 0; m < 4; ++m)
#pragma unroll
                for (int bj = 0; bj < 2; ++bj) hv[ai][m][bj] = __builtin_nontemporal_load((const u32x4*)(H + off0 + (size_t)(ai * HALF + m * 16) * 1024 + bj * HALF));
        asm volatile("" ::: "memory");
#pragma unroll
        for (int ai = 0; ai < 2; ++ai)
#pragma unroll
            for (int m = 0; m < 4; ++m) { const int r = ai * HALF + wr * 64 + m * 16 + fr; const size_t off = off0 + (size_t)(ai * HALF + m * 16) * 1024; float s1 = 0.f, s2 = 0.f;
#pragma unroll
                for (int bj = 0; bj < 2; ++bj) { const u32x4 hh = hv[ai][m][bj];
                    const f32x4 v0 = acc[ai][bj][m][0] + alpha * unpk_lo(hh), v1 = acc[ai][bj][m][1] + alpha * unpk_hi(hh);
                    store16_sc1(RB + off + bj * HALF, pack8(v0, v1));
                    s1 += (v0[0] + v0[1]) + (v0[2] + v0[3]) + (v1[0] + v1[1]) + (v1[2] + v1[3]);
                    s2 += (v0[0] * v0[0] + v0[1] * v0[1]) + (v0[2] * v0[2] + v0[3] * v0[3]) + (v1[0] * v1[0] + v1[1] * v1[1]) + (v1[2] * v1[2] + v1[3] * v1[3]); }
                s1 += __shfl_xor(s1, 16); s1 += __shfl_xor(s1, 32); s2 += __shfl_xor(s2, 16); s2 += __shfl_xor(s2, 32);
                if (fq == 0) P[r * 4 + wc] = (f32x2){s1, s2}; }
        __syncthreads();
        const int tid = wid * 64 + lane;
        if (tid < 256) { const f32x2 a = P[tid * 4 + 0], b = P[tid * 4 + 1], c = P[tid * 4 + 2], d = P[tid * 4 + 3];
            const float t1 = (a.x + b.x) + (c.x + d.x), t2 = (a.y + b.y) + (c.y + d.y);
            __hip_atomic_store((unsigned long long*)(statsP + (size_t)(u.pm * BM + tid) * 8 + u.pn * 2), ((unsigned long long)__float_as_uint(t2) << 32) | __float_as_uint(t1), __ATOMIC_RELAXED, __HIP_MEMORY_SCOPE_AGENT); }
        asm volatile("s_waitcnt vmcnt(0)" ::: "memory");
        __syncthreads();
        if (pcnt && tid == 0) (void)__hip_atomic_fetch_add(pcnt + 64 * u.pm, 1u, __ATOMIC_RELAXED, __HIP_MEMORY_SCOPE_AGENT);
    }
};

struct EpiP4 {
    static constexpr int STAMP_SLOT = 12; static constexpr bool PERM = true, AFTER_DRAIN = true; static constexpr int REP = REP_E4;
    const bf16_t* RB; const bf16_t* PE; const float* statsP; const float* cp1; const float* cp2; const float* bgate; const float* g; const float* b; float* out; float eps;
    __device__ __forceinline__ void fused(f32x4 (&acc)[2][2][4][2], const Unit& u, int wr, int wc, int fr, int fq, PG8_LAS unsigned char* lds, int wid, int lane) const {
        PG8_LAS float* C = (PG8_LAS float*)lds;
        PG8_LAS f32x2* T = (PG8_LAS f32x2*)(lds + 2048);
        const int tid = wid * 64 + lane;
        const size_t off0 = (size_t)(u.pm * BM + wr * 64 + fr) * 1024 + u.pn * BM + wc * 32 + 8 * fq;
        u32x4 rw[2][2], pw[2][2];
#define P4_LOAD(s) do { _Pragma("unroll") for (int mm = 0; mm < 2; ++mm) { const size_t o_ = off0 + (size_t)((((s) >> 1) & 1) * HALF + (((s) & 1) * 2 + mm) * 16) * 1024 + ((s) >> 2) * HALF; \
            rw[(s) & 1][mm] = __builtin_nontemporal_load((const u32x4*)(RB + o_)); pw[(s) & 1][mm] = __builtin_nontemporal_load((const u32x4*)(PE + o_)); } } while (0)
        P4_LOAD(0);
        { const int col = tid & 255, which = tid >> 8; const float* cp = cp1 + which * (16 * 1024); float s = 0.f;
#pragma unroll
          for (int kb = 0; kb < 16; ++kb) s += cp[kb * 1024 + u.pn * BM + col];
          if (which) s += bgate[u.pn * BM + col];
          C[which * 256 + col] = s; }
        if (tid < 256) { const float* sp = statsP + (size_t)(u.pm * BM + tid) * 8; const f32x4 a = *(const f32x4*)sp, bq = *(const f32x4*)(sp + 4);
            const float s1 = (a[0] + a[2]) + (bq[0] + bq[2]), s2 = (a[1] + a[3]) + (bq[1] + bq[3]);
            const float mu = s1 * (1.0f / 1024.0f); float var = s2 * (1.0f / 1024.0f) - mu * mu; var = var < 0.f ? 0.f : var;
            T[tid] = (f32x2){mu, __builtin_amdgcn_rsqf(var + eps)}; }
        __syncthreads();
#pragma unroll
        for (int bj = 0; bj < 2; ++bj) {
            const int cl = wc * 32 + 8 * fq + bj * HALF, gc = u.pn * BM + cl;
            const f32x4 c1a = *(const PG8_LAS f32x4*)(C + cl), c1b = *(const PG8_LAS f32x4*)(C + cl + 4), c2a = *(const PG8_LAS f32x4*)(C + 256 + cl), c2b = *(const PG8_LAS f32x4*)(C + 256 + cl + 4);
            const f32x4 ga = *(const f32x4*)(g + gc), gb = *(const f32x4*)(g + gc + 4), ba = *(const f32x4*)(b + gc), bb = *(const f32x4*)(b + gc + 4);
#pragma unroll
            for (int s4 = 0; s4 < 4; ++s4) {
                const int s = bj * 4 + s4, ai = s4 >> 1, mh = s4 & 1;
                if (s + 1 < 8) P4_LOAD(s + 1);
                asm volatile("" ::: "memory");
#pragma unroll
                for (int mm = 0; mm < 2; ++mm) { const int m = 2 * mh + mm, r = ai * HALF + wr * 64 + m * 16 + fr; const f32x2 sr = T[r]; const size_t off = off0 + (size_t)(ai * HALF + m * 16) * 1024 + bj * HALF;
                    const f32x4 r0 = unpk_lo(rw[s & 1][mm]), r1 = unpk_hi(rw[s & 1][mm]), p0 = unpk_lo(pw[s & 1][mm]), p1 = unpk_hi(pw[s & 1][mm]);
                    const f32x4 gp0 = (acc[ai][bj][m][0] - sr.x * c1a) * sr.y + c2a, gp1 = (acc[ai][bj][m][1] - sr.x * c1b) * sr.y + c2b;
                    const f32x4 h0 = (r0 - sr.x) * sr.y * ga + ba, h1 = (r1 - sr.x) * sr.y * gb + bb;
                    *(f32x4*)(out + off) = h0 + sigm4(gp0) * p0; *(f32x4*)(out + off + 4) = h1 + sigm4(gp1) * p1; }
            }
        }
#undef P4_LOAD
    }
};


struct EpiNone {
    static constexpr bool PERM = true, AFTER_DRAIN = false; static constexpr int REP = 1;
    __device__ __forceinline__ void operator()(const f32x4 (&acc)[2][2][4][2], const Unit& u, int wr, int wc, int fr, int fq) const { asm volatile("" :: "v"(acc[0][0][0][0]), "v"(acc[1][1][3][1])); }
};
template <class Epi, class Sched, bool ALIGN_EPI = false, bool SP2 = false>
__device__ __forceinline__ void gemm_phase(PG8_LAS unsigned char* lds, const Gemm g, const Sched& S, const Epi& E) {
    int tid_ = threadIdx.x; asm volatile("" : "+v"(tid_));
    const int tid = tid_, wid = __builtin_amdgcn_readfirstlane(tid >> 6), lane = tid & 63, wr = wid >> 2, wc = wid & 3, fr = lane & 15, fq = lane >> 4;
    const int K = g.K, nt = K / BK;
    unsigned voffA[2], voffB[2];
#pragma unroll
    for (int i = 0; i < 2; ++i) { int R, C; stage_rc(tid * 16 + i * 8192, R, C); const int Rb = Epi::PERM ? ((R & ~31) + perm32(R & 31)) : R;
        voffA[i] = (unsigned)(R * K + C) * 2u; voffB[i] = (unsigned)(Rb * K + C) * 2u; }
    const size_t kstep = (size_t)(BK * 2);
    const size_t hstep = (size_t)HALF * K * 2;
    const size_t tstep = 2 * hstep;
    const unsigned ldsw = (unsigned)wid * 1024u;
    const int aoff = lds_byte(wr * 64 + fr, fq * 8), boff = lds_byte(wc * 32 + fr, fq * 8);
#define PG8_SA(b, h) (((b) * 2 + (h)) * HTB)
#define PG8_SB(b, h) ((4 + (b) * 2 + (h)) * HTB)
#define PG8_STAGE(bufoff, gbase, voff) do { _Pragma("unroll") for (int _i = 0; _i < 2; ++_i) \
        __builtin_amdgcn_global_load_lds((const unsigned*)((const char*)(gbase) + (voff)[_i]), (PG8_LAS unsigned*)(lds + (bufoff) + ldsw + _i * 8192), 16, 0, 0); } while (0)
#define PG8_LDA(dst, b, h) do { _Pragma("unroll") for (int m = 0; m < 4; ++m) _Pragma("unroll") for (int k = 0; k < 2; ++k) dst[m][k] = *(const PG8_LAS bf16x8*)(lds + PG8_SA(b, h) + aoff + m * 2048 + k * 1024); } while (0)
#define PG8_LDB(dst, b, h) do { _Pragma("unroll") for (int n = 0; n < 2; ++n) _Pragma("unroll") for (int k = 0; k < 2; ++k) dst[n][k] = *(const PG8_LAS bf16x8*)(lds + PG8_SB(b, h) + boff + n * 2048 + k * 1024); } while (0)
#define PG8_MMA(ai, bj, At, Bt) do { __builtin_amdgcn_s_setprio(1); _Pragma("unroll") for (int m = 0; m < 4; ++m) _Pragma("unroll") for (int n = 0; n < 2; ++n) _Pragma("unroll") for (int k = 0; k < 2; ++k) \
        acc[ai][bj][m][n] = __builtin_amdgcn_mfma_f32_16x16x32_bf16(Bt[n][k], At[m][k], acc[ai][bj][m][n], 0, 0, 0); __builtin_amdgcn_s_setprio(0); } while (0)
#define PG8_WAIT_V(n) asm volatile("s_waitcnt vmcnt(" #n ")" ::: "memory")
#define PG8_WAIT_L(n) asm volatile("s_waitcnt lgkmcnt(" #n ")" ::: "memory")
#define PG8_BAR __builtin_amdgcn_s_barrier()
#define PG8_SCHED __builtin_amdgcn_sched_barrier(0)
    Unit cur, nxt; int ui = 0;
    if (!S.next(0, cur)) return;
    f32x4 acc[2][2][4][2];
#pragma unroll
    for (int a = 0; a < 2; ++a)
#pragma unroll
        for (int b = 0; b < 2; ++b)
#pragma unroll
            for (int m = 0; m < 4; ++m)
#pragma unroll
                for (int n = 0; n < 2; ++n) acc[a][b][m][n] = (f32x4){0.f, 0.f, 0.f, 0.f};
    bf16x8 At[4][2], B0[2][2], B1[2][2];
    const char* cA = (const char*)(cur.alt ? g.A2 : g.A) + (size_t)cur.pm * tstep; const char* cB = (const char*)(cur.alt ? g.Bt2 : g.Bt) + (size_t)cur.pn * tstep;
    int ntc = cur.alt ? g.nt2 : nt;
    S.a_ready(cur);
    if constexpr (SP2) {
        PG8_STAGE(PG8_SB(0, 0), cB, voffB); PG8_STAGE(PG8_SB(0, 1), cB + hstep, voffB); PG8_STAGE(PG8_SA(0, 0), cA, voffA); PG8_STAGE(PG8_SA(0, 1), cA + hstep, voffA);
        if (wr == 1) PG8_BAR;
        PG8_WAIT_V(2); PG8_BAR;
        PG8_STAGE(PG8_SB(1, 0), cB + kstep, voffB); PG8_STAGE(PG8_SA(1, 0), cA + kstep, voffA); PG8_STAGE(PG8_SB(1, 1), cB + hstep + kstep, voffB);
        PG8_WAIT_V(6); PG8_BAR;
    } else {
        PG8_STAGE(PG8_SB(0, 0), cB, voffB); PG8_STAGE(PG8_SA(0, 0), cA, voffA); PG8_STAGE(PG8_SB(0, 1), cB + hstep, voffB); PG8_STAGE(PG8_SA(0, 1), cA + hstep, voffA);
        if (wr == 1) PG8_BAR;
        PG8_WAIT_V(4); PG8_BAR;
        PG8_STAGE(PG8_SB(1, 0), cB + kstep, voffB); PG8_STAGE(PG8_SA(1, 0), cA + kstep, voffA); PG8_STAGE(PG8_SB(1, 1), cB + hstep + kstep, voffB);
        PG8_WAIT_V(6); PG8_BAR;
    }
    for (;;) {
        const bool has_next = S.next(ui + 1, nxt);
        const char* nA = has_next ? (const char*)(nxt.alt ? g.A2 : g.A) + (size_t)nxt.pm * tstep : cA; const char* nB = has_next ? (const char*)(nxt.alt ? g.Bt2 : g.Bt) + (size_t)nxt.pn * tstep : cB;
        for (int t = 0; t < ntc; t += 2) {
            const bool last = (t == ntc - 2);
            const char* a1 = cA + (size_t)(t + 1) * kstep;
            const char* a2 = last ? nA : cA + (size_t)(t + 2) * kstep; const char* b2 = last ? nB : cB + (size_t)(t + 2) * kstep;
            const char* a3 = a2 + kstep; const char* b3 = b2 + kstep;
            if (last && has_next) S.a_ready(nxt);
            if constexpr (SP2) {
            PG8_LDB(B0, 0, 0); PG8_LDB(B1, 0, 1); PG8_SCHED; PG8_LDA(At, 0, 0); PG8_STAGE(PG8_SA(1, 1), a1 + hstep, voffA);
            PG8_WAIT_V(8); PG8_WAIT_L(0); PG8_BAR; PG8_MMA(0, 0, At, B0); PG8_MMA(0, 1, At, B1); PG8_BAR; PG8_SCHED;
            PG8_LDA(At, 0, 1); PG8_STAGE(PG8_SB(0, 0), b2, voffB); PG8_STAGE(PG8_SB(0, 1), b2 + hstep, voffB); PG8_STAGE(PG8_SA(0, 0), a2, voffA);
            PG8_WAIT_V(8); PG8_WAIT_L(0); PG8_BAR; PG8_MMA(1, 0, At, B0); PG8_MMA(1, 1, At, B1); PG8_BAR; PG8_SCHED;
            PG8_LDB(B0, 1, 0); PG8_LDB(B1, 1, 1); PG8_SCHED; PG8_LDA(At, 1, 0); PG8_STAGE(PG8_SA(0, 1), a2 + hstep, voffA);
            PG8_WAIT_V(8); PG8_WAIT_L(0); PG8_BAR; PG8_MMA(0, 0, At, B0); PG8_MMA(0, 1, At, B1); PG8_BAR; PG8_SCHED;
            PG8_LDA(At, 1, 1); PG8_STAGE(PG8_SB(1, 0), b3, voffB); PG8_STAGE(PG8_SB(1, 1), b3 + hstep, voffB); PG8_STAGE(PG8_SA(1, 0), a3, voffA);
            PG8_WAIT_V(8); PG8_WAIT_L(0); PG8_BAR; PG8_MMA(1, 0, At, B0); PG8_MMA(1, 1, At, B1); PG8_BAR; PG8_SCHED;
            } else {
            PG8_LDB(B0, 0, 0); PG8_SCHED; PG8_LDA(At, 0, 0); PG8_STAGE(PG8_SA(1, 1), a1 + hstep, voffA);
            PG8_WAIT_L(8); PG8_BAR; PG8_WAIT_L(0); PG8_MMA(0, 0, At, B0); PG8_BAR; PG8_SCHED;
            PG8_LDB(B1, 0, 1); PG8_STAGE(PG8_SB(0, 0), b2, voffB);
            PG8_BAR; PG8_WAIT_L(0); PG8_MMA(0, 1, At, B1); PG8_BAR;
            PG8_LDA(At, 0, 1); PG8_STAGE(PG8_SA(0, 0), a2, voffA);
            PG8_BAR; PG8_WAIT_L(0); PG8_MMA(1, 0, At, B0); PG8_BAR; PG8_SCHED;
            PG8_STAGE(PG8_SB(0, 1), b2 + hstep, voffB);
            PG8_WAIT_V(6); PG8_BAR; PG8_MMA(1, 1, At, B1); PG8_BAR;
            PG8_LDB(B0, 1, 0); PG8_SCHED; PG8_LDA(At, 1, 0); PG8_STAGE(PG8_SA(0, 1), a2 + hstep, voffA);
            PG8_WAIT_L(8); PG8_BAR; PG8_WAIT_L(0); PG8_MMA(0, 0, At, B0); PG8_BAR; PG8_SCHED;
            PG8_LDB(B1, 1, 1); PG8_STAGE(PG8_SB(1, 0), b3, voffB);
            PG8_BAR; PG8_WAIT_L(0); PG8_MMA(0, 1, At, B1); PG8_BAR;
            PG8_LDA(At, 1, 1); PG8_STAGE(PG8_SA(1, 0), a3, voffA);
            PG8_BAR; PG8_WAIT_L(0); PG8_MMA(1, 0, At, B0); PG8_BAR; PG8_SCHED;
            PG8_STAGE(PG8_SB(1, 1), b3 + hstep, voffB);
            PG8_WAIT_V(6); PG8_BAR; PG8_MMA(1, 1, At, B1); PG8_BAR;
            }
        }
        if constexpr (ALIGN_EPI) { if (wr == 0) PG8_BAR; }
        if constexpr (!Epi::AFTER_DRAIN) { E(acc, cur, wr, wc, fr, fq); if constexpr (Epi::REP > 1) { asm volatile("" ::: "memory"); E(acc, cur, wr, wc, fr, fq); } S.done(cur); }
        if (!has_next) break;
#pragma unroll
        for (int a = 0; a < 2; ++a)
#pragma unroll
            for (int b = 0; b < 2; ++b)
#pragma unroll
                for (int m = 0; m < 4; ++m)
#pragma unroll
                    for (int n = 0; n < 2; ++n) acc[a][b][m][n] = (f32x4){0.f, 0.f, 0.f, 0.f};
        cur = nxt; cA = nA; cB = nB; ++ui; ntc = cur.alt ? g.nt2 : nt;
        if constexpr (ALIGN_EPI) { if (wr == 1) PG8_BAR; }
    }
    PG8_WAIT_V(0);
    if constexpr (!ALIGN_EPI) { if (wr == 0) PG8_BAR; }
    PG8_BAR;
#ifdef TPROBE
    if constexpr (Epi::AFTER_DRAIN) { if (tid == 0) ((volatile PG8_LAS unsigned long long*)(lds + TPROBE_MISC + 64))[Epi::STAMP_SLOT] = __builtin_amdgcn_s_memrealtime(); }
#endif
    if constexpr (Epi::AFTER_DRAIN) { E.fused(acc, cur, wr, wc, fr, fq, lds, wid, lane); if constexpr (Epi::REP > 1) { __syncthreads(); E.fused(acc, cur, wr, wc, fr, fq, lds, wid, lane); } S.done(cur); }
#undef PG8_SA
#undef PG8_SB
#undef PG8_STAGE
#undef PG8_LDA
#undef PG8_LDB
#undef PG8_MMA
#undef PG8_WAIT_V
#undef PG8_WAIT_L
#undef PG8_BAR
#undef PG8_SCHED
}
}
#ifndef REP_TR
#define REP_TR 1
#endif
#ifndef REP_SGU
#define REP_SGU 1
#endif
#ifndef REP_CONV
#define REP_CONV 1
#endif
#ifndef REP_P0
#define REP_P0 1
#endif
#ifndef REP_P1
#define REP_P1 1
#endif
#ifndef REP_P2
#define REP_P2 1
#endif
#ifndef REP_P3
#define REP_P3 1
#endif
#ifndef REP_P4
#define REP_P4 1
#endif
#ifndef PG8_SP2
#define PG8_SP2 true
#endif
#ifndef PG8_ALIGN
#define PG8_ALIGN true
#endif
#define LAS __attribute__((address_space(3)))
typedef unsigned short bf16;
typedef unsigned v4u __attribute__((ext_vector_type(4)));
typedef unsigned v2u __attribute__((ext_vector_type(2)));
typedef float f32x4 __attribute__((ext_vector_type(4)));
typedef float f32x2 __attribute__((ext_vector_type(2)));
typedef short bf16x8 __attribute__((ext_vector_type(8)));
#define LDS_WAIT() asm volatile("s_waitcnt lgkmcnt(0)" ::: "memory")

constexpr int NWAVES = 8, NTHR = 512;
constexpr int M = 16384, D = 1024, DIN = 3072, DPLE = 256, DC = 512, SEQ = 8192, CHUNK = 128, NHEAD = 8, CW = 31;
constexpr float LN_EPS = 1e-5f, ALPHA = 1.189207115002721f;
constexpr size_t MiB = 1u << 20;
constexpr size_t WS_CP1 = 0, WS_CP2 = 64 * 1024, WS_STATSP = 128 * 1024;
constexpr size_t WS_WSB = 1 * MiB;
constexpr size_t WS_WIN = 2 * MiB, WS_WOUT = 8 * MiB, WS_WG = 10 * MiB, WS_WPLE = 12 * MiB;
constexpr size_t WS_H = 16 * MiB, WS_PB = 216 * MiB, WS_PE = 56 * MiB, WS_Y = 88 * MiB, WS_RB = 120 * MiB;
constexpr size_t WS_AB = 152 * MiB, WS_SZ = 168 * MiB, WS_UG = 184 * MiB, WS_GV = 200 * MiB;
constexpr size_t WS_R = 152 * MiB;
constexpr size_t WS_END = 248 * MiB;
constexpr int LDS_BYTES = 147456;

__device__ __forceinline__ unsigned f2bf(float f) { unsigned u = __builtin_bit_cast(unsigned, f); return (u + 0x7fffu + ((u >> 16) & 1u)) >> 16; }
__device__ __forceinline__ unsigned pk2(float lo, float hi) { unsigned r; asm volatile("v_cvt_pk_bf16_f32 %0, %1, %2" : "=v"(r) : "v"(lo), "v"(hi)); return r; }
__device__ __forceinline__ float bf_lo(unsigned u) { return __uint_as_float(u << 16); }
__device__ __forceinline__ float bf_hi(unsigned u) { return __uint_as_float(u & 0xffff0000u); }
template <int CTRL> __device__ __forceinline__ float dpp_addc(float v) {
    return v + __builtin_bit_cast(float, __builtin_amdgcn_update_dpp(0, __builtin_bit_cast(int, v), CTRL, 0xF, 0xF, true));
}
__device__ __forceinline__ float wave_sum(float v) {
    v = dpp_addc<0xB1>(v);
    v = dpp_addc<0x4E>(v);
    v = dpp_addc<0x141>(v);
    v = dpp_addc<0x140>(v);
    const int vi = __builtin_bit_cast(int, v);
    const float r0 = __builtin_bit_cast(float, __builtin_amdgcn_readlane(vi, 0)), r1 = __builtin_bit_cast(float, __builtin_amdgcn_readlane(vi, 16)),
                r2 = __builtin_bit_cast(float, __builtin_amdgcn_readlane(vi, 32)), r3 = __builtin_bit_cast(float, __builtin_amdgcn_readlane(vi, 48));
    return (r0 + r1) + (r2 + r3);
}
__device__ __forceinline__ float sigm_f(float x) { return __builtin_amdgcn_rcpf(1.0f + __builtin_amdgcn_exp2f(-1.44269504089f * x)); }

#define GAS __attribute__((address_space(1)))
constexpr size_t WS_BAR = 768 * 1024, BAR_ZERO_BYTES = 32768;
constexpr size_t WS_PCNT = WS_BAR + 16384;
constexpr int MISC_OFF = LDS_BYTES - 256;
#define XB_TMO      128
#define XB_XCNT(j)  (256  + 64 * (j))
#define XB_XSUB(j)  (1280 + 64 * (j))
#define XB_XGEN(j)  (2304 + 64 * (j))
#define XB_TOP      3328
#define XB_TOPGEN   3392
#define XCD_BAR_WORDS 3456
#define XB_SPIN_CAP (1u << 18)

__device__ __forceinline__ unsigned xb_ld(unsigned* p)              { return __hip_atomic_load(p, __ATOMIC_RELAXED, __HIP_MEMORY_SCOPE_AGENT); }
__device__ __forceinline__ unsigned xb_add(unsigned* p, unsigned v) { return __hip_atomic_fetch_add(p, v, __ATOMIC_RELAXED, __HIP_MEMORY_SCOPE_AGENT); }
__device__ __forceinline__ unsigned xb_xcc_id() { return (unsigned)__builtin_amdgcn_s_getreg((3 << 11) | 20) & 0xFu; }
#define XB_SPIN(cond, bar) do { unsigned _sp = 0; while (cond) { __builtin_amdgcn_s_sleep(1); \
    if ((++_sp & 255u) == 0u) { if (xb_ld(&(bar)[XB_TMO])) break; if (_sp > XB_SPIN_CAP) { atomicAdd(&(bar)[XB_TMO], 1u); break; } } } } while (0)

struct XcdBarrier {
    unsigned* bar; unsigned x;
    volatile LAS unsigned* st;
};

__device__ __forceinline__ XcdBarrier xcd_barrier_post(unsigned* bar, volatile LAS unsigned* st) {
    XcdBarrier b; b.bar = bar; b.x = xb_xcc_id(); b.st = st;
    if (threadIdx.x == 0) (void)xb_add(&bar[XB_XCNT(b.x)], 1u);
    return b;
}
__device__ __forceinline__ void xcd_barrier_complete(unsigned* bar, unsigned x, unsigned& nloc, unsigned& nx) {
    const unsigned G = gridDim.x * gridDim.y * gridDim.z;
    unsigned sum, cnt, mine, sp = 0u;
    for (;;) {
        sum = 0u; cnt = 0u; mine = 0u;
#pragma unroll
        for (unsigned j = 0; j < 16; ++j) { const unsigned c = xb_ld(&bar[XB_XCNT(j)]); sum += c; cnt += (c > 0u) ? 1u : 0u; mine = (j == x) ? c : mine; }
        if (sum == G) break;
        __builtin_amdgcn_s_sleep(1);
        if ((++sp & 255u) == 0u) { if (xb_ld(&bar[XB_TMO])) break; if (sp > XB_SPIN_CAP) { atomicAdd(&bar[XB_TMO], 1u); break; } }
    }
    nloc = mine > 0u ? mine : 1u; nx = cnt > 0u ? cnt : 1u;
}

__device__ __forceinline__ void xcd_barrier(const XcdBarrier& b) {
    asm volatile("s_waitcnt vmcnt(0)" ::: "memory");
    __syncthreads();
    if (threadIdx.x == 0) {
        unsigned* bar = b.bar;
        __builtin_amdgcn_s_waitcnt(0);
        unsigned nloc = b.st[0], nx = b.st[1];
        if (nloc == 0u) { xcd_barrier_complete(bar, b.x, nloc, nx); b.st[0] = nloc; b.st[1] = nx; }
        const unsigned old = xb_add(&bar[XB_XSUB(b.x)], 1u);
        const unsigned gen = old / nloc;
        if (old + 1u == (gen + 1u) * nloc) {
            __builtin_amdgcn_fence(__ATOMIC_RELEASE, "agent");
            asm volatile("s_waitcnt vmcnt(0)" ::: "memory");
            const unsigned og = xb_add(&bar[XB_TOP], 1u);
            const unsigned tg = og / nx;
            if (og + 1u == (tg + 1u) * nx) xb_add(&bar[XB_TOPGEN], 1u);
            else XB_SPIN(xb_ld(&bar[XB_TOPGEN]) == tg, bar);
            __builtin_amdgcn_fence(__ATOMIC_ACQUIRE, "agent");
            xb_add(&bar[XB_XGEN(b.x)], 1u);
            asm volatile("s_waitcnt vmcnt(0)" ::: "memory");
        } else {
            XB_SPIN(xb_ld(&bar[XB_XGEN(b.x)]) == gen, bar);
            __builtin_amdgcn_fence(__ATOMIC_ACQUIRE, "agent");
            asm volatile("s_waitcnt vmcnt(0)" ::: "memory");
        }
    }
    __syncthreads();
}

#ifdef TPROBE
#define STAMP(i) do { __syncthreads(); if (threadIdx.x == 0) ((volatile LAS unsigned long long*)(lds + MISC_OFF + 64))[i] = __builtin_amdgcn_s_memrealtime(); } while (0)
#else
#define STAMP(i) do { } while (0)
#endif
struct Args { const float* in[19]; float* out; unsigned char* ws; };

__device__ __forceinline__ int win_map(int n) {
    const int seg = n >> 9, o = n & 511, blk = o >> 7, w = o & 127;
    if (seg == 0) return 256 * blk + w;
    if (seg == 1) return 256 * blk + 128 + w;
    if (seg == 2) return 1536 + o;
    if (seg == 3) return (blk < 2 ? 1024 + 256 * blk : 2048 + 256 * (blk - 2)) + w;
    if (seg == 5) return (blk < 2 ? 1024 + 256 * blk : 2048 + 256 * (blk - 2)) + 128 + w;
    return 2560 + o;
}
template <bool GATE>
__device__ __forceinline__ void tr_item(const float* W, int K, int N, bf16* WT, int drow, LAS float* scr, int k0, int n0, int lane, const float* g, const float* b, float* cp1, float* cp2) {
#pragma unroll
    for (int i = 0; i < 32; ++i) { const int kk = 2 * i + (lane >> 5); scr[kk * 33 + (lane & 31)] = __builtin_nontemporal_load(W + (size_t)(k0 + kk) * N + n0 + (lane & 31)); }
    LDS_WAIT(); asm volatile("" ::: "memory");
    const int c = lane & 7;
    float gs[8];
#pragma unroll
    for (int e = 0; e < 8; ++e) gs[e] = GATE ? g[k0 + 8 * c + e] : 1.0f;
#pragma unroll
    for (int j = 0; j < 4; ++j) { const int n = (lane >> 3) + 8 * j; const LAS float* s = scr + (8 * c) * 33 + n;
        v4u o; o.x = pk2(s[0 * 33] * gs[0], s[1 * 33] * gs[1]); o.y = pk2(s[2 * 33] * gs[2], s[3 * 33] * gs[3]); o.z = pk2(s[4 * 33] * gs[4], s[5 * 33] * gs[5]); o.w = pk2(s[6 * 33] * gs[6], s[7 * 33] * gs[7]);
        *(v4u*)(WT + (size_t)(drow + n) * K + k0 + 8 * c) = o; }
    if (GATE) { const int n = lane & 31, half = lane >> 5; float s1 = 0.f, s2 = 0.f;
#pragma unroll 8
        for (int kk = 0; kk < 32; ++kk) { const int k = 32 * half + kk; const float w = scr[k * 33 + n]; s1 += g[k0 + k] * w; s2 += b[k0 + k] * w; }
        s1 += __shfl_xor(s1, 32); s2 += __shfl_xor(s2, 32);
        if (lane < 32) { cp1[(k0 >> 6) * N + n0 + n] = s1; cp2[(k0 >> 6) * N + n0 + n] = s2; } }
    LDS_WAIT(); asm volatile("" ::: "memory");
}

__device__ __forceinline__ void p0_prologue(const Args& a, LAS unsigned char* lds, int wave, int lane) {
    unsigned char* ws = a.ws;
    LAS float* scr = (LAS float*)(lds + wave * 16384);
    const int gw = blockIdx.x * NWAVES + wave, NGW = gridDim.x * NWAVES;
    constexpr int I_IN = (D / 64) * (DIN / 32), I_OUT = (D / 64) * (D / 32), I_G = I_OUT, I_PLE = (DPLE / 64) * (D / 32);
    constexpr int NITEMS = I_IN + I_OUT + I_G + I_PLE;
    const float* x = a.in[0]; bf16* H = (bf16*)(ws + WS_H);
    f32x4 xv[8][4];
    const bool xl = (gridDim.x % 8 == 0) && (M / 8) % (int)gridDim.x == 0;
    const int rbase = xl ? (int)(blockIdx.x % 8) * (M / 8) + ((int)(blockIdx.x / 8) * NWAVES + wave) * 8 : gw, rstep = xl ? 1 : NGW, rend = xl ? rbase + 8 : M;
#pragma unroll
    for (int r = 0; r < 8; ++r) { const int mr = rbase + r * rstep; const f32x4* xr = (const f32x4*)(x + (size_t)(mr < rend ? mr : rbase) * D) + lane;
#pragma unroll
        for (int j = 0; j < 4; ++j) xv[r][j] = __builtin_nontemporal_load(xr + 64 * j); }
    for (int rep = 0; rep < REP_TR; ++rep)
    for (int it = gw; it < NITEMS; it += NGW) {
        int r = it;
        if (r < I_IN) { const int nblk = DIN / 32, kb = r / nblk, nb = r % nblk; tr_item<false>(a.in[4], D, DIN, (bf16*)(ws + WS_WIN), win_map(32 * nb), scr, 64 * kb, 32 * nb, lane, nullptr, nullptr, nullptr, nullptr); continue; } r -= I_IN;
        if (r < I_OUT) { const int nblk = D / 32, kb = r / nblk, nb = r % nblk; tr_item<false>(a.in[13], D, D, (bf16*)(ws + WS_WOUT), 32 * nb, scr, 64 * kb, 32 * nb, lane, nullptr, nullptr, nullptr, nullptr); continue; } r -= I_OUT;
        if (r < I_G) { const int nblk = D / 32, kb = r / nblk, nb = r % nblk; tr_item<true>(a.in[17], D, D, (bf16*)(ws + WS_WG), 32 * nb, scr, 64 * kb, 32 * nb, lane, a.in[14], a.in[15], (float*)(ws + WS_CP1), (float*)(ws + WS_CP2)); continue; } r -= I_G;
        { const int nblk = D / 32, kb = r / nblk, nb = r % nblk; tr_item<false>(a.in[16], D  , D, (bf16*)(ws + WS_WPLE), 32 * nb, scr, 64 * kb, 32 * nb, lane, nullptr, nullptr, nullptr, nullptr); }
    }
    STAMP(14);
    {
        f32x4 gg[4], bb[4];
#pragma unroll
        for (int j = 0; j < 4; ++j) { gg[j] = *(const f32x4*)(a.in[2] + 4 * lane + 256 * j); bb[j] = *(const f32x4*)(a.in[3] + 4 * lane + 256 * j); }
        for (int m = rbase; m < rend; m += xl ? (1 << 30) : 8 * rstep) {
            if (m != rbase) {
#pragma unroll
                for (int r = 0; r < 8; ++r) { const int mr = m + r * rstep; const f32x4* xr = (const f32x4*)(x + (size_t)(mr < rend ? mr : m) * D) + lane;
#pragma unroll
                    for (int j = 0; j < 4; ++j) xv[r][j] = __builtin_nontemporal_load(xr + 64 * j); }
            }
#pragma unroll
            for (int r = 0; r < 8; ++r) { float s = 0.f;
#pragma unroll
                for (int j = 0; j < 4; ++j) s += (xv[r][j][0] + xv[r][j][1]) + (xv[r][j][2] + xv[r][j][3]);
                const float mean = wave_sum(s) * (1.f / D); float s2 = 0.f;
#pragma unroll
                for (int j = 0; j < 4; ++j) { xv[r][j] = xv[r][j] - mean; s2 += (xv[r][j][0] * xv[r][j][0] + xv[r][j][1] * xv[r][j][1]) + (xv[r][j][2] * xv[r][j][2] + xv[r][j][3] * xv[r][j][3]); }
                const float rstd = __builtin_amdgcn_rsqf(wave_sum(s2) * (1.f / D) + LN_EPS);
                if (m + r * rstep < rend) { v2u* o8 = (v2u*)(H + (size_t)(m + r * rstep) * D) + lane;
#pragma unroll
                    for (int j = 0; j < 4; ++j) { const f32x4 y = xv[r][j] * rstd * gg[j] + bb[j]; o8[64 * j] = (v2u){pk2(y[0], y[1]), pk2(y[2], y[3])}; } } }
        }
    }
    STAMP(15);
    {
        const float* p = a.in[1]; bf16* Pb = (bf16*)(ws + WS_PB);
        const int gt = blockIdx.x * NTHR + threadIdx.x, NGT = gridDim.x * NTHR;
        for (int i0 = gt; i0 < M * DPLE / 8; i0 += 4 * NGT) {
            f32x4 a0[4], a1[4];
#pragma unroll
            for (int r = 0; r < 4; ++r) { const int i = i0 + r * NGT; const bool ok = i < M * DPLE / 8; const size_t o = (size_t)(ok ? i : i0) * 8; a0[r] = __builtin_nontemporal_load((const f32x4*)(p + o)); a1[r] = __builtin_nontemporal_load((const f32x4*)(p + o + 4)); }
#pragma unroll
            for (int r = 0; r < 4; ++r) { const int i = i0 + r * NGT; if (i < M * DPLE / 8)
                *(v4u*)(Pb + (size_t)(i >> 5) * D + (i & 31) * 8) = (v4u){pk2(a0[r][0], a0[r][1]), pk2(a0[r][2], a0[r][3]), pk2(a1[r][0], a1[r][1]), pk2(a1[r][2], a1[r][3])}; }
        }
        const float* wsrc = a.in[11]; bf16* Wsb = (bf16*)(ws + WS_WSB);
        for (int i = gt; i < NHEAD * CHUNK * CHUNK / 8; i += NGT) { const int t = (i >> 4) & 127, s0 = (i & 15) * 8;
            const f32x4 a0 = __builtin_nontemporal_load((const f32x4*)(wsrc + (size_t)i * 8)), a1 = __builtin_nontemporal_load((const f32x4*)(wsrc + (size_t)i * 8 + 4));
            float e[8] = {a0[0], a0[1], a0[2], a0[3], a1[0], a1[1], a1[2], a1[3]};
#pragma unroll
            for (int k = 0; k < 8; ++k) e[k] = (s0 + k <= t) ? e[k] : 0.f;
            *(v4u*)(Wsb + (size_t)i * 8) = (v4u){pk2(e[0], e[1]), pk2(e[2], e[3]), pk2(e[4], e[5]), pk2(e[6], e[7])}; }
    }
}

template <int J> struct ConvStep {
    static __device__ __forceinline__ void run(f32x2 (&acc)[16], const f32x2 (&w)[CW], const LAS unsigned char* p) {
        const unsigned d = *(const LAS unsigned*)(p + J * 1024); const f32x2 v = (f32x2){bf_lo(d), bf_hi(d)};
#pragma unroll
        for (int k = 0; k < CW; ++k) { const int t = J - k; if (t >= 0 && t < 16) acc[t] += w[k] * v; }
        ConvStep<J + 1>::run(acc, w, p);
    }
};
template <> struct ConvStep<46> { static __device__ __forceinline__ void run(f32x2 (&)[16], const f32x2 (&)[CW], const LAS unsigned char*) {} };
__device__ __forceinline__ void conv_tile_load(v4u (&pf)[8], int it, const bf16* Ab, int tid) {
    const int m0 = it * 32, t0 = m0 & (SEQ - 1);
#pragma unroll
    for (int i = 0; i < 8; ++i) { const int q = tid + i * NTHR, row = q >> 6, c16 = q & 63; pf[i] = (v4u){0u, 0u, 0u, 0u};
        if (q < 62 * 64 && t0 - 30 + row >= 0) pf[i] = __builtin_nontemporal_load((const v4u*)(Ab + (size_t)(m0 - 30 + row) * DC + c16 * 8)); }
}
__device__ __forceinline__ void conv_item(LAS unsigned char* lds, int it, int it_next, v4u (&pf)[8], const bf16* Ab, const bf16* SZ, bf16* Y, const f32x2 (&w)[CW], f32x2 cb,
                                          const float* lng, const float* lnb, int tid, int wave, int lane) {
    const int m0 = it * 32;
    LAS unsigned char* in = lds; LAS float* outt = (LAS float*)(lds + 65536);
#pragma unroll
    for (int i = 0; i < 8; ++i) { const int q = tid + i * NTHR, row = q >> 6, c16 = q & 63; if (q < 62 * 64) *(LAS v4u*)(in + row * 1024 + c16 * 16) = pf[i]; }
    __syncthreads();
    if (it_next >= 0) conv_tile_load(pf, it_next, Ab, tid);
    f32x4 gg[2], bb[2]; v2u zz[4][2];
#pragma unroll
    for (int j = 0; j < 2; ++j) { const int c = 4 * lane + 256 * j; gg[j] = *(const f32x4*)(lng + c); bb[j] = *(const f32x4*)(lnb + c);
#pragma unroll
        for (int rr = 0; rr < 4; ++rr) zz[rr][j] = __builtin_nontemporal_load((const v2u*)(SZ + (size_t)(m0 + 4 * wave + rr) * DC + c)); }
    const int cp = tid & 255, rh = tid >> 8;
    f32x2 acc[16];
#pragma unroll
    for (int t = 0; t < 16; ++t) acc[t] = (f32x2){0.f, 0.f};
    ConvStep<0>::run(acc, w, in + (16 * rh) * 1024 + cp * 4);
#pragma unroll
    for (int t = 0; t < 16; ++t) *(LAS f32x2*)(outt + (16 * rh + t) * DC + 2 * cp) = acc[t] + cb;
    __syncthreads();
    {
#pragma unroll
        for (int rr = 0; rr < 4; ++rr) { const int row = 4 * wave + rr; const size_t m = (size_t)(m0 + row);
            f32x4 v[2]; float s = 0.f;
#pragma unroll
            for (int j = 0; j < 2; ++j) { v[j] = *(const LAS f32x4*)(outt + row * DC + 4 * lane + 256 * j); s += (v[j][0] + v[j][1]) + (v[j][2] + v[j][3]); }
            const float mean = wave_sum(s) * (1.f / DC); float s2 = 0.f;
#pragma unroll
            for (int j = 0; j < 2; ++j) { v[j] = v[j] - mean; s2 += (v[j][0] * v[j][0] + v[j][1] * v[j][1]) + (v[j][2] * v[j][2] + v[j][3] * v[j][3]); }
            const float rstd = __builtin_amdgcn_rsqf(wave_sum(s2) * (1.f / DC) + LN_EPS);
#pragma unroll
            for (int j = 0; j < 2; ++j) { const int c = 4 * lane + 256 * j;
                f32x4 y = v[j] * rstd * gg[j] + bb[j];
                y = (f32x4){y[0] * sigm_f(y[0]), y[1] * sigm_f(y[1]), y[2] * sigm_f(y[2]), y[3] * sigm_f(y[3])};
                y = y * (f32x4){bf_lo(zz[rr][j].x), bf_hi(zz[rr][j].x), bf_lo(zz[rr][j].y), bf_hi(zz[rr][j].y)};
                *(v2u*)(Y + m * D + c) = (v2u){pk2(y[0], y[1]), pk2(y[2], y[3])}; } }
    }
    __syncthreads();
}

__device__ __forceinline__ void sgu_item(LAS unsigned char* lds, int c, const bf16* GV, const bf16* UG, const bf16* Wsb, const float* bs, const float* lng, const float* lnb, bf16* Y,
                                         int tid, int wave, int lane) {
    constexpr int RS = 1056;
    const int m0 = c * CHUNK;
    {
        const f32x4 g0 = *(const f32x4*)(lng + 8 * lane), g1 = *(const f32x4*)(lng + 8 * lane + 4), b0 = *(const f32x4*)(lnb + 8 * lane), b1 = *(const f32x4*)(lnb + 8 * lane + 4);
        v4u raw[16];
#pragma unroll
        for (int i = 0; i < 16; ++i) raw[i] = __builtin_nontemporal_load((const v4u*)(GV + (size_t)(m0 + 16 * wave + i) * DC + 8 * lane));
#pragma unroll
        for (int i = 0; i < 16; ++i) {
            f32x4 x0 = (f32x4){bf_lo(raw[i].x), bf_hi(raw[i].x), bf_lo(raw[i].y), bf_hi(raw[i].y)}, x1 = (f32x4){bf_lo(raw[i].z), bf_hi(raw[i].z), bf_lo(raw[i].w), bf_hi(raw[i].w)};
            const float s = (x0[0] + x0[1]) + (x0[2] + x0[3]) + (x1[0] + x1[1]) + (x1[2] + x1[3]);
            const float mean = wave_sum(s) * (1.f / DC);
            x0 = x0 - mean; x1 = x1 - mean;
            const float q = (x0[0] * x0[0] + x0[1] * x0[1]) + (x0[2] * x0[2] + x0[3] * x0[3]) + (x1[0] * x1[0] + x1[1] * x1[1]) + (x1[2] * x1[2] + x1[3] * x1[3]);
            const float rstd = __builtin_amdgcn_rsqf(wave_sum(q) * (1.f / DC) + LN_EPS);
            x0 = x0 * rstd * g0 + b0; x1 = x1 * rstd * g1 + b1;
            *(LAS v4u*)(lds + (16 * wave + i) * RS + lane * 16) = (v4u){pk2(x0[0], x0[1]), pk2(x0[2], x0[3]), pk2(x1[0], x1[1]), pk2(x1[2], x1[3])};
        }
    }
    asm volatile("" ::: "memory");
    bf16x8 wf[20]; float biasv[8];
    int lane_ = lane; asm volatile("" : "+v"(lane_));
    const int h = wave, fr = lane_ & 15, q = lane_ >> 4;
    const bf16* wsb0 = Wsb + (size_t)h * CHUNK * CHUNK; const unsigned woff = (unsigned)(fr * CHUNK + 8 * q);
    {
        int n = 0;
#pragma unroll
        for (int tb = 0; tb < 8; ++tb)
#pragma unroll
            for (int ks = 0; ks < 4; ++ks) if (ks <= (tb >> 1)) { wf[n] = *(const bf16x8*)(wsb0 + (woff + (unsigned)(16 * tb * CHUNK + 32 * ks))); ++n; }
#pragma unroll
        for (int tb = 0; tb < 8; ++tb) biasv[tb] = bs[h * CHUNK + 16 * tb + fr];
    }
    const bf16* ug0 = UG + (size_t)m0 * DC + h * 64; bf16* y0 = Y + (size_t)m0 * D + DC + h * 64;
    const unsigned uoff = (unsigned)(fr * DC + 4 * q), yoff = (unsigned)(fr * D + 4 * q);
    v2u ugv[2][8][2];
#define SGU_UG_LOAD(dh_) do { _Pragma("unroll") for (int tb = 0; tb < 8; ++tb) _Pragma("unroll") for (int nb = 0; nb < 2; ++nb) \
        ugv[dh_][tb][nb] = __builtin_nontemporal_load((const v2u*)(ug0 + (uoff + (unsigned)(16 * tb * DC + (dh_) * 32 + 16 * nb)))); } while (0)
    SGU_UG_LOAD(0);
    __syncthreads();
#pragma unroll
    for (int dh = 0; dh < 2; ++dh) {
        asm volatile("" ::: "memory");
        const int dbase = h * 64 + dh * 32;
        if (dh == 0) SGU_UG_LOAD(1);
        typedef short s16x4 __attribute__((ext_vector_type(4)));
        const LAS unsigned char* vb0 = lds + (8 * q + ((lane_ & 15) >> 2)) * RS + 2 * (dbase + 4 * (lane_ & 3)); const LAS unsigned char* vb1 = vb0 + 64 * RS;
        asm volatile("" : "+v"(vb1));
        bf16x8 vf[2][4];
#pragma unroll
        for (int nb = 0; nb < 2; ++nb)
#pragma unroll
            for (int ks = 0; ks < 4; ++ks) {
                const LAS unsigned char* pb = (ks < 2 ? vb0 : vb1) + (32 * (ks & 1)) * RS + 32 * nb;
                const s16x4 lo = __builtin_amdgcn_ds_read_tr16_b64_v4i16((LAS s16x4*)(pb)), hi = __builtin_amdgcn_ds_read_tr16_b64_v4i16((LAS s16x4*)(pb + 4 * RS));
                vf[nb][ks] = __builtin_shufflevector(lo, hi, 0, 1, 2, 3, 4, 5, 6, 7); }
        int n = 0;
#pragma unroll
        for (int tbh = 0; tbh < 2; ++tbh) {
            f32x4 acc[4][2];
#pragma unroll
            for (int tl = 0; tl < 4; ++tl) { acc[tl][0] = (f32x4){0.f, 0.f, 0.f, 0.f}; acc[tl][1] = (f32x4){0.f, 0.f, 0.f, 0.f}; }
#pragma unroll
            for (int tl = 0; tl < 4; ++tl)
#pragma unroll
                for (int ks = 0; ks < 4; ++ks) if (ks <= ((4 * tbh + tl) >> 1)) {
                    acc[tl][0] = __builtin_amdgcn_mfma_f32_16x16x32_bf16(vf[0][ks], wf[n], acc[tl][0], 0, 0, 0);
                    acc[tl][1] = __builtin_amdgcn_mfma_f32_16x16x32_bf16(vf[1][ks], wf[n], acc[tl][1], 0, 0, 0); ++n; }
#pragma unroll
            for (int tl = 0; tl < 4; ++tl) { const int tb = 4 * tbh + tl;
#pragma unroll
                for (int nb = 0; nb < 2; ++nb) { const v2u ug = ugv[dh][tb][nb];
                    const f32x4 o = (acc[tl][nb] + biasv[tb]) * (f32x4){bf_lo(ug.x), bf_hi(ug.x), bf_lo(ug.y), bf_hi(ug.y)};
                    *(v2u*)(y0 + (yoff + (unsigned)(16 * tb * D + dh * 32 + 16 * nb))) = (v2u){pk2(o[0], o[1]), pk2(o[2], o[3])}; } }
        }
    }
    __syncthreads();
#undef SGU_UG_LOAD
}

__device__ __forceinline__ void p2_mixer(const Args& a, LAS unsigned char* lds, int tid, int wave, int lane) {
    unsigned char* ws = a.ws;
    const bf16* Ab = (const bf16*)(ws + WS_AB); const bf16* SZ = (const bf16*)(ws + WS_SZ); const bf16* UG = (const bf16*)(ws + WS_UG); const bf16* GV = (const bf16*)(ws + WS_GV);
    bf16* Y = (bf16*)(ws + WS_Y);
    constexpr int NCH = M / CHUNK, NCI = M / 32;
    const bool xl = (gridDim.x == 256);
    const int xq = blockIdx.x % 8, lq = blockIdx.x / 8;
    int c_first, c_step, c_last, k_first, k_step, k_last;
    if (xl) { c_first = lq < 16 ? xq * (NCH / 8) + lq : 0; c_last = lq < 16 ? c_first + 1 : 0; c_step = 1;
              k_first = lq < 16 ? 0 : xq * (NCI / 8) + 4 * (lq - 16); k_last = lq < 16 ? 0 : k_first + 4; k_step = 1; }
    else { c_first = blockIdx.x; c_last = NCH; c_step = gridDim.x; k_first = blockIdx.x; k_last = NCI; k_step = gridDim.x; }
    v4u pf[8];
    for (int c = c_first; c < c_last; c += c_step)
        sgu_item(lds, c, GV, UG, (const bf16*)(ws + WS_WSB), a.in[12], a.in[9], a.in[10], Y, tid, wave, lane);
    STAMP(6);
    {
        int tid_c = threadIdx.x; asm volatile("" : "+v"(tid_c));
        const int tid = tid_c, lane = tid & 63; (void)lane;
        const int cp = tid & 255;
        f32x2 w[CW];
#pragma unroll
        for (int k = 0; k < CW; ++k) w[k] = *(const f32x2*)(a.in[5] + k * DC + 2 * cp);
        const f32x2 cb = *(const f32x2*)(a.in[6] + 2 * cp);
        if (k_first < k_last) conv_tile_load(pf, k_first, Ab, tid);
        for (int it = k_first; it < k_last; it += k_step) { const int nx = it + k_step < k_last ? it + k_step : -1;
            conv_item(lds, it, nx, pf, Ab, SZ, Y, w, cb, a.in[7], a.in[8], tid, wave, lane); }
    }
}

__global__ void __launch_bounds__(NTHR, 2) fwd_megakernel(Args a) {
    extern __shared__ __attribute__((aligned(16))) unsigned char lds_raw[];
    LAS unsigned char* lds = (LAS unsigned char*)lds_raw;
    cg::grid_group grid = cg::this_grid();
#define FRESH_IDS int tid = threadIdx.x; asm volatile("" : "+v"(tid)); const int lane = tid & 63, wave = __builtin_amdgcn_readfirstlane(tid >> 6); (void)lane; (void)wave;
    unsigned char* ws = a.ws;
    const int G = gridDim.x;
    if (threadIdx.x < 64) ((LAS unsigned*)(lds + MISC_OFF))[threadIdx.x] = 0u;
    __syncthreads();
    const XcdBarrier bar = xcd_barrier_post((unsigned*)(ws + WS_BAR), (volatile LAS unsigned*)(lds + MISC_OFF));
    if (ws == nullptr) grid.sync();
#define GRID_BAR() xcd_barrier(bar)
    STAMP(0);

#ifndef NO_P0
    for (int rep = 0; rep < REP_P0; ++rep) { FRESH_IDS p0_prologue(a, lds, wave, lane); }
#endif
    STAMP(1);
    GRID_BAR();
    STAMP(2);

#ifndef NO_P1
    for (int rep = 0; rep < REP_P1; ++rep) {
#ifndef NO_IN
    {
        pg8::Gemm g{(const bf16*)(ws + WS_H), (const bf16*)(ws + WS_WIN), M, DIN, D, (const bf16*)(ws + WS_PB), (const bf16*)(ws + WS_WPLE), DPLE / 64}; pg8::StaticOrder S; S.init(M, DIN, G, (int)blockIdx.x); S.init2(D);
        pg8::EpiP1 E{(bf16*)(ws + WS_AB), (bf16*)(ws + WS_SZ), (bf16*)(ws + WS_UG), (bf16*)(ws + WS_GV), (bf16*)(ws + WS_PE)};
        pg8::gemm_phase<pg8::EpiP1, pg8::StaticOrder, PG8_ALIGN, PG8_SP2>(lds, g, S, E);
    }
#endif
    }
#endif
    STAMP(4);
    GRID_BAR();
    STAMP(5);

#ifndef NO_P2
    for (int rep = 0; rep < REP_P2; ++rep) { FRESH_IDS p2_mixer(a, lds, tid, wave, lane); }
#endif
    STAMP(7);
    GRID_BAR();
    STAMP(8);

#ifndef NO_P3
    for (int rep = 0; rep < REP_P3; ++rep)
    {
        pg8::Gemm g{(const bf16*)(ws + WS_Y), (const bf16*)(ws + WS_WOUT), M, D, D}; pg8::StaticOrder S; S.init(M, D, G, (int)blockIdx.x);
#ifdef PROBE_K3
        { pg8::EpiNone E0; pg8::gemm_phase<pg8::EpiNone, pg8::StaticOrder, false, PG8_SP2>(lds, g, S, E0); }
#endif
        pg8::EpiP3 E{(const bf16*)(ws + WS_H), (bf16*)(ws + WS_RB), (float*)(ws + WS_STATSP), ALPHA, G == 256 ? (unsigned*)(ws + WS_PCNT) : nullptr};
        pg8::gemm_phase<pg8::EpiP3, pg8::StaticOrder, false, PG8_SP2>(lds, g, S, E);
    }
#endif
    STAMP(10);
    if (G == 256) {
        pg8::StaticOrder S4; S4.init(M, D, G, (int)blockIdx.x); pg8::Unit u4; (void)S4.next(0, u4);
        if (threadIdx.x == 0) { unsigned* pc = (unsigned*)(ws + WS_PCNT) + 64 * u4.pm; unsigned* bw = (unsigned*)(ws + WS_BAR);
            XB_SPIN(xb_ld(pc) < 4u, bw);
            __builtin_amdgcn_fence(__ATOMIC_ACQUIRE, "agent"); }
        asm volatile("s_waitcnt vmcnt(0)" ::: "memory");
        __syncthreads();
    } else { GRID_BAR(); }
    STAMP(11);

#ifndef NO_P4
    for (int rep = 0; rep < REP_P4; ++rep)
    {
        pg8::Gemm g{(const bf16*)(ws + WS_RB), (const bf16*)(ws + WS_WG), M, D, D}; pg8::StaticOrder S; S.init(M, D, G, (int)blockIdx.x);
        pg8::EpiP4 E{(const bf16*)(ws + WS_RB), (const bf16*)(ws + WS_PE), (const float*)(ws + WS_STATSP), (const float*)(ws + WS_CP1), (const float*)(ws + WS_CP2), a.in[18], a.in[14], a.in[15], a.out, LN_EPS};
        pg8::gemm_phase<pg8::EpiP4, pg8::StaticOrder, false, PG8_SP2>(lds, g, S, E);
    }
#endif
#ifdef TPROBE
    STAMP(13);
    if (blockIdx.x == 0) {
        volatile LAS unsigned long long* T = (volatile LAS unsigned long long*)(lds + MISC_OFF + 64);
        __syncthreads();
        unsigned long long d = 0;
        if (TPROBE == 1) d = (T[2] - T[1]) + (T[5] - T[4]) + (T[8] - T[7]) + (T[11] - T[10]);
        if (TPROBE == 2) d = T[9] - T[8];
        if (TPROBE == 3) d = T[10] - T[9];
        if (TPROBE == 4) d = T[12] - T[11];
        if (TPROBE == 5) d = T[13] - T[12];
        if (TPROBE == 6) d = T[6] - T[5];
        if (TPROBE == 7) d = T[7] - T[6];
        if (TPROBE == 8) d = T[1] - T[0];
        if (TPROBE == 9) d = T[3] - T[2];
        if (TPROBE == 10) d = T[4] - T[3];
        if (TPROBE == 12) d = T[14] - T[0];
        if (TPROBE == 13) d = T[15] - T[14];
        if (TPROBE == 14) d = T[1] - T[15];
        if (TPROBE == 15) d = T[4] - T[2];
        if (TPROBE == 16) d = T[13] - T[0];
        if (TPROBE == 11) d = 2000;
        const unsigned long long t0 = __builtin_amdgcn_s_memrealtime();
        while (__builtin_amdgcn_s_memrealtime() - t0 < d) __builtin_amdgcn_s_sleep(4);
    }
#endif
}

extern "C" void kernel_launch(void* const* d_in, const int* in_sizes, int n_in, void* d_out, int out_size, void* d_ws, size_t ws_size, hipStream_t stream) {
    static int grid = 0;
    if (grid == 0) {
        if (n_in != 19 || in_sizes[0] != M * D || out_size != M * D || ws_size < WS_END) { fprintf(stderr, "kernel_launch: unexpected shapes (n_in %d, in0 %d, out %d, ws %zu)\n", n_in, n_in > 0 ? in_sizes[0] : -1, out_size, ws_size); grid = -1; return; }
        int dev = 0, cus = 0, per_cu = 0;
        if (hipGetDevice(&dev) != hipSuccess || hipDeviceGetAttribute(&cus, hipDeviceAttributeMultiprocessorCount, dev) != hipSuccess) { fprintf(stderr, "kernel_launch: device query failed\n"); grid = -1; return; }
        if (hipFuncSetAttribute((const void*)fwd_megakernel, hipFuncAttributeMaxDynamicSharedMemorySize, LDS_BYTES) != hipSuccess) { fprintf(stderr, "kernel_launch: hipFuncSetAttribute failed\n"); grid = -1; return; }
        if (hipOccupancyMaxActiveBlocksPerMultiprocessor(&per_cu, (const void*)fwd_megakernel, NTHR, LDS_BYTES) != hipSuccess || per_cu < 1) { fprintf(stderr, "kernel_launch: occupancy query says %d\n", per_cu); per_cu = 1; }
        (void)hipGetLastError();
        grid = cus * 1;
    }
    if (grid < 0) return;
    Args a{};
    for (int i = 0; i < 19; ++i) a.in[i] = (const float*)d_in[i];
    a.out = (float*)d_out; a.ws = (unsigned char*)d_ws;
    if (hipMemsetAsync((char*)d_ws + WS_BAR, 0, BAR_ZERO_BYTES, stream) != hipSuccess) { fprintf(stderr, "kernel_launch: memset failed\n"); return; }
#ifdef PROBE_MEMSET2
    (void)hipMemsetAsync((char*)d_ws + 900 * 1024, 0, BAR_ZERO_BYTES, stream);
#endif
    void* args[] = {&a};
    hipError_t e = hipLaunchCooperativeKernel((const void*)fwd_megakernel, dim3(grid), dim3(NTHR), args, LDS_BYTES, stream);
    if (e != hipSuccess) fprintf(stderr, "kernel_launch: cooperative launch failed: %s (grid %d)\n", hipGetErrorString(e), grid);
}
```
